# Optimizing an MI355X kernel written in HIP

```python
import math
import jax, jax.numpy as jnp
from jax import lax
import numpy as np

D_MODEL = 1024
BATCH = 2
SEQ = 8192
DEPTH = 2

CHUNK = 64
Q_BLOCK = 128
D_MIX = D_MODEL
M_WIDTH = D_MIX // 2
M_HEADS = 4
M_HEAD_DIM = M_WIDTH // M_HEADS
CONV_WIDTH = 4
A_WIDTH = D_MIX - M_WIDTH
A_HEADS = 4
A_VDIM = A_WIDTH // A_HEADS
A_QK_DIM = A_VDIM // 2
ROPE_THETA = 10000.0
EPS = 1e-6
PROJ_SIZES = (M_WIDTH, M_WIDTH, M_WIDTH, M_HEADS, M_HEADS, M_WIDTH,
              A_WIDTH, A_WIDTH, A_WIDTH, A_WIDTH)
D_IN = 4 * M_WIDTH + 2 * M_HEADS + 4 * A_WIDTH

kernel_name = "hymba_mlstm_diffattn_trunk"


def rmsnorm(x, w):
    xf = x.astype(jnp.float32)
    y = xf * lax.rsqrt(jnp.mean(xf * xf, axis=-1, keepdims=True) + EPS)
    return (y * w.astype(jnp.float32)).astype(x.dtype)


def causal_conv(x, w, b):
    K, C = w.shape
    y = lax.conv_general_dilated(
        x, w.reshape(K, 1, C).astype(x.dtype), window_strides=(1,),
        padding=[(K - 1, 0)], dimension_numbers=('NWC', 'WIO', 'NWC'),
        feature_group_count=C)
    return y + b


def rope(x):
    S, dh = x.shape[1], x.shape[-1]
    inv = 1.0 / (ROPE_THETA ** (jnp.arange(0, dh, 2, dtype=jnp.float32) / dh))
    ang = jnp.arange(S, dtype=jnp.float32)[:, None] * inv[None, :]
    cos = jnp.concatenate([jnp.cos(ang), jnp.cos(ang)], -1)[None, :, None, None, :]
    sin = jnp.concatenate([jnp.sin(ang), jnp.sin(ang)], -1)[None, :, None, None, :]
    xf = x.astype(jnp.float32)
    x1, x2 = jnp.split(xf, 2, axis=-1)
    rot = jnp.concatenate([-x2, x1], -1)
    return (xf * cos + rot * sin).astype(x.dtype)


def mlstm_chunkwise(q, k, v, i_pre, f_pre):
    B, S, H, D = q.shape
    L = CHUNK
    N = S // L

    def to_chunks(t):
        return t.astype(jnp.float32).reshape(B, N, L, H, -1).transpose(1, 0, 3, 2, 4)

    qc = to_chunks(q)
    kc = to_chunks(k) * (D ** -0.5)
    vc = to_chunks(v)
    lf = jax.nn.log_sigmoid(f_pre.astype(jnp.float32)).reshape(B, N, L, H).transpose(1, 0, 3, 2)
    li = i_pre.astype(jnp.float32).reshape(B, N, L, H).transpose(1, 0, 3, 2)
    causal = jnp.tril(jnp.ones((L, L), dtype=bool))

    def step(carry, inp):
        C, n, m = carry
        q_, k_, v_, lf_, li_ = inp
        b = jnp.cumsum(lf_, axis=-1)
        dmat = jnp.where(causal, b[..., :, None] - b[..., None, :] + li_[..., None, :], -jnp.inf)
        inter = b + m[..., None]
        m_i = jnp.maximum(inter, jnp.max(dmat, axis=-1))
        w_intra = jnp.exp(dmat - m_i[..., None])
        w_inter = jnp.exp(inter - m_i)
        s = jnp.einsum('bhid,bhjd->bhij', q_, k_) * w_intra
        num = (w_inter[..., None] * jnp.einsum('bhid,bhde->bhie', q_, C)
               + jnp.einsum('bhij,bhje->bhie', s, v_))
        den = w_inter * jnp.einsum('bhid,bhd->bhi', q_, n) + jnp.sum(s, axis=-1)
        h = num / jnp.maximum(jnp.abs(den), jnp.exp(-m_i))[..., None]
        b_last = b[..., -1]
        g = b_last[..., None] - b + li_
        m_new = jnp.maximum(b_last + m, jnp.max(g, axis=-1))
        decay = jnp.exp(b_last + m - m_new)
        wk = jnp.exp(g - m_new[..., None])
        C_new = decay[..., None, None] * C + jnp.einsum('bhl,bhld,bhle->bhde', wk, k_, v_)
        n_new = decay[..., None] * n + jnp.einsum('bhl,bhld->bhd', wk, k_)
        return (C_new, n_new, m_new), h

    init = (jnp.zeros((B, H, D, D), jnp.float32), jnp.zeros((B, H, D), jnp.float32),
            jnp.zeros((B, H), jnp.float32))
    _, hs = lax.scan(step, init, (qc, kc, vc, lf, li))
    return hs.transpose(1, 0, 3, 2, 4).reshape(B, S, H, D).astype(q.dtype)


def diff_attention(q, k, v, lam):
    B, S, H, _, dk = q.shape
    dv = v.shape[-1]
    nb = S // Q_BLOCK
    qb = q.astype(jnp.float32).reshape(B, nb, Q_BLOCK, H, 2, dk).transpose(1, 0, 3, 4, 2, 5)
    kt = k.astype(jnp.float32).transpose(0, 2, 3, 1, 4)
    vt = v.astype(jnp.float32).transpose(0, 2, 1, 3)
    key_chunk = jnp.arange(S) // CHUNK
    scale = dk ** -0.5

    def block(args):
        qblk, start = args
        s = jnp.einsum('bhcqd,bhckd->bhcqk', qblk, kt) * scale
        q_chunk = (start + jnp.arange(Q_BLOCK)) // CHUNK
        mask = key_chunk[None, :] <= q_chunk[:, None]
        p = jax.nn.softmax(jnp.where(mask, s, -jnp.inf), axis=-1)
        a = p[:, :, 0] - lam * p[:, :, 1]
        return jnp.einsum('bhqk,bhke->bhqe', a, vt)

    out = lax.map(block, (qb, jnp.arange(nb) * Q_BLOCK))
    return out.transpose(1, 0, 3, 2, 4).reshape(B, S, H, dv).astype(v.dtype)


def hybrid_layer(x, norm_w, w_in, conv_w, conv_b, i_bias, f_bias, m_norm_w, m_skip,
                 lam_q1, lam_k1, lam_q2, lam_k2, a_norm_w, w_out, lambda_init):
    B, S, _ = x.shape
    h = rmsnorm(x, norm_w)
    proj = jnp.einsum('bsd,de->bse', h, w_in)
    idx = list(np.cumsum(PROJ_SIZES)[:-1])
    mq, mk, mv, mi, mf, mz, aq, ak, av, az = jnp.split(proj, idx, axis=-1)

    qk = jax.nn.silu(causal_conv(jnp.concatenate([mq, mk], -1), conv_w, conv_b))
    mq_c, mk_c = jnp.split(qk, 2, axis=-1)
    to_heads = lambda t: t.reshape(B, S, M_HEADS, M_HEAD_DIM)
    hm = mlstm_chunkwise(to_heads(mq_c), to_heads(mk_c), to_heads(mv), mi + i_bias, mf + f_bias)
    hm = rmsnorm(hm, m_norm_w.reshape(M_HEADS, M_HEAD_DIM)).reshape(B, S, M_WIDTH)
    ym = (hm + m_skip * mq_c) * jax.nn.silu(mz)

    qa = rope(aq.reshape(B, S, A_HEADS, 2, A_QK_DIM))
    ka = rope(ak.reshape(B, S, A_HEADS, 2, A_QK_DIM))
    lam = (jnp.exp(jnp.sum(lam_q1.astype(jnp.float32) * lam_k1.astype(jnp.float32)))
           - jnp.exp(jnp.sum(lam_q2.astype(jnp.float32) * lam_k2.astype(jnp.float32)))
           + lambda_init)
    ha = diff_attention(qa, ka, av.reshape(B, S, A_HEADS, A_VDIM), lam)
    ha = (rmsnorm(ha, a_norm_w) * (1.0 - lambda_init)).reshape(B, S, A_WIDTH)
    ya = ha * jax.nn.silu(az)

    y = jnp.einsum('bse,ed->bsd', jnp.concatenate([ym, ya], -1), w_out)
    return x + y


def setup_inputs(seed: int = 0) -> dict:
    key = jax.random.key(seed)
    ks = jax.random.split(key, 16)
    f32 = jnp.float32
    nrm = lambda k, shape, s: jax.random.normal(k, shape, f32) * s
    f_base = jnp.linspace(3.0, 6.0, M_HEADS, dtype=f32)[None, :]
    return {
        "x": nrm(ks[0], (BATCH, SEQ, D_MODEL), 1.0),
        "norm_w": 1.0 + nrm(ks[1], (DEPTH, D_MODEL), 0.02),
        "w_in": nrm(ks[2], (DEPTH, D_MODEL, D_IN), D_MODEL ** -0.5),
        "conv_w": nrm(ks[3], (DEPTH, CONV_WIDTH, 2 * M_WIDTH), CONV_WIDTH ** -0.5),
        "conv_b": nrm(ks[4], (DEPTH, 2 * M_WIDTH), 0.01),
        "i_bias": nrm(ks[5], (DEPTH, M_HEADS), 0.1),
        "f_bias": f_base + nrm(ks[6], (DEPTH, M_HEADS), 0.1),
        "m_norm_w": 1.0 + nrm(ks[7], (DEPTH, M_WIDTH), 0.02),
        "m_skip": 1.0 + nrm(ks[8], (DEPTH, M_WIDTH), 0.02),
        "lam_q1": nrm(ks[9], (DEPTH, A_QK_DIM), 0.1),
        "lam_k1": nrm(ks[10], (DEPTH, A_QK_DIM), 0.1),
        "lam_q2": nrm(ks[11], (DEPTH, A_QK_DIM), 0.1),
        "lam_k2": nrm(ks[12], (DEPTH, A_QK_DIM), 0.1),
        "a_norm_w": 1.0 + nrm(ks[13], (DEPTH, A_VDIM), 0.02),
        "w_out": nrm(ks[14], (DEPTH, D_MIX, D_MODEL), D_MIX ** -0.5),
        "final_norm_w": 1.0 + nrm(ks[15], (D_MODEL,), 0.02),
    }


def reference(x, norm_w, w_in, conv_w, conv_b, i_bias, f_bias, m_norm_w, m_skip,
              lam_q1, lam_k1, lam_q2, lam_k2, a_norm_w, w_out, final_norm_w):
    for l in range(DEPTH):
        lambda_init = 0.8 - 0.6 * math.exp(-0.3 * l)
        x = hybrid_layer(x, norm_w[l], w_in[l], conv_w[l], conv_b[l], i_bias[l], f_bias[l],
                         m_norm_w[l], m_skip[l], lam_q1[l], lam_k1[l], lam_q2[l], lam_k2[l],
                         a_norm_w[l], w_out[l], lambda_init)
    return rmsnorm(x, final_norm_w)
```

```cpp
#include <hip/hip_runtime.h>
#include <hip/hip_cooperative_groups.h>
#include <cstdio>
#include <cstdint>
namespace cg = cooperative_groups;

#ifndef MK_ONE_LAUNCH
#define MK_ONE_LAUNCH 0
#endif

namespace pg8 {
#define PG8_LAS __attribute__((address_space(3)))
typedef unsigned short bf16_t;
typedef short bf16x8 __attribute__((ext_vector_type(8)));
typedef float f32x4 __attribute__((ext_vector_type(4)));
typedef unsigned u32x4 __attribute__((ext_vector_type(4)));
constexpr int BM = 256, BK = 64, HALF = 128, HTB = HALF * BK * 2  , STAGE_BYTES = 8 * HTB, NXCD = 8, WGM = 8;

__host__ __device__ __forceinline__ int lds_byte(int r, int c) { const int st = (r >> 4) * 2 + (c >> 5), rr = r & 15, cc = c & 31, ob = rr * 64 + cc * 2; return st * 1024 + (ob ^ (((ob >> 9) & 1) << 5)); }
__host__ __device__ __forceinline__ void stage_rc(int b, int& R, int& C) { const int st = b / 1024, sb = b % 1024, swz = sb ^ (((sb >> 9) & 1) << 5); R = (st >> 1) * 16 + swz / 64; C = (st & 1) * 32 + (swz % 64) / 2; }
__host__ __device__ __forceinline__ int perm32(int rho) { const int n = rho >> 4, i = rho & 15; return 8 * (i >> 2) + 4 * n + (i & 3); }

struct Unit { int pm, pn; };
struct Gemm { const bf16_t* A; const bf16_t* Bt; int M, N, K; };

struct StaticOrder {
    int nM, nN, nwg, G, c;
    __host__ __device__ void init(int M, int N, int G_, int c_) { nM = M / BM; nN = N / BM; nwg = nM * nN; G = G_; c = c_; }
    __host__ __device__ bool next(int i, Unit& u) const {
        const long L = (long)i * G + c; if (L >= nwg) return false;
        int wgid = (int)L; { const int q = nwg / NXCD, r = nwg % NXCD, xcd = wgid % NXCD, off = wgid / NXCD; wgid = (xcd < r ? xcd * (q + 1) : r * (q + 1) + (xcd - r) * q) + off; }
        const int nig = WGM * nN, gid = wgid / nig, fm = gid * WGM, gsz = (nM - fm) < WGM ? (nM - fm) : WGM;
        u.pm = fm + ((wgid % nig) % gsz); u.pn = (wgid % nig) / gsz; return true;
    }
    __device__ __forceinline__ void a_ready(const Unit&) const {}
    __device__ __forceinline__ void done(const Unit&) const {}
};


__device__ __forceinline__ unsigned cvt_pk_bf16(float lo, float hi) { unsigned r; asm volatile("v_cvt_pk_bf16_f32 %0, %1, %2" : "=v"(r) : "v"(lo), "v"(hi)); return r; }
typedef unsigned u32x2 __attribute__((ext_vector_type(2)));

struct EpiProj {
    static constexpr bool PERM = true, AFTER_DRAIN = false;
    bf16_t* P; const float* cosT; const float* sinT; float c2;
    __device__ __forceinline__ void operator()(const f32x4 (&acc)[2][2][4][2], const Unit& u, int wr, int wc, int fr, int fq) const {
        const int row0 = u.pm * BM + wr * 64 + fr;
        const int kind = (u.pn >= 8 && u.pn < 12) ? (u.pn < 10 ? 1 : 2) : 0;
        if (kind == 0) {
            const int col0 = u.pn * BM + wc * 32 + 8 * fq;
#pragma unroll
            for (int ai = 0; ai < 2; ++ai)
#pragma unroll
                for (int m = 0; m < 4; ++m) { bf16_t* rowp = P + (size_t)(row0 + ai * HALF + m * 16) * 4096 + col0;
#pragma unroll
                    for (int bj = 0; bj < 2; ++bj) { const f32x4 v0 = acc[ai][bj][m][0], v1 = acc[ai][bj][m][1];
                        u32x4 w; w.x = cvt_pk_bf16(v0[0], v0[1]); w.y = cvt_pk_bf16(v0[2], v0[3]); w.z = cvt_pk_bf16(v1[0], v1[1]); w.w = cvt_pk_bf16(v1[2], v1[3]);
                        *(u32x4*)(rowp + bj * HALF) = w; } }
        } else {
            const float sc = (kind == 1) ? c2 : 1.0f;
#pragma unroll
            for (int ai = 0; ai < 2; ++ai)
#pragma unroll
                for (int m = 0; m < 4; ++m) { const int row = row0 + ai * HALF + m * 16; const int pos = row & 8191;
#pragma unroll
                    for (int bj = 0; bj < 2; ++bj) { const f32x4 v0 = acc[ai][bj][m][0], v1 = acc[ai][bj][m][1];
                        const int cg_ = u.pn * BM + bj * HALF + wc * 32 + 8 * fq; const int i0 = (cg_ & 63) >> 1; const int gb = cg_ & ~63;
                        const f32x4 cs = *(const f32x4*)(cosT + pos * 32 + i0), sn = *(const f32x4*)(sinT + pos * 32 + i0);
                        const f32x4 x1 = (f32x4){v0[0], v0[2], v1[0], v1[2]}, x2 = (f32x4){v0[1], v0[3], v1[1], v1[3]};
                        const f32x4 o1 = (x1 * cs - x2 * sn) * sc, o2 = (x2 * cs + x1 * sn) * sc;
                        u32x2 w1, w2; w1.x = cvt_pk_bf16(o1[0], o1[1]); w1.y = cvt_pk_bf16(o1[2], o1[3]); w2.x = cvt_pk_bf16(o2[0], o2[1]); w2.y = cvt_pk_bf16(o2[2], o2[3]);
                        bf16_t* dst = P + (size_t)row * 4096 + gb + i0;
                        *(u32x2*)dst = w1; *(u32x2*)(dst + 32) = w2; } }
        }
    }
};
struct EpiRes {
    static constexpr bool PERM = false, AFTER_DRAIN = false;
    const float* base; float* out;
    __device__ __forceinline__ void operator()(const f32x4 (&acc)[2][2][4][2], const Unit& u, int wr, int wc, int fr, int fq) const {
        const int row0 = u.pm * BM + wr * 64 + fr, col0 = u.pn * BM + wc * 32 + 4 * fq;
#pragma unroll
        for (int ai = 0; ai < 2; ++ai)
#pragma unroll
            for (int m = 0; m < 4; ++m) { const size_t off = (size_t)(row0 + ai * HALF + m * 16) * 1024 + col0;
#pragma unroll
                for (int bj = 0; bj < 2; ++bj)
#pragma unroll
                    for (int n = 0; n < 2; ++n) { const f32x4 bs = *(const f32x4*)(base + off + bj * HALF + n * 16); *(f32x4*)(out + off + bj * HALF + n * 16) = bs + acc[ai][bj][m][n]; }
                if (m & 1) asm volatile("" ::: "memory"); }
    }
};

template <class Epi, class Sched, bool ALIGN_EPI = false, bool SP2 = false>
__device__ __forceinline__ void gemm_phase(PG8_LAS unsigned char* lds, const Gemm g, const Sched& S, const Epi& E) {
    const int tid = threadIdx.x, wid = __builtin_amdgcn_readfirstlane(tid >> 6), lane = tid & 63, wr = wid >> 2, wc = wid & 3, fr = lane & 15, fq = lane >> 4;
    const int K = g.K, nt = K / BK;
    unsigned voffA[2], voffB[2];
#pragma unroll
    for (int i = 0; i < 2; ++i) { int R, C; stage_rc(tid * 16 + i * 8192, R, C); const int Rb = Epi::PERM ? ((R & ~31) + perm32(R & 31)) : R;
        voffA[i] = (unsigned)(R * K + C) * 2u; voffB[i] = (unsigned)(Rb * K + C) * 2u; }
    const size_t kstep = (size_t)(BK * 2);
    const size_t hstep = (size_t)HALF * K * 2;
    const size_t tstep = 2 * hstep;
    const unsigned ldsw = (unsigned)wid * 1024u;
    const int aoff = lds_byte(wr * 64 + fr, fq * 8), boff = lds_byte(wc * 32 + fr, fq * 8);
#define PG8_SA(b, h) (((b) * 2 + (h)) * HTB)
#define PG8_SB(b, h) ((4 + (b) * 2 + (h)) * HTB)
#define PG8_STAGE(bufoff, gbase, voff) do { _Pragma("unroll") for (int _i = 0; _i < 2; ++_i) \
        __builtin_amdgcn_global_load_lds((const unsigned*)((const char*)(gbase) + (voff)[_i]), (PG8_LAS unsigned*)(lds + (bufoff) + ldsw + _i * 8192), 16, 0, 0); } while (0)
#define PG8_LDA(dst, b, h) do { _Pragma("unroll") for (int m = 0; m < 4; ++m) _Pragma("unroll") for (int k = 0; k < 2; ++k) dst[m][k] = *(const PG8_LAS bf16x8*)(lds + PG8_SA(b, h) + aoff + m * 2048 + k * 1024); } while (0)
#define PG8_LDB(dst, b, h) do { _Pragma("unroll") for (int n = 0; n < 2; ++n) _Pragma("unroll") for (int k = 0; k < 2; ++k) dst[n][k] = *(const PG8_LAS bf16x8*)(lds + PG8_SB(b, h) + boff + n * 2048 + k * 1024); } while (0)
#define PG8_MMA(ai, bj, At, Bt) do { __builtin_amdgcn_s_setprio(1); _Pragma("unroll") for (int m = 0; m < 4; ++m) _Pragma("unroll") for (int n = 0; n < 2; ++n) _Pragma("unroll") for (int k = 0; k < 2; ++k) \
        acc[ai][bj][m][n] = __builtin_amdgcn_mfma_f32_16x16x32_bf16(Bt[n][k], At[m][k], acc[ai][bj][m][n], 0, 0, 0); __builtin_amdgcn_s_setprio(0); } while (0)
#define PG8_WAIT_V(n) asm volatile("s_waitcnt vmcnt(" #n ")" ::: "memory")
#define PG8_WAIT_L(n) asm volatile("s_waitcnt lgkmcnt(" #n ")" ::: "memory")
#define PG8_BAR __builtin_amdgcn_s_barrier()
#define PG8_SCHED __builtin_amdgcn_sched_barrier(0)
    Unit cur, nxt; int ui = 0;
    if (!S.next(0, cur)) return;
    f32x4 acc[2][2][4][2];
#pragma unroll
    for (int a = 0; a < 2; ++a)
#pragma unroll
        for (int b = 0; b < 2; ++b)
#pragma unroll
            for (int m = 0; m < 4; ++m)
#pragma unroll
                for (int n = 0; n < 2; ++n) acc[a][b][m][n] = (f32x4){0.f, 0.f, 0.f, 0.f};
    bf16x8 At[4][2], B0[2][2], B1[2][2];
    const char* cA = (const char*)g.A + (size_t)cur.pm * tstep; const char* cB = (const char*)g.Bt + (size_t)cur.pn * tstep;
    S.a_ready(cur);
    if constexpr (SP2) {
        PG8_STAGE(PG8_SB(0, 0), cB, voffB); PG8_STAGE(PG8_SB(0, 1), cB + hstep, voffB); PG8_STAGE(PG8_SA(0, 0), cA, voffA); PG8_STAGE(PG8_SA(0, 1), cA + hstep, voffA);
        if (wr == 1) PG8_BAR;
        PG8_WAIT_V(2); PG8_BAR;
        PG8_STAGE(PG8_SB(1, 0), cB + kstep, voffB); PG8_STAGE(PG8_SA(1, 0), cA + kstep, voffA); PG8_STAGE(PG8_SB(1, 1), cB + hstep + kstep, voffB);
        PG8_WAIT_V(6); PG8_BAR;
    } else {
        PG8_STAGE(PG8_SB(0, 0), cB, voffB); PG8_STAGE(PG8_SA(0, 0), cA, voffA); PG8_STAGE(PG8_SB(0, 1), cB + hstep, voffB); PG8_STAGE(PG8_SA(0, 1), cA + hstep, voffA);
        if (wr == 1) PG8_BAR;
        PG8_WAIT_V(4); PG8_BAR;
        PG8_STAGE(PG8_SB(1, 0), cB + kstep, voffB); PG8_STAGE(PG8_SA(1, 0), cA + kstep, voffA); PG8_STAGE(PG8_SB(1, 1), cB + hstep + kstep, voffB);
        PG8_WAIT_V(6); PG8_BAR;
    }
    for (;;) {
        const bool has_next = S.next(ui + 1, nxt);
        const char* nA = has_next ? (const char*)g.A + (size_t)nxt.pm * tstep : cA; const char* nB = has_next ? (const char*)g.Bt + (size_t)nxt.pn * tstep : cB;
        for (int t = 0; t < nt; t += 2) {
            const bool last = (t == nt - 2);
            const char* a1 = cA + (size_t)(t + 1) * kstep;
            const char* a2 = last ? nA : cA + (size_t)(t + 2) * kstep; const char* b2 = last ? nB : cB + (size_t)(t + 2) * kstep;
            const char* a3 = a2 + kstep; const char* b3 = b2 + kstep;
            if (last && has_next) S.a_ready(nxt);
            if constexpr (SP2) {
            PG8_LDB(B0, 0, 0); PG8_LDB(B1, 0, 1); PG8_SCHED; PG8_LDA(At, 0, 0); PG8_STAGE(PG8_SA(1, 1), a1 + hstep, voffA);
            PG8_WAIT_V(8); PG8_WAIT_L(0); PG8_BAR; PG8_MMA(0, 0, At, B0); PG8_MMA(0, 1, At, B1); PG8_BAR; PG8_SCHED;
            PG8_LDA(At, 0, 1); PG8_STAGE(PG8_SB(0, 0), b2, voffB); PG8_STAGE(PG8_SB(0, 1), b2 + hstep, voffB); PG8_STAGE(PG8_SA(0, 0), a2, voffA);
            PG8_WAIT_V(8); PG8_WAIT_L(0); PG8_BAR; PG8_MMA(1, 0, At, B0); PG8_MMA(1, 1, At, B1); PG8_BAR; PG8_SCHED;
            PG8_LDB(B0, 1, 0); PG8_LDB(B1, 1, 1); PG8_SCHED; PG8_LDA(At, 1, 0); PG8_STAGE(PG8_SA(0, 1), a2 + hstep, voffA);
            PG8_WAIT_V(8); PG8_WAIT_L(0); PG8_BAR; PG8_MMA(0, 0, At, B0); PG8_MMA(0, 1, At, B1); PG8_BAR; PG8_SCHED;
            PG8_LDA(At, 1, 1); PG8_STAGE(PG8_SB(1, 0), b3, voffB); PG8_STAGE(PG8_SB(1, 1), b3 + hstep, voffB); PG8_STAGE(PG8_SA(1, 0), a3, voffA);
            PG8_WAIT_V(8); PG8_WAIT_L(0); PG8_BAR; PG8_MMA(1, 0, At, B0); PG8_MMA(1, 1, At, B1); PG8_BAR; PG8_SCHED;
            } else {
            PG8_LDB(B0, 0, 0); PG8_SCHED; PG8_LDA(At, 0, 0); PG8_STAGE(PG8_SA(1, 1), a1 + hstep, voffA);
            PG8_WAIT_L(8); PG8_BAR; PG8_WAIT_L(0); PG8_MMA(0, 0, At, B0); PG8_BAR; PG8_SCHED;
            PG8_LDB(B1, 0, 1); PG8_STAGE(PG8_SB(0, 0), b2, voffB);
            PG8_BAR; PG8_WAIT_L(0); PG8_MMA(0, 1, At, B1); PG8_BAR;
            PG8_LDA(At, 0, 1); PG8_STAGE(PG8_SA(0, 0), a2, voffA);
            PG8_BAR; PG8_WAIT_L(0); PG8_MMA(1, 0, At, B0); PG8_BAR; PG8_SCHED;
            PG8_STAGE(PG8_SB(0, 1), b2 + hstep, voffB);
            PG8_WAIT_V(6); PG8_BAR; PG8_MMA(1, 1, At, B1); PG8_BAR;
            PG8_LDB(B0, 1, 0); PG8_SCHED; PG8_LDA(At, 1, 0); PG8_STAGE(PG8_SA(0, 1), a2 + hstep, voffA);
            PG8_WAIT_L(8); PG8_BAR; PG8_WAIT_L(0); PG8_MMA(0, 0, At, B0); PG8_BAR; PG8_SCHED;
            PG8_LDB(B1, 1, 1); PG8_STAGE(PG8_SB(1, 0), b3, voffB);
            PG8_BAR; PG8_WAIT_L(0); PG8_MMA(0, 1, At, B1); PG8_BAR;
            PG8_LDA(At, 1, 1); PG8_STAGE(PG8_SA(1, 0), a3, voffA);
            PG8_BAR; PG8_WAIT_L(0); PG8_MMA(1, 0, At, B0); PG8_BAR; PG8_SCHED;
            PG8_STAGE(PG8_SB(1, 1), b3 + hstep, voffB);
            PG8_WAIT_V(6); PG8_BAR; PG8_MMA(1, 1, At, B1); PG8_BAR;
            }
        }
        if constexpr (ALIGN_EPI) { if (wr == 0) PG8_BAR; }
        if constexpr (!Epi::AFTER_DRAIN) { E(acc, cur, wr, wc, fr, fq); S.done(cur); }
        if (!has_next) break;
#pragma unroll
        for (int a = 0; a < 2; ++a)
#pragma unroll
            for (int b = 0; b < 2; ++b)
#pragma unroll
                for (int m = 0; m < 4; ++m)
#pragma unroll
                    for (int n = 0; n < 2; ++n) acc[a][b][m][n] = (f32x4){0.f, 0.f, 0.f, 0.f};
        cur = nxt; cA = nA; cB = nB; ++ui;
        if constexpr (ALIGN_EPI) { if (wr == 1) PG8_BAR; }
    }
    PG8_WAIT_V(0);
    if constexpr (!ALIGN_EPI) { if (wr == 0) PG8_BAR; }
    PG8_BAR;
    if constexpr (Epi::AFTER_DRAIN) { E.fused(acc, cur, wr, wc, fr, fq, lds, wid, lane); S.done(cur); }
#undef PG8_SA
#undef PG8_SB
#undef PG8_STAGE
#undef PG8_LDA
#undef PG8_LDB
#undef PG8_MMA
#undef PG8_WAIT_V
#undef PG8_WAIT_L
#undef PG8_BAR
#undef PG8_SCHED
}
}

constexpr int BATCH = 2, SEQ = 8192, DMODEL = 1024, DEPTH = 2, TOK = BATCH * SEQ;
constexpr int DIN = 4104, NPROJ = 4096;
constexpr int C_MQ = 0, C_MK = 512, C_MV = 1024, C_MZ = 1536, C_AQ = 2048, C_AK = 2560, C_AV = 3072, C_AZ = 3584;
constexpr float EPS = 1e-6f;
constexpr float C2 = 0.125f * 1.4426950408889634f;
constexpr float KSCALE = 0.08838834764831845f;
__constant__ float INVF[32] = {1.000000000e+00f, 7.498942018e-01f, 5.623413324e-01f, 4.216965139e-01f, 3.162277639e-01f, 2.371373624e-01f, 1.778279394e-01f, 1.333521456e-01f, 1.000000015e-01f, 7.498941571e-02f, 5.623412877e-02f, 4.216964915e-02f, 3.162277862e-02f, 2.371373586e-02f, 1.778279431e-02f, 1.333521493e-02f, 9.999999776e-03f, 7.498942316e-03f, 5.623413250e-03f, 4.216964822e-03f, 3.162277862e-03f, 2.371373819e-03f, 1.778279431e-03f, 1.333521446e-03f, 1.000000047e-03f, 7.498941850e-04f, 5.623413017e-04f, 4.216964880e-04f, 3.162277862e-04f, 2.371373848e-04f, 1.778279402e-04f, 1.333521504e-04f};
__device__ __forceinline__ float lambda_init(int l) { return l == 0 ? 0.2f : 0.35550906759096934f; }

constexpr size_t MiB = 1u << 20;
constexpr size_t WS_CTL = 0, CTL_ZERO_BYTES = 1 * MiB;
constexpr size_t WS_WIN = 2 * MiB;
constexpr size_t WS_WOUT = 18 * MiB;
constexpr size_t WS_COS = 22 * MiB, WS_SIN = 23 * MiB;
constexpr size_t WS_LAM = 24 * MiB;
constexpr size_t WS_GATES = 25 * MiB;
constexpr size_t WS_DC = 32 * MiB, WS_CST = 48 * MiB;
constexpr size_t WS_XN = 56 * MiB;
constexpr size_t WS_PROJ = 88 * MiB;
constexpr size_t WS_QC = 216 * MiB, WS_KC = 232 * MiB, WS_END = 248 * MiB;

constexpr int RING_BYTES = 131072, LDS_BYTES = 147456;

typedef unsigned short bf16;
typedef float f32x4 __attribute__((ext_vector_type(4)));
typedef unsigned v4u __attribute__((ext_vector_type(4)));
#define LAS __attribute__((address_space(3)))
__device__ __forceinline__ float bf2f(unsigned short u) { return __uint_as_float((unsigned)u << 16); }
__device__ __forceinline__ unsigned f2bf(float f) { unsigned u = __builtin_bit_cast(unsigned, f); return (u + 0x7fffu + ((u >> 16) & 1u)) >> 16; }
__device__ __forceinline__ unsigned pk2(float lo, float hi) { return f2bf(lo) | (f2bf(hi) << 16); }
__device__ __forceinline__ float wave_sum(float v) {
#pragma unroll
    for (int o = 1; o < 64; o <<= 1) v += __shfl_xor(v, o);
    return v;
}
__device__ __forceinline__ float silu_f(float x) { return x / (1.0f + __expf(-x)); }
__device__ __forceinline__ float logsigmoid_f(float x) { return fminf(x, 0.f) - log1pf(expf(-fabsf(x))); }

struct Args {
    const float* x; const float* norm_w; const float* w_in; const float* conv_w; const float* conv_b; const float* i_bias; const float* f_bias; const float* m_norm_w;
    const float* m_skip; const float* lq1; const float* lk1; const float* lq2; const float* lk2; const float* a_norm_w; const float* w_out; const float* fnw;
    float* out; unsigned char* ws; int ph_lo, ph_hi;
};

__device__ __forceinline__ int src_col(int g) {
    if (g < 1536) return g;
    if (g < 2048) return g + 8;
    if (g < 3072) { const int base = (g < 2560) ? 2056 : 2568; const int j = (g - 2048) & 511; const int grp = j >> 6, jj = j & 63; return base + grp * 64 + (jj >> 1) + 32 * (jj & 1); }
    return g + 8;
}
template <bool MAP> __device__ __forceinline__ void transpose_item(const float* W, int ldw, int K, int N, bf16* WT, LAS float* scr, int item, int lane) {
    const int nblk = N / 32, kb = item / nblk, nb = item % nblk, k0 = 64 * kb, n0 = 32 * nb;
    const int sc = MAP ? src_col(n0 + (lane & 31)) : (n0 + (lane & 31));
#pragma unroll 8
    for (int i = 0; i < 32; ++i) { const int kk = 2 * i + (lane >> 5); scr[kk * 33 + (lane & 31)] = W[(size_t)(k0 + kk) * ldw + sc]; }
    asm volatile("s_waitcnt lgkmcnt(0)" ::: "memory");
    const int c = lane & 7;
#pragma unroll
    for (int j = 0; j < 4; ++j) { const int n = (lane >> 3) + 8 * j; const LAS float* s = scr + (8 * c) * 33 + n;
        v4u o; o.x = pk2(s[0 * 33], s[1 * 33]); o.y = pk2(s[2 * 33], s[3 * 33]); o.z = pk2(s[4 * 33], s[5 * 33]); o.w = pk2(s[6 * 33], s[7 * 33]);
        *(v4u*)(WT + (size_t)(n0 + n) * K + k0 + 8 * c) = o; }
    asm volatile("s_waitcnt lgkmcnt(0)" ::: "memory");
}
__device__ __forceinline__ void sincos_acc(float xf, float& s, float& c) {
    const double x = (double)xf; const double k = __builtin_rint(x * 0.63661977236758134308);
    const double r = (x - k * 1.57079632679489655800) - k * 6.123233995736766e-17; const double r2 = r * r;
    double sp = r2 * (-1.0 / 6227020800.0) + (1.0 / 39916800.0); sp = sp * r2 - (1.0 / 362880.0); sp = sp * r2 + (1.0 / 5040.0); sp = sp * r2 - (1.0 / 120.0); sp = sp * r2 + (1.0 / 6.0); sp = r - r * r2 * sp;
    double cp = r2 * (1.0 / 87178291200.0) - (1.0 / 479001600.0); cp = cp * r2 + (1.0 / 3628800.0); cp = cp * r2 - (1.0 / 40320.0); cp = cp * r2 + (1.0 / 720.0); cp = cp * r2 - (1.0 / 24.0); cp = cp * r2 + 0.5; cp = 1.0 - r2 * cp;
    const int q = ((int)k) & 3;
    const double ss = (q == 0) ? sp : (q == 1) ? cp : (q == 2) ? -sp : -cp;
    const double cc = (q == 0) ? cp : (q == 1) ? -sp : (q == 2) ? -cp : sp;
    s = (float)ss; c = (float)cc;
}

struct Frame {
    LAS unsigned char* lds; int tid, lane, wave, vcu, G;
    unsigned char* ws;
};

__device__ __forceinline__ void phase_prologue(const Frame& F, const Args& a) {
    LAS float* scr = (LAS float*)(F.lds + F.wave * 16384);
    const int gw = F.vcu * 8 + F.wave, NGW = F.G * 8;
    constexpr int I_IN = (DMODEL / 64) * (NPROJ / 32), I_OUT = (DMODEL / 64) * (DMODEL / 32);
    constexpr int NITEMS = DEPTH * (I_IN + I_OUT);
    for (int it = gw; it < NITEMS; it += NGW) {
        int r = it; const int l = r / (I_IN + I_OUT); r -= l * (I_IN + I_OUT);
        if (r < I_IN) transpose_item<true>(a.w_in + (size_t)l * DMODEL * DIN, DIN, DMODEL, NPROJ, (bf16*)(F.ws + WS_WIN) + (size_t)l * NPROJ * DMODEL, scr, r, F.lane);
        else transpose_item<false>(a.w_out + (size_t)l * DMODEL * DMODEL, DMODEL, DMODEL, DMODEL, (bf16*)(F.ws + WS_WOUT) + (size_t)l * DMODEL * DMODEL, scr, r - I_IN, F.lane);
    }
    float* cosT = (float*)(F.ws + WS_COS); float* sinT = (float*)(F.ws + WS_SIN);
    for (int idx = (F.vcu * 512 + F.tid); idx < SEQ * 32; idx += F.G * 512) {
        const int pos = idx >> 5, i = idx & 31; const float ang = (float)pos * INVF[i]; float s, c; sincos_acc(ang, s, c); cosT[idx] = c; sinT[idx] = s;
    }
    if (F.vcu == 0 && F.wave < DEPTH) {
        const int l = F.wave;
        const float p1 = wave_sum(a.lq1[l * 64 + F.lane] * a.lk1[l * 64 + F.lane]), p2 = wave_sum(a.lq2[l * 64 + F.lane] * a.lk2[l * 64 + F.lane]);
        if (F.lane == 0) ((float*)(F.ws + WS_LAM))[l] = expf(p1) - expf(p2) + lambda_init(l);
    }
}

__device__ __forceinline__ void phase_rownorm(const Frame& F, const float* xin, const float* nw, const float* wg_src, const float* ib, const float* fb, bf16* XN, float* GATES, float* fout) {
    LAS float* WG = (LAS float*)F.lds;
    __syncthreads();
    if (wg_src) {
        for (int idx = F.tid; idx < 8192; idx += 512) { const int k = idx >> 3, g = idx & 7; WG[g * 1024 + k] = wg_src[(size_t)k * DIN + 1536 + g]; }
    }
    __syncthreads();
    const int gw = F.vcu * 8 + F.wave, NGW = F.G * 8;
    f32x4 nwv[4];
#pragma unroll
    for (int j = 0; j < 4; ++j) nwv[j] = ((const f32x4*)nw)[64 * j + F.lane];
    for (int row = gw; row < TOK; row += NGW) {
        const f32x4* xr = (const f32x4*)(xin + (size_t)row * DMODEL) + F.lane;
        f32x4 v[4]; float s = 0.f;
#pragma unroll
        for (int j = 0; j < 4; ++j) { v[j] = xr[64 * j]; s += (v[j].x * v[j].x + v[j].y * v[j].y) + (v[j].z * v[j].z + v[j].w * v[j].w); }
        const float rstd = 1.0f / sqrtf(wave_sum(s) * (1.0f / DMODEL) + EPS);
#pragma unroll
        for (int j = 0; j < 4; ++j) v[j] = v[j] * rstd * nwv[j];
        if (fout) {
            f32x4* o = (f32x4*)(fout + (size_t)row * DMODEL) + F.lane;
#pragma unroll
            for (int j = 0; j < 4; ++j) o[64 * j] = v[j];
        } else {
            unsigned long long* o8 = (unsigned long long*)(XN + (size_t)row * DMODEL) + F.lane;
#pragma unroll
            for (int j = 0; j < 4; ++j) o8[64 * j] = (unsigned long long)pk2(v[j].x, v[j].y) | ((unsigned long long)pk2(v[j].z, v[j].w) << 32);
            float gs[8];
#pragma unroll
            for (int g = 0; g < 8; ++g) { float t = 0.f;
#pragma unroll
                for (int j = 0; j < 4; ++j) { const f32x4 w = *(const LAS f32x4*)(WG + g * 1024 + 256 * j + 4 * F.lane); t += (v[j].x * w.x + v[j].y * w.y) + (v[j].z * w.z + v[j].w * w.w); }
                gs[g] = wave_sum(t); }
            float mine = gs[0];
#pragma unroll
            for (int g = 1; g < 8; ++g) mine = (F.lane == g) ? gs[g] : mine;
            if (F.lane < 4) GATES[(size_t)row * 8 + F.lane] = mine + ib[F.lane];
            else if (F.lane < 8) GATES[(size_t)row * 8 + F.lane] = logsigmoid_f(mine + fb[F.lane - 4]);
        }
    }
    __syncthreads();
}

__device__ __forceinline__ void naive_mlstm_unit(const Frame& F, const Args& a, int l, int bh) {
    const int b = bh >> 2, h = bh & 3, e = F.tid & 127; const bool act = F.tid < 128;
    LAS float* qs = (LAS float*)F.lds; LAS float* ks = qs + 128; LAS float* red = ks + 128; LAS float* red2 = red + 8;
    const bf16* PROJ = (const bf16*)(F.ws + WS_PROJ); const float* GATES = (const float*)(F.ws + WS_GATES); bf16* Y = (bf16*)(F.ws + WS_XN);
    const float* cw = a.conv_w + (size_t)l * 4 * 1024; const float* cb = a.conv_b + (size_t)l * 1024;
    const int cq = h * 128 + e, ck = 512 + h * 128 + e;
    const float wq0 = cw[cq], wq1 = cw[1024 + cq], wq2 = cw[2048 + cq], wq3 = cw[3072 + cq], bq = cb[cq];
    const float wk0 = cw[ck], wk1 = cw[1024 + ck], wk2 = cw[2048 + ck], wk3 = cw[3072 + ck], bk = cb[ck];
    const float mnw = a.m_norm_w[l * 512 + cq], msk = a.m_skip[l * 512 + cq];
    float C[128];
#pragma unroll
    for (int d = 0; d < 128; ++d) C[d] = 0.f;
    float n_e = 0.f, m = 0.f, xq1 = 0.f, xq2 = 0.f, xq3 = 0.f, xk1 = 0.f, xk2 = 0.f, xk3 = 0.f;
    for (int t = 0; t < SEQ; ++t) {
        const size_t row = (size_t)b * SEQ + t; const bf16* pr = PROJ + row * 4096;
        float qc = 0.f, ve = 0.f, mz = 0.f, a_ = 0.f, bb = 0.f;
        if (act) {
            const float xq0 = bf2f(pr[C_MQ + cq]), xk0 = bf2f(pr[C_MK + cq]); ve = bf2f(pr[C_MV + cq]); mz = bf2f(pr[C_MZ + cq]);
            const float li = GATES[row * 8 + h], lf = GATES[row * 8 + 4 + h];
            qc = silu_f(bq + wq0 * xq3 + wq1 * xq2 + wq2 * xq1 + wq3 * xq0);
            const float kc = silu_f(bk + wk0 * xk3 + wk1 * xk2 + wk2 * xk1 + wk3 * xk0) * KSCALE;
            xq3 = xq2; xq2 = xq1; xq1 = xq0; xk3 = xk2; xk2 = xk1; xk1 = xk0;
            const float m_new = fmaxf(lf + m, li); a_ = expf(lf + m - m_new); bb = expf(li - m_new); m = m_new;
            n_e = a_ * n_e + bb * kc;
            qs[e] = qc; ks[e] = kc;
            const float dp = wave_sum(n_e * qc); if (F.lane == 0) red[F.wave] = dp;
        }
        __syncthreads();
        float hval = 0.f;
        if (act) {
            const float den = red[0] + red[1]; const float bv = bb * ve; float acc = 0.f;
#pragma unroll
            for (int d = 0; d < 128; ++d) { C[d] = a_ * C[d] + bv * ks[d]; acc += C[d] * qs[d]; }
            hval = acc / fmaxf(fabsf(den), expf(-m));
            const float sq = wave_sum(hval * hval); if (F.lane == 0) red2[F.wave] = sq;
        }
        __syncthreads();
        if (act) {
            const float ssq = red2[0] + red2[1];
            const float hm = hval * (1.0f / sqrtf(ssq * (1.0f / 128.0f) + EPS)) * mnw;
            const float ym = (hm + msk * qc) * silu_f(mz);
            Y[row * 1024 + cq] = (bf16)f2bf(ym);
        }
    }
    __syncthreads();
}

__device__ __forceinline__ void naive_attn_unit(const Frame& F, const Args& a, int l, int unit) {
    const int blk = unit & 63, h = (unit >> 6) & 3, b = unit >> 8;
    const int r = F.tid & 127, map = (F.tid >> 7) & 1, half = F.tid >> 8;
    const int q0 = blk * 128, c0 = q0 >> 6, myc = c0 + (r >> 6);
    LAS float* Kf = (LAS float*)F.lds; LAS float* Vf = Kf + 64 * 128; LAS float* Cb = Kf; LAS float* red = Kf + 2 * 64 * 128;
    const bf16* PROJ = (const bf16*)(F.ws + WS_PROJ); bf16* Y = (bf16*)(F.ws + WS_XN);
    const size_t row = (size_t)b * SEQ + q0 + r;
    float q[64], o[64];
    { const bf16* qp = PROJ + row * 4096 + C_AQ + h * 128 + map * 64;
#pragma unroll
      for (int d = 0; d < 64; ++d) q[d] = bf2f(qp[d]); }
#pragma unroll
    for (int e = 0; e < 64; ++e) o[e] = 0.f;
    float m = -1e30f, lsum = 0.f;
    for (int kt = 0; kt <= c0 + 1; ++kt) {
        __syncthreads();
#pragma unroll
        for (int i = 0; i < 2; ++i) { const int id = F.tid + 512 * i, key = id >> 4, c8 = id & 15;
            const bf16* kp = PROJ + ((size_t)b * SEQ + kt * 64 + key) * 4096 + h * 128 + c8 * 8;
            const v4u kk = *(const v4u*)(kp + C_AK), vv = *(const v4u*)(kp + C_AV);
            LAS float* kd = Kf + key * 128 + c8 * 8; LAS float* vd = Vf + key * 128 + c8 * 8;
            kd[0] = __uint_as_float(kk.x << 16); kd[1] = __uint_as_float(kk.x & 0xffff0000u); kd[2] = __uint_as_float(kk.y << 16); kd[3] = __uint_as_float(kk.y & 0xffff0000u);
            kd[4] = __uint_as_float(kk.z << 16); kd[5] = __uint_as_float(kk.z & 0xffff0000u); kd[6] = __uint_as_float(kk.w << 16); kd[7] = __uint_as_float(kk.w & 0xffff0000u);
            vd[0] = __uint_as_float(vv.x << 16); vd[1] = __uint_as_float(vv.x & 0xffff0000u); vd[2] = __uint_as_float(vv.y << 16); vd[3] = __uint_as_float(vv.y & 0xffff0000u);
            vd[4] = __uint_as_float(vv.z << 16); vd[5] = __uint_as_float(vv.z & 0xffff0000u); vd[6] = __uint_as_float(vv.w << 16); vd[7] = __uint_as_float(vv.w & 0xffff0000u); }
        __syncthreads();
        if (kt <= myc) {
            for (int j = 0; j < 64; ++j) {
                const LAS float* kr = Kf + j * 128 + map * 64; const LAS float* vr = Vf + j * 128 + half * 64;
                float s = 0.f;
#pragma unroll
                for (int d = 0; d < 64; ++d) s += q[d] * kr[d];
                const float m_new = fmaxf(m, s), alpha = exp2f(m - m_new), p = exp2f(s - m_new);
                lsum = lsum * alpha + p; m = m_new;
#pragma unroll
                for (int e = 0; e < 64; ++e) o[e] = o[e] * alpha + p * vr[e];
            }
        }
    }
    __syncthreads();
    const float inv_l = 1.0f / lsum; const float lam = ((const float*)(F.ws + WS_LAM))[l];
    if (map == 1) {
#pragma unroll
        for (int e = 0; e < 64; ++e) Cb[r * 128 + half * 64 + e] = lam * o[e] * inv_l;
    }
    __syncthreads();
    float ssq = 0.f;
    if (map == 0) {
#pragma unroll
        for (int e = 0; e < 64; ++e) { o[e] = o[e] * inv_l - Cb[r * 128 + half * 64 + e]; ssq += o[e] * o[e]; }
        red[half * 128 + r] = ssq;
    }
    __syncthreads();
    if (map == 0) {
        const float rstd = 1.0f / sqrtf((red[r] + red[128 + r]) * (1.0f / 128.0f) + EPS); const float g = 1.0f - lambda_init(l);
        const bf16* azp = PROJ + row * 4096 + C_AZ + h * 128 + half * 64; bf16* yp = Y + row * 1024 + 512 + h * 128 + half * 64; const float* anw = a.a_norm_w + l * 128 + half * 64;
#pragma unroll
        for (int e = 0; e < 64; ++e) yp[e] = (bf16)f2bf(o[e] * rstd * anw[e] * g * silu_f(bf2f(azp[e])));
    }
    __syncthreads();
}

constexpr int N_PHASES = 1 + 6 * DEPTH;
#ifndef NAIVE_MIX
#define NAIVE_MIX 1
#endif
constexpr bool HAS_B12 = (NAIVE_MIX == 0);
#define PH_IN(k) (lo <= (k) && (k) < hi)
#define PH_SYNC(k) do { if (lo <= (k) && (k) + 1 < hi) cg::this_grid().sync(); } while (0)
template <int L> __device__ __forceinline__ void layer_phases(const Frame& F, const Args& a, const int lo, const int hi) {
    constexpr int base = 1 + 6 * L;
    bf16* XN = (bf16*)(a.ws + WS_XN); bf16* PROJ = (bf16*)(a.ws + WS_PROJ); float* GATES = (float*)(a.ws + WS_GATES);
    if (PH_IN(base + 0)) {
        pg8::Gemm g{XN, (const bf16*)(a.ws + WS_WIN) + (size_t)L * NPROJ * DMODEL, TOK, NPROJ, DMODEL}; pg8::StaticOrder S; S.init(TOK, NPROJ, F.G, (int)blockIdx.x);
        pg8::EpiProj E{PROJ, (const float*)(a.ws + WS_COS), (const float*)(a.ws + WS_SIN), C2};
        pg8::gemm_phase<pg8::EpiProj, pg8::StaticOrder, true, true>(F.lds, g, S, E);
    }
    PH_SYNC(base + 0);
    if (HAS_B12) { PH_SYNC(base + 1); PH_SYNC(base + 2); }
    if (PH_IN(base + 3)) {
        if (F.vcu < 8) naive_mlstm_unit(F, a, L, F.vcu);
        for (int u = F.vcu; u < 512; u += F.G) naive_attn_unit(F, a, L, u);
    }
    PH_SYNC(base + 3);
    if (PH_IN(base + 4)) {
        pg8::Gemm g{XN  , (const bf16*)(a.ws + WS_WOUT) + (size_t)L * DMODEL * DMODEL, TOK, DMODEL, DMODEL}; pg8::StaticOrder S; S.init(TOK, DMODEL, F.G, (int)blockIdx.x);
        pg8::EpiRes E{L == 0 ? a.x : a.out, a.out};
        pg8::gemm_phase<pg8::EpiRes, pg8::StaticOrder, false, true>(F.lds, g, S, E);
    }
    PH_SYNC(base + 4);
    if (PH_IN(base + 5)) {
        if (L + 1 < DEPTH) phase_rownorm(F, a.out, a.norm_w + (L + 1) * DMODEL, a.w_in + (size_t)(L + 1) * DMODEL * DIN, a.i_bias + (L + 1) * 4, a.f_bias + (L + 1) * 4, XN, GATES, nullptr);
        else phase_rownorm(F, a.out, a.fnw, nullptr, nullptr, nullptr, nullptr, nullptr, a.out);
    }
    if (L + 1 < DEPTH) PH_SYNC(base + 5);
}
__global__ void __launch_bounds__(512, 2) fwd_kernel(Args a) {
    extern __shared__ __attribute__((aligned(16))) unsigned char lds_raw[];
    Frame F; F.lds = (LAS unsigned char*)lds_raw; F.tid = threadIdx.x; F.lane = F.tid & 63; F.wave = __builtin_amdgcn_readfirstlane(F.tid >> 6);
    F.G = gridDim.x; { const int bx = blockIdx.x; F.vcu = (F.G % 8 == 0) ? (bx % 8) * (F.G / 8) + bx / 8 : bx; }
    F.ws = a.ws;
    const int lo = a.ph_lo, hi = a.ph_hi;
    if (PH_IN(0)) {
        phase_prologue(F, a);
        phase_rownorm(F, a.x, a.norm_w, a.w_in, a.i_bias, a.f_bias, (bf16*)(a.ws + WS_XN), (float*)(a.ws + WS_GATES), nullptr);
    }
    PH_SYNC(0);
    layer_phases<0>(F, a, lo, hi);
    layer_phases<1>(F, a, lo, hi);
}

extern "C" void kernel_launch(void* const* d_in, const int* in_sizes, int n_in, void* d_out, int out_size, void* d_ws, size_t ws_size, hipStream_t stream) {
    static int grid = 0;
    if (grid == 0) {
        if (n_in != 16 || in_sizes[0] != TOK * DMODEL || out_size != TOK * DMODEL || ws_size < WS_END) { fprintf(stderr, "kernel_launch: unexpected shapes (n_in %d, in0 %d, out %d, ws %zu)\n", n_in, n_in > 0 ? in_sizes[0] : -1, out_size, ws_size); grid = -1; return; }
        int dev = 0, cus = 0, per_cu = 0;
        hipGetDevice(&dev); hipDeviceGetAttribute(&cus, hipDeviceAttributeMultiprocessorCount, dev);
        if (hipFuncSetAttribute((const void*)fwd_kernel, hipFuncAttributeMaxDynamicSharedMemorySize, LDS_BYTES) != hipSuccess) { fprintf(stderr, "kernel_launch: hipFuncSetAttribute failed\n"); grid = -1; return; }
        hipOccupancyMaxActiveBlocksPerMultiprocessor(&per_cu, (const void*)fwd_kernel, 512, LDS_BYTES);
        (void)hipGetLastError();
        if (per_cu < 1) { fprintf(stderr, "kernel_launch: occupancy query says %d blocks per CU\n", per_cu); grid = -1; return; }
        grid = cus;
        if (grid != 256) fprintf(stderr, "kernel_launch: note: %d CUs\n", grid);
    }
    if (grid < 0) return;
    Args a{};
    a.x = (const float*)d_in[0]; a.norm_w = (const float*)d_in[1]; a.w_in = (const float*)d_in[2]; a.conv_w = (const float*)d_in[3]; a.conv_b = (const float*)d_in[4];
    a.i_bias = (const float*)d_in[5]; a.f_bias = (const float*)d_in[6]; a.m_norm_w = (const float*)d_in[7]; a.m_skip = (const float*)d_in[8];
    a.lq1 = (const float*)d_in[9]; a.lk1 = (const float*)d_in[10]; a.lq2 = (const float*)d_in[11]; a.lk2 = (const float*)d_in[12]; a.a_norm_w = (const float*)d_in[13];
    a.w_out = (const float*)d_in[14]; a.fnw = (const float*)d_in[15]; a.out = (float*)d_out; a.ws = (unsigned char*)d_ws;
#if MK_ONE_LAUNCH
    a.ph_lo = 0; a.ph_hi = N_PHASES;
    void* args[] = {&a};
    hipError_t e = hipLaunchCooperativeKernel((const void*)fwd_kernel, dim3(grid), dim3(512), args, LDS_BYTES, stream);
    if (e != hipSuccess) fprintf(stderr, "cooperative launch failed: %s (grid %d)\n", hipGetErrorString(e), grid);
#else
    for (int ph = 0; ph < N_PHASES; ++ph) {
        if (ph > 0) { const int s = (ph - 1) % 6; if (!HAS_B12 && (s == 1 || s == 2)) continue; }
        a.ph_lo = ph; a.ph_hi = ph + 1;
        hipLaunchKernelGGL(fwd_kernel, dim3(grid), dim3(512), LDS_BYTES, stream, a);
    }
#endif
}
```

```cpp
#include <hip/hip_runtime.h>
#include <hip/hip_cooperative_groups.h>
#include <cstdio>
#include <cstdint>
namespace cg = cooperative_groups;

#ifndef MK_ONE_LAUNCH
#define MK_ONE_LAUNCH 1
#endif

namespace pg8 {
#define PG8_LAS __attribute__((address_space(3)))
typedef unsigned short bf16_t;
typedef short bf16x8 __attribute__((ext_vector_type(8)));
typedef float f32x4 __attribute__((ext_vector_type(4)));
typedef unsigned u32x4 __attribute__((ext_vector_type(4)));
constexpr int BM = 256, BK = 64, HALF = 128, HTB = HALF * BK * 2  , STAGE_BYTES = 8 * HTB, NXCD = 8, WGM = 8;

__host__ __device__ __forceinline__ int lds_byte(int r, int c) { const int st = (r >> 4) * 2 + (c >> 5), rr = r & 15, cc = c & 31, ob = rr * 64 + cc * 2; return st * 1024 + (ob ^ (((ob >> 9) & 1) << 5)); }
__host__ __device__ __forceinline__ void stage_rc(int b, int& R, int& C) { const int st = b / 1024, sb = b % 1024, swz = sb ^ (((sb >> 9) & 1) << 5); R = (st >> 1) * 16 + swz / 64; C = (st & 1) * 32 + (swz % 64) / 2; }
__host__ __device__ __forceinline__ int perm32(int rho) { const int n = rho >> 4, i = rho & 15; return 8 * (i >> 2) + 4 * n + (i & 3); }

struct Unit { int pm, pn; };
struct Gemm { const bf16_t* A; const bf16_t* Bt; int M, N, K; };

struct StaticOrder {
    int nM, nN, nwg, G, c;
    __host__ __device__ void init(int M, int N, int G_, int c_) { nM = M / BM; nN = N / BM; nwg = nM * nN; G = G_; c = c_; }
    __host__ __device__ bool next(int i, Unit& u) const {
        const long L = (long)i * G + c; if (L >= nwg) return false;
        int wgid = (int)L; { const int q = nwg / NXCD, r = nwg % NXCD, xcd = wgid % NXCD, off = wgid / NXCD; wgid = (xcd < r ? xcd * (q + 1) : r * (q + 1) + (xcd - r) * q) + off; }
        const int nig = WGM * nN, gid = wgid / nig, fm = gid * WGM, gsz = (nM - fm) < WGM ? (nM - fm) : WGM;
        u.pm = fm + ((wgid % nig) % gsz); u.pn = (wgid % nig) / gsz; return true;
    }
    __device__ __forceinline__ void a_ready(const Unit&) const {}
    __device__ __forceinline__ void done(const Unit&) const {}
};


__device__ __forceinline__ unsigned cvt_pk_bf16(float lo, float hi) { unsigned r; asm volatile("v_cvt_pk_bf16_f32 %0, %1, %2" : "=v"(r) : "v"(lo), "v"(hi)); return r; }
typedef unsigned u32x2 __attribute__((ext_vector_type(2)));

struct EpiProj {
    static constexpr bool PERM = true, AFTER_DRAIN = false;
    bf16_t* P; const float* cosT; const float* sinT; float c2;
    __device__ __forceinline__ void operator()(const f32x4 (&acc)[2][2][4][2], const Unit& u, int wr, int wc, int fr, int fq) const {
        const int row0 = u.pm * BM + wr * 64 + fr;
        const int kind = (u.pn >= 8 && u.pn < 12) ? (u.pn < 10 ? 1 : 2) : 0;
        if (kind == 0) {
            const int col0 = u.pn * BM + wc * 32 + 8 * fq;
#pragma unroll
            for (int ai = 0; ai < 2; ++ai)
#pragma unroll
                for (int m = 0; m < 4; ++m) { bf16_t* rowp = P + (size_t)(row0 + ai * HALF + m * 16) * 4096 + col0;
#pragma unroll
                    for (int bj = 0; bj < 2; ++bj) { const f32x4 v0 = acc[ai][bj][m][0], v1 = acc[ai][bj][m][1];
                        u32x4 w; w.x = cvt_pk_bf16(v0[0], v0[1]); w.y = cvt_pk_bf16(v0[2], v0[3]); w.z = cvt_pk_bf16(v1[0], v1[1]); w.w = cvt_pk_bf16(v1[2], v1[3]);
                        *(u32x4*)(rowp + bj * HALF) = w; } }
        } else {
            const float sc = (kind == 1) ? c2 : 1.0f;
#pragma unroll
            for (int ai = 0; ai < 2; ++ai)
#pragma unroll
                for (int m = 0; m < 4; ++m) { const int row = row0 + ai * HALF + m * 16; const int pos = row & 8191;
#pragma unroll
                    for (int bj = 0; bj < 2; ++bj) { const f32x4 v0 = acc[ai][bj][m][0], v1 = acc[ai][bj][m][1];
                        const int cg_ = u.pn * BM + bj * HALF + wc * 32 + 8 * fq; const int i0 = (cg_ & 63) >> 1; const int gb = cg_ & ~63;
                        const f32x4 cs = *(const f32x4*)(cosT + pos * 32 + i0), sn = *(const f32x4*)(sinT + pos * 32 + i0);
                        const f32x4 x1 = (f32x4){v0[0], v0[2], v1[0], v1[2]}, x2 = (f32x4){v0[1], v0[3], v1[1], v1[3]};
                        const f32x4 o1 = (x1 * cs - x2 * sn) * sc, o2 = (x2 * cs + x1 * sn) * sc;
                        u32x2 w1, w2; w1.x = cvt_pk_bf16(o1[0], o1[1]); w1.y = cvt_pk_bf16(o1[2], o1[3]); w2.x = cvt_pk_bf16(o2[0], o2[1]); w2.y = cvt_pk_bf16(o2[2], o2[3]);
                        bf16_t* dst = P + (size_t)row * 4096 + gb + i0;
                        *(u32x2*)dst = w1; *(u32x2*)(dst + 32) = w2; } }
        }
    }
};
struct EpiRes {
    static constexpr bool PERM = false, AFTER_DRAIN = false;
    const float* base; float* out;
    __device__ __forceinline__ void operator()(const f32x4 (&acc)[2][2][4][2], const Unit& u, int wr, int wc, int fr, int fq) const {
        const int row0 = u.pm * BM + wr * 64 + fr, col0 = u.pn * BM + wc * 32 + 4 * fq;
#pragma unroll
        for (int ai = 0; ai < 2; ++ai)
#pragma unroll
            for (int m = 0; m < 4; ++m) { const size_t off = (size_t)(row0 + ai * HALF + m * 16) * 1024 + col0;
#pragma unroll
                for (int bj = 0; bj < 2; ++bj)
#pragma unroll
                    for (int n = 0; n < 2; ++n) { const f32x4 bs = *(const f32x4*)(base + off + bj * HALF + n * 16); *(f32x4*)(out + off + bj * HALF + n * 16) = bs + acc[ai][bj][m][n]; }
                if (m & 1) asm volatile("" ::: "memory"); }
    }
};

template <class Epi, class Sched, bool ALIGN_EPI = false, bool SP2 = false>
__device__ __forceinline__ void gemm_phase(PG8_LAS unsigned char* lds, const Gemm g, const Sched& S, const Epi& E) {
    const int tid = threadIdx.x, wid = __builtin_amdgcn_readfirstlane(tid >> 6), lane = tid & 63, wr = wid >> 2, wc = wid & 3, fr = lane & 15, fq = lane >> 4;
    const int K = g.K, nt = K / BK;
    unsigned voffA[2], voffB[2];
#pragma unroll
    for (int i = 0; i < 2; ++i) { int R, C; stage_rc(tid * 16 + i * 8192, R, C); const int Rb = Epi::PERM ? ((R & ~31) + perm32(R & 31)) : R;
        voffA[i] = (unsigned)(R * K + C) * 2u; voffB[i] = (unsigned)(Rb * K + C) * 2u; }
    const size_t kstep = (size_t)(BK * 2);
    const size_t hstep = (size_t)HALF * K * 2;
    const size_t tstep = 2 * hstep;
    const unsigned ldsw = (unsigned)wid * 1024u;
    const int aoff = lds_byte(wr * 64 + fr, fq * 8), boff = lds_byte(wc * 32 + fr, fq * 8);
#define PG8_SA(b, h) (((b) * 2 + (h)) * HTB)
#define PG8_SB(b, h) ((4 + (b) * 2 + (h)) * HTB)
#define PG8_STAGE(bufoff, gbase, voff) do { _Pragma("unroll") for (int _i = 0; _i < 2; ++_i) \
        __builtin_amdgcn_global_load_lds((const unsigned*)((const char*)(gbase) + (voff)[_i]), (PG8_LAS unsigned*)(lds + (bufoff) + ldsw + _i * 8192), 16, 0, 0); } while (0)
#define PG8_LDA(dst, b, h) do { _Pragma("unroll") for (int m = 0; m < 4; ++m) _Pragma("unroll") for (int k = 0; k < 2; ++k) dst[m][k] = *(const PG8_LAS bf16x8*)(lds + PG8_SA(b, h) + aoff + m * 2048 + k * 1024); } while (0)
#define PG8_LDB(dst, b, h) do { _Pragma("unroll") for (int n = 0; n < 2; ++n) _Pragma("unroll") for (int k = 0; k < 2; ++k) dst[n][k] = *(const PG8_LAS bf16x8*)(lds + PG8_SB(b, h) + boff + n * 2048 + k * 1024); } while (0)
#define PG8_MMA(ai, bj, At, Bt) do { __builtin_amdgcn_s_setprio(1); _Pragma("unroll") for (int m = 0; m < 4; ++m) _Pragma("unroll") for (int n = 0; n < 2; ++n) _Pragma("unroll") for (int k = 0; k < 2; ++k) \
        acc[ai][bj][m][n] = __builtin_amdgcn_mfma_f32_16x16x32_bf16(Bt[n][k], At[m][k], acc[ai][bj][m][n], 0, 0, 0); __builtin_amdgcn_s_setprio(0); } while (0)
#define PG8_WAIT_V(n) asm volatile("s_waitcnt vmcnt(" #n ")" ::: "memory")
#define PG8_WAIT_L(n) asm volatile("s_waitcnt lgkmcnt(" #n ")" ::: "memory")
#define PG8_BAR __builtin_amdgcn_s_barrier()
#define PG8_SCHED __builtin_amdgcn_sched_barrier(0)
    Unit cur, nxt; int ui = 0;
    if (!S.next(0, cur)) return;
    f32x4 acc[2][2][4][2];
#pragma unroll
    for (int a = 0; a < 2; ++a)
#pragma unroll
        for (int b = 0; b < 2; ++b)
#pragma unroll
            for (int m = 0; m < 4; ++m)
#pragma unroll
                for (int n = 0; n < 2; ++n) acc[a][b][m][n] = (f32x4){0.f, 0.f, 0.f, 0.f};
    bf16x8 At[4][2], B0[2][2], B1[2][2];
    const char* cA = (const char*)g.A + (size_t)cur.pm * tstep; const char* cB = (const char*)g.Bt + (size_t)cur.pn * tstep;
    S.a_ready(cur);
    if constexpr (SP2) {
        PG8_STAGE(PG8_SB(0, 0), cB, voffB); PG8_STAGE(PG8_SB(0, 1), cB + hstep, voffB); PG8_STAGE(PG8_SA(0, 0), cA, voffA); PG8_STAGE(PG8_SA(0, 1), cA + hstep, voffA);
        if (wr == 1) PG8_BAR;
        PG8_WAIT_V(2); PG8_BAR;
        PG8_STAGE(PG8_SB(1, 0), cB + kstep, voffB); PG8_STAGE(PG8_SA(1, 0), cA + kstep, voffA); PG8_STAGE(PG8_SB(1, 1), cB + hstep + kstep, voffB);
        PG8_WAIT_V(6); PG8_BAR;
    } else {
        PG8_STAGE(PG8_SB(0, 0), cB, voffB); PG8_STAGE(PG8_SA(0, 0), cA, voffA); PG8_STAGE(PG8_SB(0, 1), cB + hstep, voffB); PG8_STAGE(PG8_SA(0, 1), cA + hstep, voffA);
        if (wr == 1) PG8_BAR;
        PG8_WAIT_V(4); PG8_BAR;
        PG8_STAGE(PG8_SB(1, 0), cB + kstep, voffB); PG8_STAGE(PG8_SA(1, 0), cA + kstep, voffA); PG8_STAGE(PG8_SB(1, 1), cB + hstep + kstep, voffB);
        PG8_WAIT_V(6); PG8_BAR;
    }
    for (;;) {
        const bool has_next = S.next(ui + 1, nxt);
        const char* nA = has_next ? (const char*)g.A + (size_t)nxt.pm * tstep : cA; const char* nB = has_next ? (const char*)g.Bt + (size_t)nxt.pn * tstep : cB;
        for (int t = 0; t < nt; t += 2) {
            const bool last = (t == nt - 2);
            const char* a1 = cA + (size_t)(t + 1) * kstep;
            const char* a2 = last ? nA : cA + (size_t)(t + 2) * kstep; const char* b2 = last ? nB : cB + (size_t)(t + 2) * kstep;
            const char* a3 = a2 + kstep; const char* b3 = b2 + kstep;
            if (last && has_next) S.a_ready(nxt);
            if constexpr (SP2) {
            PG8_LDB(B0, 0, 0); PG8_LDB(B1, 0, 1); PG8_SCHED; PG8_LDA(At, 0, 0); PG8_STAGE(PG8_SA(1, 1), a1 + hstep, voffA);
            PG8_WAIT_V(8); PG8_WAIT_L(0); PG8_BAR; PG8_MMA(0, 0, At, B0); PG8_MMA(0, 1, At, B1); PG8_BAR; PG8_SCHED;
            PG8_LDA(At, 0, 1); PG8_STAGE(PG8_SB(0, 0), b2, voffB); PG8_STAGE(PG8_SB(0, 1), b2 + hstep, voffB); PG8_STAGE(PG8_SA(0, 0), a2, voffA);
            PG8_WAIT_V(8); PG8_WAIT_L(0); PG8_BAR; PG8_MMA(1, 0, At, B0); PG8_MMA(1, 1, At, B1); PG8_BAR; PG8_SCHED;
            PG8_LDB(B0, 1, 0); PG8_LDB(B1, 1, 1); PG8_SCHED; PG8_LDA(At, 1, 0); PG8_STAGE(PG8_SA(0, 1), a2 + hstep, voffA);
            PG8_WAIT_V(8); PG8_WAIT_L(0); PG8_BAR; PG8_MMA(0, 0, At, B0); PG8_MMA(0, 1, At, B1); PG8_BAR; PG8_SCHED;
            PG8_LDA(At, 1, 1); PG8_STAGE(PG8_SB(1, 0), b3, voffB); PG8_STAGE(PG8_SB(1, 1), b3 + hstep, voffB); PG8_STAGE(PG8_SA(1, 0), a3, voffA);
            PG8_WAIT_V(8); PG8_WAIT_L(0); PG8_BAR; PG8_MMA(1, 0, At, B0); PG8_MMA(1, 1, At, B1); PG8_BAR; PG8_SCHED;
            } else {
            PG8_LDB(B0, 0, 0); PG8_SCHED; PG8_LDA(At, 0, 0); PG8_STAGE(PG8_SA(1, 1), a1 + hstep, voffA);
            PG8_WAIT_L(8); PG8_BAR; PG8_WAIT_L(0); PG8_MMA(0, 0, At, B0); PG8_BAR; PG8_SCHED;
            PG8_LDB(B1, 0, 1); PG8_STAGE(PG8_SB(0, 0), b2, voffB);
            PG8_BAR; PG8_WAIT_L(0); PG8_MMA(0, 1, At, B1); PG8_BAR;
            PG8_LDA(At, 0, 1); PG8_STAGE(PG8_SA(0, 0), a2, voffA);
            PG8_BAR; PG8_WAIT_L(0); PG8_MMA(1, 0, At, B0); PG8_BAR; PG8_SCHED;
            PG8_STAGE(PG8_SB(0, 1), b2 + hstep, voffB);
            PG8_WAIT_V(6); PG8_BAR; PG8_MMA(1, 1, At, B1); PG8_BAR;
            PG8_LDB(B0, 1, 0); PG8_SCHED; PG8_LDA(At, 1, 0); PG8_STAGE(PG8_SA(0, 1), a2 + hstep, voffA);
            PG8_WAIT_L(8); PG8_BAR; PG8_WAIT_L(0); PG8_MMA(0, 0, At, B0); PG8_BAR; PG8_SCHED;
            PG8_LDB(B1, 1, 1); PG8_STAGE(PG8_SB(1, 0), b3, voffB);
            PG8_BAR; PG8_WAIT_L(0); PG8_MMA(0, 1, At, B1); PG8_BAR;
            PG8_LDA(At, 1, 1); PG8_STAGE(PG8_SA(1, 0), a3, voffA);
            PG8_BAR; PG8_WAIT_L(0); PG8_MMA(1, 0, At, B0); PG8_BAR; PG8_SCHED;
            PG8_STAGE(PG8_SB(1, 1), b3 + hstep, voffB);
            PG8_WAIT_V(6); PG8_BAR; PG8_MMA(1, 1, At, B1); PG8_BAR;
            }
        }
        if constexpr (ALIGN_EPI) { if (wr == 0) PG8_BAR; }
        if constexpr (!Epi::AFTER_DRAIN) { E(acc, cur, wr, wc, fr, fq); S.done(cur); }
        if (!has_next) break;
#pragma unroll
        for (int a = 0; a < 2; ++a)
#pragma unroll
            for (int b = 0; b < 2; ++b)
#pragma unroll
                for (int m = 0; m < 4; ++m)
#pragma unroll
                    for (int n = 0; n < 2; ++n) acc[a][b][m][n] = (f32x4){0.f, 0.f, 0.f, 0.f};
        cur = nxt; cA = nA; cB = nB; ++ui;
        if constexpr (ALIGN_EPI) { if (wr == 1) PG8_BAR; }
    }
    PG8_WAIT_V(0);
    if constexpr (!ALIGN_EPI) { if (wr == 0) PG8_BAR; }
    PG8_BAR;
    if constexpr (Epi::AFTER_DRAIN) { E.fused(acc, cur, wr, wc, fr, fq, lds, wid, lane); S.done(cur); }
#undef PG8_SA
#undef PG8_SB
#undef PG8_STAGE
#undef PG8_LDA
#undef PG8_LDB
#undef PG8_MMA
#undef PG8_WAIT_V
#undef PG8_WAIT_L
#undef PG8_BAR
#undef PG8_SCHED
}
}

constexpr int BATCH = 2, SEQ = 8192, DMODEL = 1024, DEPTH = 2, TOK = BATCH * SEQ;
constexpr int DIN = 4104, NPROJ = 4096;
constexpr int C_MQ = 0, C_MK = 512, C_MV = 1024, C_MZ = 1536, C_AQ = 2048, C_AK = 2560, C_AV = 3072, C_AZ = 3584;
constexpr float EPS = 1e-6f;
constexpr float C2 = 0.125f * 1.4426950408889634f;
constexpr float KSCALE = 0.08838834764831845f;
__constant__ float INVF[32] = {1.000000000e+00f, 7.498942018e-01f, 5.623413324e-01f, 4.216965139e-01f, 3.162277639e-01f, 2.371373624e-01f, 1.778279394e-01f, 1.333521456e-01f, 1.000000015e-01f, 7.498941571e-02f, 5.623412877e-02f, 4.216964915e-02f, 3.162277862e-02f, 2.371373586e-02f, 1.778279431e-02f, 1.333521493e-02f, 9.999999776e-03f, 7.498942316e-03f, 5.623413250e-03f, 4.216964822e-03f, 3.162277862e-03f, 2.371373819e-03f, 1.778279431e-03f, 1.333521446e-03f, 1.000000047e-03f, 7.498941850e-04f, 5.623413017e-04f, 4.216964880e-04f, 3.162277862e-04f, 2.371373848e-04f, 1.778279402e-04f, 1.333521504e-04f};
__device__ __forceinline__ float lambda_init(int l) { return l == 0 ? 0.2f : 0.35550906759096934f; }

constexpr size_t MiB = 1u << 20;
constexpr size_t WS_CTL = 0, CTL_ZERO_BYTES = 1 * MiB;
constexpr size_t WS_WIN = 2 * MiB;
constexpr size_t WS_WOUT = 18 * MiB;
constexpr size_t WS_COS = 22 * MiB, WS_SIN = 23 * MiB;
constexpr size_t WS_LAM = 24 * MiB;
constexpr size_t WS_GATES = 25 * MiB;
constexpr size_t WS_DC = 32 * MiB, WS_CST = 48 * MiB;
constexpr size_t WS_XN = 56 * MiB;
constexpr size_t WS_PROJ = 88 * MiB;
constexpr size_t WS_QC = 216 * MiB, WS_KC = 232 * MiB, WS_END = 248 * MiB;

constexpr int RING_BYTES = 131072, LDS_BYTES = 147456;

typedef unsigned short bf16;
typedef float f32x4 __attribute__((ext_vector_type(4)));
typedef unsigned v4u __attribute__((ext_vector_type(4)));
#define LAS __attribute__((address_space(3)))
__device__ __forceinline__ float bf2f(unsigned short u) { return __uint_as_float((unsigned)u << 16); }
__device__ __forceinline__ unsigned f2bf(float f) { unsigned u = __builtin_bit_cast(unsigned, f); return (u + 0x7fffu + ((u >> 16) & 1u)) >> 16; }
__device__ __forceinline__ unsigned pk2(float lo, float hi) { return f2bf(lo) | (f2bf(hi) << 16); }
__device__ __forceinline__ float wave_sum(float v) {
#pragma unroll
    for (int o = 1; o < 64; o <<= 1) v += __shfl_xor(v, o);
    return v;
}
__device__ __forceinline__ float silu_f(float x) { return x / (1.0f + __expf(-x)); }
__device__ __forceinline__ float logsigmoid_f(float x) { return fminf(x, 0.f) - log1pf(expf(-fabsf(x))); }

struct Args {
    const float* x; const float* norm_w; const float* w_in; const float* conv_w; const float* conv_b; const float* i_bias; const float* f_bias; const float* m_norm_w;
    const float* m_skip; const float* lq1; const float* lk1; const float* lq2; const float* lk2; const float* a_norm_w; const float* w_out; const float* fnw;
    float* out; unsigned char* ws; int ph_lo, ph_hi;
};

__device__ __forceinline__ int src_col(int g) {
    if (g < 1536) return g;
    if (g < 2048) return g + 8;
    if (g < 3072) { const int base = (g < 2560) ? 2056 : 2568; const int j = (g - 2048) & 511; const int grp = j >> 6, jj = j & 63; return base + grp * 64 + (jj >> 1) + 32 * (jj & 1); }
    return g + 8;
}
template <bool MAP> __device__ __forceinline__ void transpose_item(const float* W, int ldw, int K, int N, bf16* WT, LAS float* scr, int item, int lane) {
    const int nblk = N / 32, kb = item / nblk, nb = item % nblk, k0 = 64 * kb, n0 = 32 * nb;
    const int sc = MAP ? src_col(n0 + (lane & 31)) : (n0 + (lane & 31));
#pragma unroll 8
    for (int i = 0; i < 32; ++i) { const int kk = 2 * i + (lane >> 5); scr[kk * 33 + (lane & 31)] = W[(size_t)(k0 + kk) * ldw + sc]; }
    asm volatile("s_waitcnt lgkmcnt(0)" ::: "memory");
    const int c = lane & 7;
#pragma unroll
    for (int j = 0; j < 4; ++j) { const int n = (lane >> 3) + 8 * j; const LAS float* s = scr + (8 * c) * 33 + n;
        v4u o; o.x = pk2(s[0 * 33], s[1 * 33]); o.y = pk2(s[2 * 33], s[3 * 33]); o.z = pk2(s[4 * 33], s[5 * 33]); o.w = pk2(s[6 * 33], s[7 * 33]);
        *(v4u*)(WT + (size_t)(n0 + n) * K + k0 + 8 * c) = o; }
    asm volatile("s_waitcnt lgkmcnt(0)" ::: "memory");
}
__device__ __forceinline__ void sincos_acc(float xf, float& s, float& c) {
    const double x = (double)xf; const double k = __builtin_rint(x * 0.63661977236758134308);
    const double r = (x - k * 1.57079632679489655800) - k * 6.123233995736766e-17; const double r2 = r * r;
    double sp = r2 * (-1.0 / 6227020800.0) + (1.0 / 39916800.0); sp = sp * r2 - (1.0 / 362880.0); sp = sp * r2 + (1.0 / 5040.0); sp = sp * r2 - (1.0 / 120.0); sp = sp * r2 + (1.0 / 6.0); sp = r - r * r2 * sp;
    double cp = r2 * (1.0 / 87178291200.0) - (1.0 / 479001600.0); cp = cp * r2 + (1.0 / 3628800.0); cp = cp * r2 - (1.0 / 40320.0); cp = cp * r2 + (1.0 / 720.0); cp = cp * r2 - (1.0 / 24.0); cp = cp * r2 + 0.5; cp = 1.0 - r2 * cp;
    const int q = ((int)k) & 3;
    const double ss = (q == 0) ? sp : (q == 1) ? cp : (q == 2) ? -sp : -cp;
    const double cc = (q == 0) ? cp : (q == 1) ? -sp : (q == 2) ? -cp : sp;
    s = (float)ss; c = (float)cc;
}

struct Frame {
    LAS unsigned char* lds; int tid, lane, wave, vcu, G;
    unsigned char* ws;
};

__device__ __forceinline__ void phase_prologue(const Frame& F, const Args& a) {
    LAS float* scr = (LAS float*)(F.lds + F.wave * 16384);
    const int gw = F.vcu * 8 + F.wave, NGW = F.G * 8;
    constexpr int I_IN = (DMODEL / 64) * (NPROJ / 32), I_OUT = (DMODEL / 64) * (DMODEL / 32);
    constexpr int NITEMS = DEPTH * (I_IN + I_OUT);
    for (int it = gw; it < NITEMS; it += NGW) {
        int r = it; const int l = r / (I_IN + I_OUT); r -= l * (I_IN + I_OUT);
        if (r < I_IN) transpose_item<true>(a.w_in + (size_t)l * DMODEL * DIN, DIN, DMODEL, NPROJ, (bf16*)(F.ws + WS_WIN) + (size_t)l * NPROJ * DMODEL, scr, r, F.lane);
        else transpose_item<false>(a.w_out + (size_t)l * DMODEL * DMODEL, DMODEL, DMODEL, DMODEL, (bf16*)(F.ws + WS_WOUT) + (size_t)l * DMODEL * DMODEL, scr, r - I_IN, F.lane);
    }
    float* cosT = (float*)(F.ws + WS_COS); float* sinT = (float*)(F.ws + WS_SIN);
    for (int idx = (F.vcu * 512 + F.tid); idx < SEQ * 32; idx += F.G * 512) {
        const int pos = idx >> 5, i = idx & 31; const float ang = (float)pos * INVF[i]; float s, c; sincos_acc(ang, s, c); cosT[idx] = c; sinT[idx] = s;
    }
    if (F.vcu == 0 && F.wave < DEPTH) {
        const int l = F.wave;
        const float p1 = wave_sum(a.lq1[l * 64 + F.lane] * a.lk1[l * 64 + F.lane]), p2 = wave_sum(a.lq2[l * 64 + F.lane] * a.lk2[l * 64 + F.lane]);
        if (F.lane == 0) ((float*)(F.ws + WS_LAM))[l] = expf(p1) - expf(p2) + lambda_init(l);
    }
}

__device__ __forceinline__ void phase_rownorm(const Frame& F, const float* xin, const float* nw, const float* wg_src, const float* ib, const float* fb, bf16* XN, float* GATES, float* fout) {
    LAS float* WG = (LAS float*)F.lds;
    __syncthreads();
    if (wg_src) {
        for (int idx = F.tid; idx < 8192; idx += 512) { const int k = idx >> 3, g = idx & 7; WG[g * 1024 + k] = wg_src[(size_t)k * DIN + 1536 + g]; }
    }
    __syncthreads();
    const int gw = F.vcu * 8 + F.wave, NGW = F.G * 8;
    f32x4 nwv[4];
#pragma unroll
    for (int j = 0; j < 4; ++j) nwv[j] = ((const f32x4*)nw)[64 * j + F.lane];
    for (int row = gw; row < TOK; row += NGW) {
        const f32x4* xr = (const f32x4*)(xin + (size_t)row * DMODEL) + F.lane;
        f32x4 v[4]; float s = 0.f;
#pragma unroll
        for (int j = 0; j < 4; ++j) { v[j] = xr[64 * j]; s += (v[j].x * v[j].x + v[j].y * v[j].y) + (v[j].z * v[j].z + v[j].w * v[j].w); }
        const float rstd = 1.0f / sqrtf(wave_sum(s) * (1.0f / DMODEL) + EPS);
#pragma unroll
        for (int j = 0; j < 4; ++j) v[j] = v[j] * rstd * nwv[j];
        if (fout) {
            f32x4* o = (f32x4*)(fout + (size_t)row * DMODEL) + F.lane;
#pragma unroll
            for (int j = 0; j < 4; ++j) o[64 * j] = v[j];
        } else {
            unsigned long long* o8 = (unsigned long long*)(XN + (size_t)row * DMODEL) + F.lane;
#pragma unroll
            for (int j = 0; j < 4; ++j) o8[64 * j] = (unsigned long long)pk2(v[j].x, v[j].y) | ((unsigned long long)pk2(v[j].z, v[j].w) << 32);
            float gs[8];
#pragma unroll
            for (int g = 0; g < 8; ++g) { float t = 0.f;
#pragma unroll
                for (int j = 0; j < 4; ++j) { const f32x4 w = *(const LAS f32x4*)(WG + g * 1024 + 256 * j + 4 * F.lane); t += (v[j].x * w.x + v[j].y * w.y) + (v[j].z * w.z + v[j].w * w.w); }
                gs[g] = wave_sum(t); }
            float mine = gs[0];
#pragma unroll
            for (int g = 1; g < 8; ++g) mine = (F.lane == g) ? gs[g] : mine;
            if (F.lane < 4) GATES[(size_t)row * 8 + F.lane] = mine + ib[F.lane];
            else if (F.lane < 8) GATES[(size_t)row * 8 + F.lane] = logsigmoid_f(mine + fb[F.lane - 4]);
        }
    }
    __syncthreads();
}

__device__ __forceinline__ void naive_mlstm_unit(const Frame& F, const Args& a, int l, int bh) {
    const int b = bh >> 2, h = bh & 3, e = F.tid & 127; const bool act = F.tid < 128;
    LAS float* qs = (LAS float*)F.lds; LAS float* ks = qs + 128; LAS float* red = ks + 128; LAS float* red2 = red + 8;
    const bf16* PROJ = (const bf16*)(F.ws + WS_PROJ); const float* GATES = (const float*)(F.ws + WS_GATES); bf16* Y = (bf16*)(F.ws + WS_XN);
    const float* cw = a.conv_w + (size_t)l * 4 * 1024; const float* cb = a.conv_b + (size_t)l * 1024;
    const int cq = h * 128 + e, ck = 512 + h * 128 + e;
    const float wq0 = cw[cq], wq1 = cw[1024 + cq], wq2 = cw[2048 + cq], wq3 = cw[3072 + cq], bq = cb[cq];
    const float wk0 = cw[ck], wk1 = cw[1024 + ck], wk2 = cw[2048 + ck], wk3 = cw[3072 + ck], bk = cb[ck];
    const float mnw = a.m_norm_w[l * 512 + cq], msk = a.m_skip[l * 512 + cq];
    float C[128];
#pragma unroll
    for (int d = 0; d < 128; ++d) C[d] = 0.f;
    float n_e = 0.f, m = 0.f, xq1 = 0.f, xq2 = 0.f, xq3 = 0.f, xk1 = 0.f, xk2 = 0.f, xk3 = 0.f;
    for (int t = 0; t < SEQ; ++t) {
        const size_t row = (size_t)b * SEQ + t; const bf16* pr = PROJ + row * 4096;
        float qc = 0.f, ve = 0.f, mz = 0.f, a_ = 0.f, bb = 0.f;
        if (act) {
            const float xq0 = bf2f(pr[C_MQ + cq]), xk0 = bf2f(pr[C_MK + cq]); ve = bf2f(pr[C_MV + cq]); mz = bf2f(pr[C_MZ + cq]);
            const float li = GATES[row * 8 + h], lf = GATES[row * 8 + 4 + h];
            qc = silu_f(bq + wq0 * xq3 + wq1 * xq2 + wq2 * xq1 + wq3 * xq0);
            const float kc = silu_f(bk + wk0 * xk3 + wk1 * xk2 + wk2 * xk1 + wk3 * xk0) * KSCALE;
            xq3 = xq2; xq2 = xq1; xq1 = xq0; xk3 = xk2; xk2 = xk1; xk1 = xk0;
            const float m_new = fmaxf(lf + m, li); a_ = expf(lf + m - m_new); bb = expf(li - m_new); m = m_new;
            n_e = a_ * n_e + bb * kc;
            qs[e] = qc; ks[e] = kc;
            const float dp = wave_sum(n_e * qc); if (F.lane == 0) red[F.wave] = dp;
        }
        __syncthreads();
        float hval = 0.f;
        if (act) {
            const float den = red[0] + red[1]; const float bv = bb * ve; float acc = 0.f;
#pragma unroll
            for (int d = 0; d < 128; ++d) { C[d] = a_ * C[d] + bv * ks[d]; acc += C[d] * qs[d]; }
            hval = acc / fmaxf(fabsf(den), expf(-m));
            const float sq = wave_sum(hval * hval); if (F.lane == 0) red2[F.wave] = sq;
        }
        __syncthreads();
        if (act) {
            const float ssq = red2[0] + red2[1];
            const float hm = hval * (1.0f / sqrtf(ssq * (1.0f / 128.0f) + EPS)) * mnw;
            const float ym = (hm + msk * qc) * silu_f(mz);
            Y[row * 1024 + cq] = (bf16)f2bf(ym);
        }
    }
    __syncthreads();
}

__device__ __forceinline__ void naive_attn_unit(const Frame& F, const Args& a, int l, int unit) {
    const int blk = unit & 63, h = (unit >> 6) & 3, b = unit >> 8;
    const int r = F.tid & 127, map = (F.tid >> 7) & 1, half = F.tid >> 8;
    const int q0 = blk * 128, c0 = q0 >> 6, myc = c0 + (r >> 6);
    LAS float* Kf = (LAS float*)F.lds; LAS float* Vf = Kf + 64 * 128; LAS float* Cb = Kf; LAS float* red = Kf + 2 * 64 * 128;
    const bf16* PROJ = (const bf16*)(F.ws + WS_PROJ); bf16* Y = (bf16*)(F.ws + WS_XN);
    const size_t row = (size_t)b * SEQ + q0 + r;
    float q[64], o[64];
    { const bf16* qp = PROJ + row * 4096 + C_AQ + h * 128 + map * 64;
#pragma unroll
      for (int d = 0; d < 64; ++d) q[d] = bf2f(qp[d]); }
#pragma unroll
    for (int e = 0; e < 64; ++e) o[e] = 0.f;
    float m = -1e30f, lsum = 0.f;
    for (int kt = 0; kt <= c0 + 1; ++kt) {
        __syncthreads();
#pragma unroll
        for (int i = 0; i < 2; ++i) { const int id = F.tid + 512 * i, key = id >> 4, c8 = id & 15;
            const bf16* kp = PROJ + ((size_t)b * SEQ + kt * 64 + key) * 4096 + h * 128 + c8 * 8;
            const v4u kk = *(const v4u*)(kp + C_AK), vv = *(const v4u*)(kp + C_AV);
            LAS float* kd = Kf + key * 128 + c8 * 8; LAS float* vd = Vf + key * 128 + c8 * 8;
            kd[0] = __uint_as_float(kk.x << 16); kd[1] = __uint_as_float(kk.x & 0xffff0000u); kd[2] = __uint_as_float(kk.y << 16); kd[3] = __uint_as_float(kk.y & 0xffff0000u);
            kd[4] = __uint_as_float(kk.z << 16); kd[5] = __uint_as_float(kk.z & 0xffff0000u); kd[6] = __uint_as_float(kk.w << 16); kd[7] = __uint_as_float(kk.w & 0xffff0000u);
            vd[0] = __uint_as_float(vv.x << 16); vd[1] = __uint_as_float(vv.x & 0xffff0000u); vd[2] = __uint_as_float(vv.y << 16); vd[3] = __uint_as_float(vv.y & 0xffff0000u);
            vd[4] = __uint_as_float(vv.z << 16); vd[5] = __uint_as_float(vv.z & 0xffff0000u); vd[6] = __uint_as_float(vv.w << 16); vd[7] = __uint_as_float(vv.w & 0xffff0000u); }
        __syncthreads();
        if (kt <= myc) {
            for (int j = 0; j < 64; ++j) {
                const LAS float* kr = Kf + j * 128 + map * 64; const LAS float* vr = Vf + j * 128 + half * 64;
                float s = 0.f;
#pragma unroll
                for (int d = 0; d < 64; ++d) s += q[d] * kr[d];
                const float m_new = fmaxf(m, s), alpha = exp2f(m - m_new), p = exp2f(s - m_new);
                lsum = lsum * alpha + p; m = m_new;
#pragma unroll
                for (int e = 0; e < 64; ++e) o[e] = o[e] * alpha + p * vr[e];
            }
        }
    }
    __syncthreads();
    const float inv_l = 1.0f / lsum; const float lam = ((const float*)(F.ws + WS_LAM))[l];
    if (map == 1) {
#pragma unroll
        for (int e = 0; e < 64; ++e) Cb[r * 128 + half * 64 + e] = lam * o[e] * inv_l;
    }
    __syncthreads();
    float ssq = 0.f;
    if (map == 0) {
#pragma unroll
        for (int e = 0; e < 64; ++e) { o[e] = o[e] * inv_l - Cb[r * 128 + half * 64 + e]; ssq += o[e] * o[e]; }
        red[half * 128 + r] = ssq;
    }
    __syncthreads();
    if (map == 0) {
        const float rstd = 1.0f / sqrtf((red[r] + red[128 + r]) * (1.0f / 128.0f) + EPS); const float g = 1.0f - lambda_init(l);
        const bf16* azp = PROJ + row * 4096 + C_AZ + h * 128 + half * 64; bf16* yp = Y + row * 1024 + 512 + h * 128 + half * 64; const float* anw = a.a_norm_w + l * 128 + half * 64;
#pragma unroll
        for (int e = 0; e < 64; ++e) yp[e] = (bf16)f2bf(o[e] * rstd * anw[e] * g * silu_f(bf2f(azp[e])));
    }
    __syncthreads();
}

constexpr int N_PHASES = 1 + 6 * DEPTH;
#ifndef NAIVE_MIX
#define NAIVE_MIX 1
#endif
constexpr bool HAS_B12 = (NAIVE_MIX == 0);
#define PH_IN(k) (lo <= (k) && (k) < hi)
#define PH_SYNC(k) do { if (lo <= (k) && (k) + 1 < hi) cg::this_grid().sync(); } while (0)
template <int L> __device__ __forceinline__ void layer_phases(const Frame& F, const Args& a, const int lo, const int hi) {
    constexpr int base = 1 + 6 * L;
    bf16* XN = (bf16*)(a.ws + WS_XN); bf16* PROJ = (bf16*)(a.ws + WS_PROJ); float* GATES = (float*)(a.ws + WS_GATES);
    if (PH_IN(base + 0)) {
        pg8::Gemm g{XN, (const bf16*)(a.ws + WS_WIN) + (size_t)L * NPROJ * DMODEL, TOK, NPROJ, DMODEL}; pg8::StaticOrder S; S.init(TOK, NPROJ, F.G, (int)blockIdx.x);
        pg8::EpiProj E{PROJ, (const float*)(a.ws + WS_COS), (const float*)(a.ws + WS_SIN), C2};
        pg8::gemm_phase<pg8::EpiProj, pg8::StaticOrder, true, true>(F.lds, g, S, E);
    }
    PH_SYNC(base + 0);
    if (HAS_B12) { PH_SYNC(base + 1); PH_SYNC(base + 2); }
    if (PH_IN(base + 3)) {
        if (F.vcu < 8) naive_mlstm_unit(F, a, L, F.vcu);
        for (int u = F.vcu; u < 512; u += F.G) naive_attn_unit(F, a, L, u);
    }
    PH_SYNC(base + 3);
    if (PH_IN(base + 4)) {
        pg8::Gemm g{XN  , (const bf16*)(a.ws + WS_WOUT) + (size_t)L * DMODEL * DMODEL, TOK, DMODEL, DMODEL}; pg8::StaticOrder S; S.init(TOK, DMODEL, F.G, (int)blockIdx.x);
        pg8::EpiRes E{L == 0 ? a.x : a.out, a.out};
        pg8::gemm_phase<pg8::EpiRes, pg8::StaticOrder, false, true>(F.lds, g, S, E);
    }
    PH_SYNC(base + 4);
    if (PH_IN(base + 5)) {
        if (L + 1 < DEPTH) phase_rownorm(F, a.out, a.norm_w + (L + 1) * DMODEL, a.w_in + (size_t)(L + 1) * DMODEL * DIN, a.i_bias + (L + 1) * 4, a.f_bias + (L + 1) * 4, XN, GATES, nullptr);
        else phase_rownorm(F, a.out, a.fnw, nullptr, nullptr, nullptr, nullptr, nullptr, a.out);
    }
    if (L + 1 < DEPTH) PH_SYNC(base + 5);
}
__global__ void __launch_bounds__(512, 2) fwd_kernel(Args a) {
    extern __shared__ __attribute__((aligned(16))) unsigned char lds_raw[];
    Frame F; F.lds = (LAS unsigned char*)lds_raw; F.tid = threadIdx.x; F.lane = F.tid & 63; F.wave = __builtin_amdgcn_readfirstlane(F.tid >> 6);
    F.G = gridDim.x; { const int bx = blockIdx.x; F.vcu = (F.G % 8 == 0) ? (bx % 8) * (F.G / 8) + bx / 8 : bx; }
    F.ws = a.ws;
    const int lo = a.ph_lo, hi = a.ph_hi;
    if (PH_IN(0)) {
        phase_prologue(F, a);
        phase_rownorm(F, a.x, a.norm_w, a.w_in, a.i_bias, a.f_bias, (bf16*)(a.ws + WS_XN), (float*)(a.ws + WS_GATES), nullptr);
    }
    PH_SYNC(0);
    layer_phases<0>(F, a, lo, hi);
    layer_phases<1>(F, a, lo, hi);
}

extern "C" void kernel_launch(void* const* d_in, const int* in_sizes, int n_in, void* d_out, int out_size, void* d_ws, size_t ws_size, hipStream_t stream) {
    static int grid = 0;
    if (grid == 0) {
        if (n_in != 16 || in_sizes[0] != TOK * DMODEL || out_size != TOK * DMODEL || ws_size < WS_END) { fprintf(stderr, "kernel_launch: unexpected shapes (n_in %d, in0 %d, out %d, ws %zu)\n", n_in, n_in > 0 ? in_sizes[0] : -1, out_size, ws_size); grid = -1; return; }
        int dev = 0, cus = 0, per_cu = 0;
        hipGetDevice(&dev); hipDeviceGetAttribute(&cus, hipDeviceAttributeMultiprocessorCount, dev);
        if (hipFuncSetAttribute((const void*)fwd_kernel, hipFuncAttributeMaxDynamicSharedMemorySize, LDS_BYTES) != hipSuccess) { fprintf(stderr, "kernel_launch: hipFuncSetAttribute failed\n"); grid = -1; return; }
        hipOccupancyMaxActiveBlocksPerMultiprocessor(&per_cu, (const void*)fwd_kernel, 512, LDS_BYTES);
        (void)hipGetLastError();
        if (per_cu < 1) { fprintf(stderr, "kernel_launch: occupancy query says %d blocks per CU\n", per_cu); grid = -1; return; }
        grid = cus;
        if (grid != 256) fprintf(stderr, "kernel_launch: note: %d CUs\n", grid);
    }
    if (grid < 0) return;
    Args a{};
    a.x = (const float*)d_in[0]; a.norm_w = (const float*)d_in[1]; a.w_in = (const float*)d_in[2]; a.conv_w = (const float*)d_in[3]; a.conv_b = (const float*)d_in[4];
    a.i_bias = (const float*)d_in[5]; a.f_bias = (const float*)d_in[6]; a.m_norm_w = (const float*)d_in[7]; a.m_skip = (const float*)d_in[8];
    a.lq1 = (const float*)d_in[9]; a.lk1 = (const float*)d_in[10]; a.lq2 = (const float*)d_in[11]; a.lk2 = (const float*)d_in[12]; a.a_norm_w = (const float*)d_in[13];
    a.w_out = (const float*)d_in[14]; a.fnw = (const float*)d_in[15]; a.out = (float*)d_out; a.ws = (unsigned char*)d_ws;
#if MK_ONE_LAUNCH
    a.ph_lo = 0; a.ph_hi = N_PHASES;
    void* args[] = {&a};
    hipError_t e = hipLaunchCooperativeKernel((const void*)fwd_kernel, dim3(grid), dim3(512), args, LDS_BYTES, stream);
    if (e != hipSuccess) fprintf(stderr, "cooperative launch failed: %s (grid %d)\n", hipGetErrorString(e), grid);
#else
    for (int ph = 0; ph < N_PHASES; ++ph) {
        if (ph > 0) { const int s = (ph - 1) % 6; if (!HAS_B12 && (s == 1 || s == 2)) continue; }
        a.ph_lo = ph; a.ph_hi = ph + 1;
        hipLaunchKernelGGL(fwd_kernel, dim3(grid), dim3(512), LDS_BYTES, stream, a);
    }
#endif
}
```

```cpp
#include <hip/hip_runtime.h>
#include <hip/hip_cooperative_groups.h>
#include <cstdio>
#include <cstdint>
namespace cg = cooperative_groups;

#ifndef MK_ONE_LAUNCH
#define MK_ONE_LAUNCH 1
#endif

namespace pg8 {
#define PG8_LAS __attribute__((address_space(3)))
typedef unsigned short bf16_t;
typedef short bf16x8 __attribute__((ext_vector_type(8)));
typedef float f32x4 __attribute__((ext_vector_type(4)));
typedef unsigned u32x4 __attribute__((ext_vector_type(4)));
constexpr int BM = 256, BK = 64, HALF = 128, HTB = HALF * BK * 2  , STAGE_BYTES = 8 * HTB, NXCD = 8, WGM = 8;

__host__ __device__ __forceinline__ int lds_byte(int r, int c) { const int st = (r >> 4) * 2 + (c >> 5), rr = r & 15, cc = c & 31, ob = rr * 64 + cc * 2; return st * 1024 + (ob ^ (((ob >> 9) & 1) << 5)); }
__host__ __device__ __forceinline__ void stage_rc(int b, int& R, int& C) { const int st = b / 1024, sb = b % 1024, swz = sb ^ (((sb >> 9) & 1) << 5); R = (st >> 1) * 16 + swz / 64; C = (st & 1) * 32 + (swz % 64) / 2; }
__host__ __device__ __forceinline__ int perm32(int rho) { const int n = rho >> 4, i = rho & 15; return 8 * (i >> 2) + 4 * n + (i & 3); }

struct Unit { int pm, pn; };
struct Gemm { const bf16_t* A; const bf16_t* Bt; int M, N, K; };

struct StaticOrder {
    int nM, nN, nwg, G, c;
    __host__ __device__ void init(int M, int N, int G_, int c_) { nM = M / BM; nN = N / BM; nwg = nM * nN; G = G_; c = c_; }
    __host__ __device__ bool next(int i, Unit& u) const {
        const long L = (long)i * G + c; if (L >= nwg) return false;
        int wgid = (int)L; { const int q = nwg / NXCD, r = nwg % NXCD, xcd = wgid % NXCD, off = wgid / NXCD; wgid = (xcd < r ? xcd * (q + 1) : r * (q + 1) + (xcd - r) * q) + off; }
        const int nig = WGM * nN, gid = wgid / nig, fm = gid * WGM, gsz = (nM - fm) < WGM ? (nM - fm) : WGM;
        u.pm = fm + ((wgid % nig) % gsz); u.pn = (wgid % nig) / gsz; return true;
    }
    __device__ __forceinline__ void a_ready(const Unit&) const {}
    __device__ __forceinline__ void done(const Unit&) const {}
};


__device__ __forceinline__ unsigned cvt_pk_bf16(float lo, float hi) { unsigned r; asm volatile("v_cvt_pk_bf16_f32 %0, %1, %2" : "=v"(r) : "v"(lo), "v"(hi)); return r; }
typedef unsigned u32x2 __attribute__((ext_vector_type(2)));

struct EpiProj {
    static constexpr bool PERM = true, AFTER_DRAIN = false;
    bf16_t* P; const float* cosT; const float* sinT; float c2;
    __device__ __forceinline__ void operator()(const f32x4 (&acc)[2][2][4][2], const Unit& u, int wr, int wc, int fr, int fq) const {
        const int row0 = u.pm * BM + wr * 64 + fr;
        const int kind = (u.pn >= 8 && u.pn < 12) ? (u.pn < 10 ? 1 : 2) : 0;
        if (kind == 0) {
            const int col0 = u.pn * BM + wc * 32 + 8 * fq;
#pragma unroll
            for (int ai = 0; ai < 2; ++ai)
#pragma unroll
                for (int m = 0; m < 4; ++m) { bf16_t* rowp = P + (size_t)(row0 + ai * HALF + m * 16) * 4096 + col0;
#pragma unroll
                    for (int bj = 0; bj < 2; ++bj) { const f32x4 v0 = acc[ai][bj][m][0], v1 = acc[ai][bj][m][1];
                        u32x4 w; w.x = cvt_pk_bf16(v0[0], v0[1]); w.y = cvt_pk_bf16(v0[2], v0[3]); w.z = cvt_pk_bf16(v1[0], v1[1]); w.w = cvt_pk_bf16(v1[2], v1[3]);
                        *(u32x4*)(rowp + bj * HALF) = w; } }
        } else {
            const float sc = (kind == 1) ? c2 : 1.0f;
#pragma unroll
            for (int ai = 0; ai < 2; ++ai)
#pragma unroll
                for (int m = 0; m < 4; ++m) { const int row = row0 + ai * HALF + m * 16; const int pos = row & 8191;
#pragma unroll
                    for (int bj = 0; bj < 2; ++bj) { const f32x4 v0 = acc[ai][bj][m][0], v1 = acc[ai][bj][m][1];
                        const int cg_ = u.pn * BM + bj * HALF + wc * 32 + 8 * fq; const int i0 = (cg_ & 63) >> 1; const int gb = cg_ & ~63;
                        const f32x4 cs = *(const f32x4*)(cosT + pos * 32 + i0), sn = *(const f32x4*)(sinT + pos * 32 + i0);
                        const f32x4 x1 = (f32x4){v0[0], v0[2], v1[0], v1[2]}, x2 = (f32x4){v0[1], v0[3], v1[1], v1[3]};
                        const f32x4 o1 = (x1 * cs - x2 * sn) * sc, o2 = (x2 * cs + x1 * sn) * sc;
                        u32x2 w1, w2; w1.x = cvt_pk_bf16(o1[0], o1[1]); w1.y = cvt_pk_bf16(o1[2], o1[3]); w2.x = cvt_pk_bf16(o2[0], o2[1]); w2.y = cvt_pk_bf16(o2[2], o2[3]);
                        bf16_t* dst = P + (size_t)row * 4096 + gb + i0;
                        *(u32x2*)dst = w1; *(u32x2*)(dst + 32) = w2; } }
        }
    }
};
struct EpiRes {
    static constexpr bool PERM = false, AFTER_DRAIN = false;
    const float* base; float* out;
    __device__ __forceinline__ void operator()(const f32x4 (&acc)[2][2][4][2], const Unit& u, int wr, int wc, int fr, int fq) const {
        const int row0 = u.pm * BM + wr * 64 + fr, col0 = u.pn * BM + wc * 32 + 4 * fq;
#pragma unroll
        for (int ai = 0; ai < 2; ++ai)
#pragma unroll
            for (int m = 0; m < 4; ++m) { const size_t off = (size_t)(row0 + ai * HALF + m * 16) * 1024 + col0;
#pragma unroll
                for (int bj = 0; bj < 2; ++bj)
#pragma unroll
                    for (int n = 0; n < 2; ++n) { const f32x4 bs = *(const f32x4*)(base + off + bj * HALF + n * 16); *(f32x4*)(out + off + bj * HALF + n * 16) = bs + acc[ai][bj][m][n]; }
                if (m & 1) asm volatile("" ::: "memory"); }
    }
};

template <class Epi, class Sched, bool ALIGN_EPI = false, bool SP2 = false>
__device__ __forceinline__ void gemm_phase(PG8_LAS unsigned char* lds, const Gemm g, const Sched& S, const Epi& E) {
    const int tid = threadIdx.x, wid = __builtin_amdgcn_readfirstlane(tid >> 6), lane = tid & 63, wr = wid >> 2, wc = wid & 3, fr = lane & 15, fq = lane >> 4;
    const int K = g.K, nt = K / BK;
    unsigned voffA[2], voffB[2];
#pragma unroll
    for (int i = 0; i < 2; ++i) { int R, C; stage_rc(tid * 16 + i * 8192, R, C); const int Rb = Epi::PERM ? ((R & ~31) + perm32(R & 31)) : R;
        voffA[i] = (unsigned)(R * K + C) * 2u; voffB[i] = (unsigned)(Rb * K + C) * 2u; }
    const size_t kstep = (size_t)(BK * 2);
    const size_t hstep = (size_t)HALF * K * 2;
    const size_t tstep = 2 * hstep;
    const unsigned ldsw = (unsigned)wid * 1024u;
    const int aoff = lds_byte(wr * 64 + fr, fq * 8), boff = lds_byte(wc * 32 + fr, fq * 8);
#define PG8_SA(b, h) (((b) * 2 + (h)) * HTB)
#define PG8_SB(b, h) ((4 + (b) * 2 + (h)) * HTB)
#define PG8_STAGE(bufoff, gbase, voff) do { _Pragma("unroll") for (int _i = 0; _i < 2; ++_i) \
        __builtin_amdgcn_global_load_lds((const unsigned*)((const char*)(gbase) + (voff)[_i]), (PG8_LAS unsigned*)(lds + (bufoff) + ldsw + _i * 8192), 16, 0, 0); } while (0)
#define PG8_LDA(dst, b, h) do { _Pragma("unroll") for (int m = 0; m < 4; ++m) _Pragma("unroll") for (int k = 0; k < 2; ++k) dst[m][k] = *(const PG8_LAS bf16x8*)(lds + PG8_SA(b, h) + aoff + m * 2048 + k * 1024); } while (0)
#define PG8_LDB(dst, b, h) do { _Pragma("unroll") for (int n = 0; n < 2; ++n) _Pragma("unroll") for (int k = 0; k < 2; ++k) dst[n][k] = *(const PG8_LAS bf16x8*)(lds + PG8_SB(b, h) + boff + n * 2048 + k * 1024); } while (0)
#define PG8_MMA(ai, bj, At, Bt) do { __builtin_amdgcn_s_setprio(1); _Pragma("unroll") for (int m = 0; m < 4; ++m) _Pragma("unroll") for (int n = 0; n < 2; ++n) _Pragma("unroll") for (int k = 0; k < 2; ++k) \
        acc[ai][bj][m][n] = __builtin_amdgcn_mfma_f32_16x16x32_bf16(Bt[n][k], At[m][k], acc[ai][bj][m][n], 0, 0, 0); __builtin_amdgcn_s_setprio(0); } while (0)
#define PG8_WAIT_V(n) asm volatile("s_waitcnt vmcnt(" #n ")" ::: "memory")
#define PG8_WAIT_L(n) asm volatile("s_waitcnt lgkmcnt(" #n ")" ::: "memory")
#define PG8_BAR __builtin_amdgcn_s_barrier()
#define PG8_SCHED __builtin_amdgcn_sched_barrier(0)
    Unit cur, nxt; int ui = 0;
    if (!S.next(0, cur)) return;
    f32x4 acc[2][2][4][2];
#pragma unroll
    for (int a = 0; a < 2; ++a)
#pragma unroll
        for (int b = 0; b < 2; ++b)
#pragma unroll
            for (int m = 0; m < 4; ++m)
#pragma unroll
                for (int n = 0; n < 2; ++n) acc[a][b][m][n] = (f32x4){0.f, 0.f, 0.f, 0.f};
    bf16x8 At[4][2], B0[2][2], B1[2][2];
    const char* cA = (const char*)g.A + (size_t)cur.pm * tstep; const char* cB = (const char*)g.Bt + (size_t)cur.pn * tstep;
    S.a_ready(cur);
    if constexpr (SP2) {
        PG8_STAGE(PG8_SB(0, 0), cB, voffB); PG8_STAGE(PG8_SB(0, 1), cB + hstep, voffB); PG8_STAGE(PG8_SA(0, 0), cA, voffA); PG8_STAGE(PG8_SA(0, 1), cA + hstep, voffA);
        if (wr == 1) PG8_BAR;
        PG8_WAIT_V(2); PG8_BAR;
        PG8_STAGE(PG8_SB(1, 0), cB + kstep, voffB); PG8_STAGE(PG8_SA(1, 0), cA + kstep, voffA); PG8_STAGE(PG8_SB(1, 1), cB + hstep + kstep, voffB);
        PG8_WAIT_V(6); PG8_BAR;
    } else {
        PG8_STAGE(PG8_SB(0, 0), cB, voffB); PG8_STAGE(PG8_SA(0, 0), cA, voffA); PG8_STAGE(PG8_SB(0, 1), cB + hstep, voffB); PG8_STAGE(PG8_SA(0, 1), cA + hstep, voffA);
        if (wr == 1) PG8_BAR;
        PG8_WAIT_V(4); PG8_BAR;
        PG8_STAGE(PG8_SB(1, 0), cB + kstep, voffB); PG8_STAGE(PG8_SA(1, 0), cA + kstep, voffA); PG8_STAGE(PG8_SB(1, 1), cB + hstep + kstep, voffB);
        PG8_WAIT_V(6); PG8_BAR;
    }
    for (;;) {
        const bool has_next = S.next(ui + 1, nxt);
        const char* nA = has_next ? (const char*)g.A + (size_t)nxt.pm * tstep : cA; const char* nB = has_next ? (const char*)g.Bt + (size_t)nxt.pn * tstep : cB;
        for (int t = 0; t < nt; t += 2) {
            const bool last = (t == nt - 2);
            const char* a1 = cA + (size_t)(t + 1) * kstep;
            const char* a2 = last ? nA : cA + (size_t)(t + 2) * kstep; const char* b2 = last ? nB : cB + (size_t)(t + 2) * kstep;
            const char* a3 = a2 + kstep; const char* b3 = b2 + kstep;
            if (last && has_next) S.a_ready(nxt);
            if constexpr (SP2) {
            PG8_LDB(B0, 0, 0); PG8_LDB(B1, 0, 1); PG8_SCHED; PG8_LDA(At, 0, 0); PG8_STAGE(PG8_SA(1, 1), a1 + hstep, voffA);
            PG8_WAIT_V(8); PG8_WAIT_L(0); PG8_BAR; PG8_MMA(0, 0, At, B0); PG8_MMA(0, 1, At, B1); PG8_BAR; PG8_SCHED;
            PG8_LDA(At, 0, 1); PG8_STAGE(PG8_SB(0, 0), b2, voffB); PG8_STAGE(PG8_SB(0, 1), b2 + hstep, voffB); PG8_STAGE(PG8_SA(0, 0), a2, voffA);
            PG8_WAIT_V(8); PG8_WAIT_L(0); PG8_BAR; PG8_MMA(1, 0, At, B0); PG8_MMA(1, 1, At, B1); PG8_BAR; PG8_SCHED;
            PG8_LDB(B0, 1, 0); PG8_LDB(B1, 1, 1); PG8_SCHED; PG8_LDA(At, 1, 0); PG8_STAGE(PG8_SA(0, 1), a2 + hstep, voffA);
            PG8_WAIT_V(8); PG8_WAIT_L(0); PG8_BAR; PG8_MMA(0, 0, At, B0); PG8_MMA(0, 1, At, B1); PG8_BAR; PG8_SCHED;
            PG8_LDA(At, 1, 1); PG8_STAGE(PG8_SB(1, 0), b3, voffB); PG8_STAGE(PG8_SB(1, 1), b3 + hstep, voffB); PG8_STAGE(PG8_SA(1, 0), a3, voffA);
            PG8_WAIT_V(8); PG8_WAIT_L(0); PG8_BAR; PG8_MMA(1, 0, At, B0); PG8_MMA(1, 1, At, B1); PG8_BAR; PG8_SCHED;
            } else {
            PG8_LDB(B0, 0, 0); PG8_SCHED; PG8_LDA(At, 0, 0); PG8_STAGE(PG8_SA(1, 1), a1 + hstep, voffA);
            PG8_WAIT_L(8); PG8_BAR; PG8_WAIT_L(0); PG8_MMA(0, 0, At, B0); PG8_BAR; PG8_SCHED;
            PG8_LDB(B1, 0, 1); PG8_STAGE(PG8_SB(0, 0), b2, voffB);
            PG8_BAR; PG8_WAIT_L(0); PG8_MMA(0, 1, At, B1); PG8_BAR;
            PG8_LDA(At, 0, 1); PG8_STAGE(PG8_SA(0, 0), a2, voffA);
            PG8_BAR; PG8_WAIT_L(0); PG8_MMA(1, 0, At, B0); PG8_BAR; PG8_SCHED;
            PG8_STAGE(PG8_SB(0, 1), b2 + hstep, voffB);
            PG8_WAIT_V(6); PG8_BAR; PG8_MMA(1, 1, At, B1); PG8_BAR;
            PG8_LDB(B0, 1, 0); PG8_SCHED; PG8_LDA(At, 1, 0); PG8_STAGE(PG8_SA(0, 1), a2 + hstep, voffA);
            PG8_WAIT_L(8); PG8_BAR; PG8_WAIT_L(0); PG8_MMA(0, 0, At, B0); PG8_BAR; PG8_SCHED;
            PG8_LDB(B1, 1, 1); PG8_STAGE(PG8_SB(1, 0), b3, voffB);
            PG8_BAR; PG8_WAIT_L(0); PG8_MMA(0, 1, At, B1); PG8_BAR;
            PG8_LDA(At, 1, 1); PG8_STAGE(PG8_SA(1, 0), a3, voffA);
            PG8_BAR; PG8_WAIT_L(0); PG8_MMA(1, 0, At, B0); PG8_BAR; PG8_SCHED;
            PG8_STAGE(PG8_SB(1, 1), b3 + hstep, voffB);
            PG8_WAIT_V(6); PG8_BAR; PG8_MMA(1, 1, At, B1); PG8_BAR;
            }
        }
        if constexpr (ALIGN_EPI) { if (wr == 0) PG8_BAR; }
        if constexpr (!Epi::AFTER_DRAIN) { E(acc, cur, wr, wc, fr, fq); S.done(cur); }
        if (!has_next) break;
#pragma unroll
        for (int a = 0; a < 2; ++a)
#pragma unroll
            for (int b = 0; b < 2; ++b)
#pragma unroll
                for (int m = 0; m < 4; ++m)
#pragma unroll
                    for (int n = 0; n < 2; ++n) acc[a][b][m][n] = (f32x4){0.f, 0.f, 0.f, 0.f};
        cur = nxt; cA = nA; cB = nB; ++ui;
        if constexpr (ALIGN_EPI) { if (wr == 1) PG8_BAR; }
    }
    PG8_WAIT_V(0);
    if constexpr (!ALIGN_EPI) { if (wr == 0) PG8_BAR; }
    PG8_BAR;
    if constexpr (Epi::AFTER_DRAIN) { E.fused(acc, cur, wr, wc, fr, fq, lds, wid, lane); S.done(cur); }
#undef PG8_SA
#undef PG8_SB
#undef PG8_STAGE
#undef PG8_LDA
#undef PG8_LDB
#undef PG8_MMA
#undef PG8_WAIT_V
#undef PG8_WAIT_L
#undef PG8_BAR
#undef PG8_SCHED
}
}

constexpr int BATCH = 2, SEQ = 8192, DMODEL = 1024, DEPTH = 2, TOK = BATCH * SEQ;
constexpr int DIN = 4104, NPROJ = 4096;
constexpr int C_MQ = 0, C_MK = 512, C_MV = 1024, C_MZ = 1536, C_AQ = 2048, C_AK = 2560, C_AV = 3072, C_AZ = 3584;
constexpr float EPS = 1e-6f;
constexpr float C2 = 0.125f * 1.4426950408889634f;
constexpr float KSCALE = 0.08838834764831845f;
__constant__ float INVF[32] = {1.000000000e+00f, 7.498942018e-01f, 5.623413324e-01f, 4.216965139e-01f, 3.162277639e-01f, 2.371373624e-01f, 1.778279394e-01f, 1.333521456e-01f, 1.000000015e-01f, 7.498941571e-02f, 5.623412877e-02f, 4.216964915e-02f, 3.162277862e-02f, 2.371373586e-02f, 1.778279431e-02f, 1.333521493e-02f, 9.999999776e-03f, 7.498942316e-03f, 5.623413250e-03f, 4.216964822e-03f, 3.162277862e-03f, 2.371373819e-03f, 1.778279431e-03f, 1.333521446e-03f, 1.000000047e-03f, 7.498941850e-04f, 5.623413017e-04f, 4.216964880e-04f, 3.162277862e-04f, 2.371373848e-04f, 1.778279402e-04f, 1.333521504e-04f};
__device__ __forceinline__ float lambda_init(int l) { return l == 0 ? 0.2f : 0.35550906759096934f; }

constexpr size_t MiB = 1u << 20;
constexpr size_t WS_CTL = 0, CTL_ZERO_BYTES = 1 * MiB;
constexpr size_t WS_WIN = 2 * MiB;
constexpr size_t WS_WOUT = 18 * MiB;
constexpr size_t WS_COS = 22 * MiB, WS_SIN = 23 * MiB;
constexpr size_t WS_LAM = 24 * MiB;
constexpr size_t WS_GATES = 25 * MiB;
constexpr size_t WS_DC = 32 * MiB, WS_CST = 48 * MiB;
constexpr size_t WS_XN = 56 * MiB;
constexpr size_t WS_PROJ = 88 * MiB;
constexpr size_t WS_QC = 216 * MiB, WS_KC = 232 * MiB, WS_END = 248 * MiB;

constexpr int RING_BYTES = 131072, LDS_BYTES = 147456;

typedef unsigned short bf16;
typedef float f32x4 __attribute__((ext_vector_type(4)));
typedef unsigned v4u __attribute__((ext_vector_type(4)));
typedef unsigned u32x4_t __attribute__((ext_vector_type(4)));
typedef unsigned u32x2_t __attribute__((ext_vector_type(2)));
#define LAS __attribute__((address_space(3)))
__device__ __forceinline__ float bf2f(unsigned short u) { return __uint_as_float((unsigned)u << 16); }
__device__ __forceinline__ unsigned f2bf(float f) { unsigned u = __builtin_bit_cast(unsigned, f); return (u + 0x7fffu + ((u >> 16) & 1u)) >> 16; }
__device__ __forceinline__ unsigned pk2(float lo, float hi) { return f2bf(lo) | (f2bf(hi) << 16); }
__device__ __forceinline__ float wave_sum(float v) {
#pragma unroll
    for (int o = 1; o < 64; o <<= 1) v += __shfl_xor(v, o);
    return v;
}
__device__ __forceinline__ float silu_f(float x) { return x / (1.0f + __expf(-x)); }
__device__ __forceinline__ float logsigmoid_f(float x) { return fminf(x, 0.f) - log1pf(expf(-fabsf(x))); }

struct Args {
    const float* x; const float* norm_w; const float* w_in; const float* conv_w; const float* conv_b; const float* i_bias; const float* f_bias; const float* m_norm_w;
    const float* m_skip; const float* lq1; const float* lk1; const float* lq2; const float* lk2; const float* a_norm_w; const float* w_out; const float* fnw;
    float* out; unsigned char* ws; int ph_lo, ph_hi;
};

__device__ __forceinline__ int src_col(int g) {
    if (g < 1536) return g;
    if (g < 2048) return g + 8;
    if (g < 3072) { const int base = (g < 2560) ? 2056 : 2568; const int j = (g - 2048) & 511; const int grp = j >> 6, jj = j & 63; return base + grp * 64 + (jj >> 1) + 32 * (jj & 1); }
    return g + 8;
}
template <bool MAP> __device__ __forceinline__ void transpose_item(const float* W, int ldw, int K, int N, bf16* WT, LAS float* scr, int item, int lane) {
    const int nblk = N / 32, kb = item / nblk, nb = item % nblk, k0 = 64 * kb, n0 = 32 * nb;
    const int sc = MAP ? src_col(n0 + (lane & 31)) : (n0 + (lane & 31));
#pragma unroll 8
    for (int i = 0; i < 32; ++i) { const int kk = 2 * i + (lane >> 5); scr[kk * 33 + (lane & 31)] = W[(size_t)(k0 + kk) * ldw + sc]; }
    asm volatile("s_waitcnt lgkmcnt(0)" ::: "memory");
    const int c = lane & 7;
#pragma unroll
    for (int j = 0; j < 4; ++j) { const int n = (lane >> 3) + 8 * j; const LAS float* s = scr + (8 * c) * 33 + n;
        v4u o; o.x = pk2(s[0 * 33], s[1 * 33]); o.y = pk2(s[2 * 33], s[3 * 33]); o.z = pk2(s[4 * 33], s[5 * 33]); o.w = pk2(s[6 * 33], s[7 * 33]);
        *(v4u*)(WT + (size_t)(n0 + n) * K + k0 + 8 * c) = o; }
    asm volatile("s_waitcnt lgkmcnt(0)" ::: "memory");
}
__device__ __forceinline__ void sincos_acc(float xf, float& s, float& c) {
    const double x = (double)xf; const double k = __builtin_rint(x * 0.63661977236758134308);
    const double r = (x - k * 1.57079632679489655800) - k * 6.123233995736766e-17; const double r2 = r * r;
    double sp = r2 * (-1.0 / 6227020800.0) + (1.0 / 39916800.0); sp = sp * r2 - (1.0 / 362880.0); sp = sp * r2 + (1.0 / 5040.0); sp = sp * r2 - (1.0 / 120.0); sp = sp * r2 + (1.0 / 6.0); sp = r - r * r2 * sp;
    double cp = r2 * (1.0 / 87178291200.0) - (1.0 / 479001600.0); cp = cp * r2 + (1.0 / 3628800.0); cp = cp * r2 - (1.0 / 40320.0); cp = cp * r2 + (1.0 / 720.0); cp = cp * r2 - (1.0 / 24.0); cp = cp * r2 + 0.5; cp = 1.0 - r2 * cp;
    const int q = ((int)k) & 3;
    const double ss = (q == 0) ? sp : (q == 1) ? cp : (q == 2) ? -sp : -cp;
    const double cc = (q == 0) ? cp : (q == 1) ? -sp : (q == 2) ? -cp : sp;
    s = (float)ss; c = (float)cc;
}

struct Frame {
    LAS unsigned char* lds; int tid, lane, wave, vcu, G;
    unsigned char* ws;
};

__device__ __forceinline__ void phase_prologue(const Frame& F, const Args& a) {
    LAS float* scr = (LAS float*)(F.lds + F.wave * 16384);
    const int gw = F.vcu * 8 + F.wave, NGW = F.G * 8;
    constexpr int I_IN = (DMODEL / 64) * (NPROJ / 32), I_OUT = (DMODEL / 64) * (DMODEL / 32);
    constexpr int NITEMS = DEPTH * (I_IN + I_OUT);
    for (int it = gw; it < NITEMS; it += NGW) {
        int r = it; const int l = r / (I_IN + I_OUT); r -= l * (I_IN + I_OUT);
        if (r < I_IN) transpose_item<true>(a.w_in + (size_t)l * DMODEL * DIN, DIN, DMODEL, NPROJ, (bf16*)(F.ws + WS_WIN) + (size_t)l * NPROJ * DMODEL, scr, r, F.lane);
        else transpose_item<false>(a.w_out + (size_t)l * DMODEL * DMODEL, DMODEL, DMODEL, DMODEL, (bf16*)(F.ws + WS_WOUT) + (size_t)l * DMODEL * DMODEL, scr, r - I_IN, F.lane);
    }
    float* cosT = (float*)(F.ws + WS_COS); float* sinT = (float*)(F.ws + WS_SIN);
    for (int idx = (F.vcu * 512 + F.tid); idx < SEQ * 32; idx += F.G * 512) {
        const int pos = idx >> 5, i = idx & 31; const float ang = (float)pos * INVF[i]; float s, c; sincos_acc(ang, s, c); cosT[idx] = c; sinT[idx] = s;
    }
    if (F.vcu == 0 && F.wave < DEPTH) {
        const int l = F.wave;
        const float p1 = wave_sum(a.lq1[l * 64 + F.lane] * a.lk1[l * 64 + F.lane]), p2 = wave_sum(a.lq2[l * 64 + F.lane] * a.lk2[l * 64 + F.lane]);
        if (F.lane == 0) ((float*)(F.ws + WS_LAM))[l] = expf(p1) - expf(p2) + lambda_init(l);
    }
}

__device__ __forceinline__ void phase_rownorm(const Frame& F, const float* xin, const float* nw, const float* wg_src, const float* ib, const float* fb, bf16* XN, float* GATES, float* fout) {
    LAS float* WG = (LAS float*)F.lds;
    __syncthreads();
    if (wg_src) {
        for (int idx = F.tid; idx < 8192; idx += 512) { const int k = idx >> 3, g = idx & 7; WG[g * 1024 + k] = wg_src[(size_t)k * DIN + 1536 + g]; }
    }
    __syncthreads();
    const int gw = F.vcu * 8 + F.wave, NGW = F.G * 8;
    f32x4 nwv[4];
#pragma unroll
    for (int j = 0; j < 4; ++j) nwv[j] = ((const f32x4*)nw)[64 * j + F.lane];
    for (int row = gw; row < TOK; row += NGW) {
        const f32x4* xr = (const f32x4*)(xin + (size_t)row * DMODEL) + F.lane;
        f32x4 v[4]; float s = 0.f;
#pragma unroll
        for (int j = 0; j < 4; ++j) { v[j] = xr[64 * j]; s += (v[j].x * v[j].x + v[j].y * v[j].y) + (v[j].z * v[j].z + v[j].w * v[j].w); }
        const float rstd = 1.0f / sqrtf(wave_sum(s) * (1.0f / DMODEL) + EPS);
#pragma unroll
        for (int j = 0; j < 4; ++j) v[j] = v[j] * rstd * nwv[j];
        if (fout) {
            f32x4* o = (f32x4*)(fout + (size_t)row * DMODEL) + F.lane;
#pragma unroll
            for (int j = 0; j < 4; ++j) o[64 * j] = v[j];
        } else {
            unsigned long long* o8 = (unsigned long long*)(XN + (size_t)row * DMODEL) + F.lane;
#pragma unroll
            for (int j = 0; j < 4; ++j) o8[64 * j] = (unsigned long long)pk2(v[j].x, v[j].y) | ((unsigned long long)pk2(v[j].z, v[j].w) << 32);
            float gs[8];
#pragma unroll
            for (int g = 0; g < 8; ++g) { float t = 0.f;
#pragma unroll
                for (int j = 0; j < 4; ++j) { const f32x4 w = *(const LAS f32x4*)(WG + g * 1024 + 256 * j + 4 * F.lane); t += (v[j].x * w.x + v[j].y * w.y) + (v[j].z * w.z + v[j].w * w.w); }
                gs[g] = wave_sum(t); }
            float mine = gs[0];
#pragma unroll
            for (int g = 1; g < 8; ++g) mine = (F.lane == g) ? gs[g] : mine;
            if (F.lane < 4) GATES[(size_t)row * 8 + F.lane] = mine + ib[F.lane];
            else if (F.lane < 8) GATES[(size_t)row * 8 + F.lane] = logsigmoid_f(mine + fb[F.lane - 4]);
        }
    }
    __syncthreads();
}

__device__ __forceinline__ void naive_mlstm_unit(const Frame& F, const Args& a, int l, int bh) {
    const int b = bh >> 2, h = bh & 3, e = F.tid & 127; const bool act = F.tid < 128;
    LAS float* qs = (LAS float*)F.lds; LAS float* ks = qs + 128; LAS float* red = ks + 128; LAS float* red2 = red + 8;
    const bf16* PROJ = (const bf16*)(F.ws + WS_PROJ); const float* GATES = (const float*)(F.ws + WS_GATES); bf16* Y = (bf16*)(F.ws + WS_XN);
    const float* cw = a.conv_w + (size_t)l * 4 * 1024; const float* cb = a.conv_b + (size_t)l * 1024;
    const int cq = h * 128 + e, ck = 512 + h * 128 + e;
    const float wq0 = cw[cq], wq1 = cw[1024 + cq], wq2 = cw[2048 + cq], wq3 = cw[3072 + cq], bq = cb[cq];
    const float wk0 = cw[ck], wk1 = cw[1024 + ck], wk2 = cw[2048 + ck], wk3 = cw[3072 + ck], bk = cb[ck];
    const float mnw = a.m_norm_w[l * 512 + cq], msk = a.m_skip[l * 512 + cq];
    float C[128];
#pragma unroll
    for (int d = 0; d < 128; ++d) C[d] = 0.f;
    float n_e = 0.f, m = 0.f, xq1 = 0.f, xq2 = 0.f, xq3 = 0.f, xk1 = 0.f, xk2 = 0.f, xk3 = 0.f;
    for (int t = 0; t < SEQ; ++t) {
        const size_t row = (size_t)b * SEQ + t; const bf16* pr = PROJ + row * 4096;
        float qc = 0.f, ve = 0.f, mz = 0.f, a_ = 0.f, bb = 0.f;
        if (act) {
            const float xq0 = bf2f(pr[C_MQ + cq]), xk0 = bf2f(pr[C_MK + cq]); ve = bf2f(pr[C_MV + cq]); mz = bf2f(pr[C_MZ + cq]);
            const float li = GATES[row * 8 + h], lf = GATES[row * 8 + 4 + h];
            qc = silu_f(bq + wq0 * xq3 + wq1 * xq2 + wq2 * xq1 + wq3 * xq0);
            const float kc = silu_f(bk + wk0 * xk3 + wk1 * xk2 + wk2 * xk1 + wk3 * xk0) * KSCALE;
            xq3 = xq2; xq2 = xq1; xq1 = xq0; xk3 = xk2; xk2 = xk1; xk1 = xk0;
            const float m_new = fmaxf(lf + m, li); a_ = expf(lf + m - m_new); bb = expf(li - m_new); m = m_new;
            n_e = a_ * n_e + bb * kc;
            qs[e] = qc; ks[e] = kc;
            const float dp = wave_sum(n_e * qc); if (F.lane == 0) red[F.wave] = dp;
        }
        __syncthreads();
        float hval = 0.f;
        if (act) {
            const float den = red[0] + red[1]; const float bv = bb * ve; float acc = 0.f;
#pragma unroll
            for (int d = 0; d < 128; ++d) { C[d] = a_ * C[d] + bv * ks[d]; acc += C[d] * qs[d]; }
            hval = acc / fmaxf(fabsf(den), expf(-m));
            const float sq = wave_sum(hval * hval); if (F.lane == 0) red2[F.wave] = sq;
        }
        __syncthreads();
        if (act) {
            const float ssq = red2[0] + red2[1];
            const float hm = hval * (1.0f / sqrtf(ssq * (1.0f / 128.0f) + EPS)) * mnw;
            const float ym = (hm + msk * qc) * silu_f(mz);
            Y[row * 1024 + cq] = (bf16)f2bf(ym);
        }
    }
    __syncthreads();
}

__device__ __forceinline__ void naive_attn_unit(const Frame& F, const Args& a, int l, int unit) {
    const int blk = unit & 63, h = (unit >> 6) & 3, b = unit >> 8;
    const int r = F.tid & 127, map = (F.tid >> 7) & 1, half = F.tid >> 8;
    const int q0 = blk * 128, c0 = q0 >> 6, myc = c0 + (r >> 6);
    LAS float* Kf = (LAS float*)F.lds; LAS float* Vf = Kf + 64 * 128; LAS float* Cb = Kf; LAS float* red = Kf + 2 * 64 * 128;
    const bf16* PROJ = (const bf16*)(F.ws + WS_PROJ); bf16* Y = (bf16*)(F.ws + WS_XN);
    const size_t row = (size_t)b * SEQ + q0 + r;
    float q[64], o[64];
    { const bf16* qp = PROJ + row * 4096 + C_AQ + h * 128 + map * 64;
#pragma unroll
      for (int d = 0; d < 64; ++d) q[d] = bf2f(qp[d]); }
#pragma unroll
    for (int e = 0; e < 64; ++e) o[e] = 0.f;
    float m = -1e30f, lsum = 0.f;
    for (int kt = 0; kt <= c0 + 1; ++kt) {
        __syncthreads();
#pragma unroll
        for (int i = 0; i < 2; ++i) { const int id = F.tid + 512 * i, key = id >> 4, c8 = id & 15;
            const bf16* kp = PROJ + ((size_t)b * SEQ + kt * 64 + key) * 4096 + h * 128 + c8 * 8;
            const v4u kk = *(const v4u*)(kp + C_AK), vv = *(const v4u*)(kp + C_AV);
            LAS float* kd = Kf + key * 128 + c8 * 8; LAS float* vd = Vf + key * 128 + c8 * 8;
            kd[0] = __uint_as_float(kk.x << 16); kd[1] = __uint_as_float(kk.x & 0xffff0000u); kd[2] = __uint_as_float(kk.y << 16); kd[3] = __uint_as_float(kk.y & 0xffff0000u);
            kd[4] = __uint_as_float(kk.z << 16); kd[5] = __uint_as_float(kk.z & 0xffff0000u); kd[6] = __uint_as_float(kk.w << 16); kd[7] = __uint_as_float(kk.w & 0xffff0000u);
            vd[0] = __uint_as_float(vv.x << 16); vd[1] = __uint_as_float(vv.x & 0xffff0000u); vd[2] = __uint_as_float(vv.y << 16); vd[3] = __uint_as_float(vv.y & 0xffff0000u);
            vd[4] = __uint_as_float(vv.z << 16); vd[5] = __uint_as_float(vv.z & 0xffff0000u); vd[6] = __uint_as_float(vv.w << 16); vd[7] = __uint_as_float(vv.w & 0xffff0000u); }
        __syncthreads();
        if (kt <= myc) {
            for (int j = 0; j < 64; ++j) {
                const LAS float* kr = Kf + j * 128 + map * 64; const LAS float* vr = Vf + j * 128 + half * 64;
                float s = 0.f;
#pragma unroll
                for (int d = 0; d < 64; ++d) s += q[d] * kr[d];
                const float m_new = fmaxf(m, s), alpha = exp2f(m - m_new), p = exp2f(s - m_new);
                lsum = lsum * alpha + p; m = m_new;
#pragma unroll
                for (int e = 0; e < 64; ++e) o[e] = o[e] * alpha + p * vr[e];
            }
        }
    }
    __syncthreads();
    const float inv_l = 1.0f / lsum; const float lam = ((const float*)(F.ws + WS_LAM))[l];
    if (map == 1) {
#pragma unroll
        for (int e = 0; e < 64; ++e) Cb[r * 128 + half * 64 + e] = lam * o[e] * inv_l;
    }
    __syncthreads();
    float ssq = 0.f;
    if (map == 0) {
#pragma unroll
        for (int e = 0; e < 64; ++e) { o[e] = o[e] * inv_l - Cb[r * 128 + half * 64 + e]; ssq += o[e] * o[e]; }
        red[half * 128 + r] = ssq;
    }
    __syncthreads();
    if (map == 0) {
        const float rstd = 1.0f / sqrtf((red[r] + red[128 + r]) * (1.0f / 128.0f) + EPS); const float g = 1.0f - lambda_init(l);
        const bf16* azp = PROJ + row * 4096 + C_AZ + h * 128 + half * 64; bf16* yp = Y + row * 1024 + 512 + h * 128 + half * 64; const float* anw = a.a_norm_w + l * 128 + half * 64;
#pragma unroll
        for (int e = 0; e < 64; ++e) yp[e] = (bf16)f2bf(o[e] * rstd * anw[e] * g * silu_f(bf2f(azp[e])));
    }
    __syncthreads();
}

namespace att {
typedef short bf16x8 __attribute__((ext_vector_type(8)));
typedef short s16x4 __attribute__((ext_vector_type(4)));
typedef float f32x16 __attribute__((ext_vector_type(16)));
typedef float f32x2_t __attribute__((ext_vector_type(2))); typedef __bf16 bf16x2_t __attribute__((ext_vector_type(2)));
typedef short v4i16_t __attribute__((ext_vector_type(4)));
constexpr int SLOT = 16384, LDS_K = 0, LDS_V = 3 * SLOT, LDS_X = 0, LDS_S = 6 * SLOT, SPITCH = 272, LDS_END = LDS_S + 4 * 32 * SPITCH;
constexpr float THR = 8.0f;
__device__ __forceinline__ void glds16(const void* gsrc, unsigned lds_dst) { unsigned keep;
    asm volatile("s_mov_b32 %0, m0\n\ts_mov_b32 m0, %2\n\ts_nop 0\n\tglobal_load_lds_dwordx4 %1, off\n\ts_mov_b32 m0, %0" : "=&s"(keep) : "v"(gsrc), "s"(lds_dst) : "memory"); }
__device__ __forceinline__ unsigned cvtpk(float lo, float hi) { f32x2_t v = {lo, hi}; bf16x2_t b = __builtin_convertvector(v, bf16x2_t); return __builtin_bit_cast(unsigned, b); }
__device__ __forceinline__ s16x4 vtr(const LAS char* p) { return __builtin_bit_cast(s16x4, __builtin_amdgcn_ds_read_tr16_b64_v4i16((LAS v4i16_t*)p)); }
__device__ __forceinline__ float swap_max(float m) { auto rr = __builtin_amdgcn_permlane32_swap(__float_as_uint(m), __float_as_uint(m), false, false); return fmaxf(__uint_as_float(rr[0]), __uint_as_float(rr[1])); }
__device__ __forceinline__ float swap_add(float m) { auto rr = __builtin_amdgcn_permlane32_swap(__float_as_uint(m), __float_as_uint(m), false, false); return __uint_as_float(rr[0]) + __uint_as_float(rr[1]); }
#define ATT_WAIT_BAR(N) asm volatile("s_waitcnt vmcnt(" #N ") lgkmcnt(0)\n\ts_barrier" ::: "memory")

__device__ __forceinline__ void attn_unit(const Frame& F, const Args& a, const int L, const int b, const int h, const int j) {
    const int lane = F.lane, r32 = lane & 31, hi = lane >> 5, wid = F.wave, rb = wid & 3, map = wid >> 2;
    const bf16* PROJ = (const bf16*)(F.ws + WS_PROJ); bf16* Y = (bf16*)(F.ws + WS_XN);
    const size_t rowbase = (size_t)b * SEQ; const int q0 = j * 128;
    const int NT = 2 * j + 2, myNT = 2 * j + 1 + (rb >> 1);
    const unsigned lds0 = (unsigned)(uintptr_t)F.lds;
    bf16x8 qr[4];
    { const bf16* qp = PROJ + (rowbase + q0 + rb * 32 + r32) * 4096 + C_AQ + h * 128 + map * 64 + hi * 8;
#pragma unroll
      for (int d0 = 0; d0 < 4; ++d0) qr[d0] = *(const bf16x8*)(qp + d0 * 16); }
    asm volatile("s_waitcnt vmcnt(0)" ::: "memory");
    const bf16* ksrc0 = PROJ + (rowbase + lane) * 4096 + C_AK + h * 128 + wid * 8; const bf16* ksrc1 = ksrc0 + 64;
    const bf16* vsrc0 = PROJ + (rowbase + 16 * (wid & 3) + (lane >> 2)) * 4096 + C_AV + h * 128 + (wid >> 2) * 32 + (lane & 3) * 8; const bf16* vsrc1 = vsrc0 + 64;
    const unsigned kdst = lds0 + LDS_K + wid * 1024, vdst = lds0 + LDS_V + wid * 1024;
#define ATT_DMA(t, slot) do { const size_t to_ = (size_t)(t) * 64 * 4096; const unsigned so_ = (unsigned)(slot) * SLOT; \
        glds16(ksrc0 + to_, (unsigned)__builtin_amdgcn_readfirstlane(kdst + so_)); glds16(ksrc1 + to_, (unsigned)__builtin_amdgcn_readfirstlane(kdst + so_ + 8192)); \
        glds16(vsrc0 + to_, (unsigned)__builtin_amdgcn_readfirstlane(vdst + so_)); glds16(vsrc1 + to_, (unsigned)__builtin_amdgcn_readfirstlane(vdst + so_ + 8192)); } while (0)
    ATT_DMA(0, 0); ATT_DMA(1, 1);
    f32x16 o[4]; o[0] = f32x16{}; o[1] = f32x16{}; o[2] = f32x16{}; o[3] = f32x16{};
    f32x16 negm = f32x16{}; float mhat = 0.f, lsum = 0.f;
    const LAS char* kfrag = (const LAS char*)F.lds + LDS_K + map * 8192 + hi * 1024 + r32 * 16;
    const LAS char* vfrag = (const LAS char*)F.lds + LDS_V + ((lane >> 4) & 1) * 32 + (lane & 3) * 8 + (4 * hi + ((lane & 15) >> 2)) * 64;
    int slot = 0;
    for (int t = 0; t < NT; ++t) {
        if (t + 1 < NT) ATT_WAIT_BAR(4); else ATT_WAIT_BAR(0);
        if (t + 2 < NT) { const int s2 = (slot >= 1) ? slot - 1 : 2; ATT_DMA(t + 2, s2); }
        if (t < myNT) {
            const LAS char* kb = kfrag + slot * SLOT; const LAS char* vb = vfrag + slot * SLOT;
            f32x16 p0, p1;
#pragma unroll
            for (int d0 = 0; d0 < 4; ++d0) {
                const bf16x8 b0 = *(const LAS bf16x8*)(kb + d0 * 2048), b1 = *(const LAS bf16x8*)(kb + d0 * 2048 + 512);
                p0 = __builtin_amdgcn_mfma_f32_32x32x16_bf16(b0, qr[d0], d0 == 0 ? negm : p0, 0, 0, 0);
                p1 = __builtin_amdgcn_mfma_f32_32x32x16_bf16(b1, qr[d0], d0 == 0 ? negm : p1, 0, 0, 0);
            }
            float rm = fmaxf(p0[0], p1[0]);
#pragma unroll
            for (int r = 1; r < 16; ++r) rm = fmaxf(rm, fmaxf(p0[r], p1[r]));
            rm = swap_max(rm);
            if (t == 0 || __any(rm > THR)) {
                const float dl = (t == 0) ? rm : fmaxf(rm, 0.f); mhat += dl;
#pragma unroll
                for (int r = 0; r < 16; ++r) { p0[r] -= dl; p1[r] -= dl; negm[r] = -mhat; }
                const float f = exp2f(-dl); lsum *= f;
#pragma unroll
                for (int d0 = 0; d0 < 4; ++d0)
#pragma unroll
                    for (int r = 0; r < 16; ++r) o[d0][r] *= f;
            }
            float sacc = 0.f;
#pragma unroll
            for (int r = 0; r < 16; ++r) { p0[r] = __builtin_amdgcn_exp2f(p0[r]); p1[r] = __builtin_amdgcn_exp2f(p1[r]); sacc += p0[r] + p1[r]; }
            lsum += sacc;
            bf16x8 pw[4];
            { u32x4_t w0 = {cvtpk(p0[0], p0[1]), cvtpk(p0[2], p0[3]), cvtpk(p0[4], p0[5]), cvtpk(p0[6], p0[7])}; pw[0] = __builtin_bit_cast(bf16x8, w0);
              u32x4_t w1 = {cvtpk(p0[8], p0[9]), cvtpk(p0[10], p0[11]), cvtpk(p0[12], p0[13]), cvtpk(p0[14], p0[15])}; pw[1] = __builtin_bit_cast(bf16x8, w1);
              u32x4_t w2 = {cvtpk(p1[0], p1[1]), cvtpk(p1[2], p1[3]), cvtpk(p1[4], p1[5]), cvtpk(p1[6], p1[7])}; pw[2] = __builtin_bit_cast(bf16x8, w2);
              u32x4_t w3 = {cvtpk(p1[8], p1[9]), cvtpk(p1[10], p1[11]), cvtpk(p1[12], p1[13]), cvtpk(p1[14], p1[15])}; pw[3] = __builtin_bit_cast(bf16x8, w3); }
#pragma unroll
            for (int d0 = 0; d0 < 4; ++d0) {
#pragma unroll
                for (int ks = 0; ks < 4; ++ks) {
                    const s16x4 lo = vtr(vb + d0 * 4096 + ks * 1024), hh = vtr(vb + d0 * 4096 + ks * 1024 + 512);
                    const bf16x8 vf = (bf16x8){lo[0], lo[1], lo[2], lo[3], hh[0], hh[1], hh[2], hh[3]};
                    o[d0] = __builtin_amdgcn_mfma_f32_32x32x16_bf16(vf, pw[ks], o[d0], 0, 0, 0);
                }
            }
        }
        slot = (slot == 2) ? 0 : slot + 1;
    }
    const float inv = 1.0f / swap_add(lsum);
    ATT_WAIT_BAR(0);
    LAS float* X = (LAS float*)(F.lds + LDS_X) + rb * 4096 + lane;
    if (map == 1) {
        const float sc = inv * ((const float*)(F.ws + WS_LAM))[L];
#pragma unroll
        for (int d0 = 0; d0 < 4; ++d0)
#pragma unroll
            for (int r = 0; r < 16; ++r) X[(d0 * 16 + r) * 64] = o[d0][r] * sc;
    }
    ATT_WAIT_BAR(0);
    if (map == 0) {
        float ssq = 0.f;
#pragma unroll
        for (int d0 = 0; d0 < 4; ++d0)
#pragma unroll
            for (int r = 0; r < 16; ++r) { const float v = o[d0][r] * inv - X[(d0 * 16 + r) * 64]; o[d0][r] = v; ssq += v * v; }
        const float rstd = 1.0f / sqrtf(swap_add(ssq) * (1.0f / 128.0f) + EPS);
        LAS char* S = (LAS char*)F.lds + LDS_S + rb * 32 * SPITCH;
#pragma unroll
        for (int d0 = 0; d0 < 4; ++d0)
#pragma unroll
            for (int g4 = 0; g4 < 4; ++g4) { u32x2_t w; w.x = cvtpk(o[d0][4 * g4] * rstd, o[d0][4 * g4 + 1] * rstd); w.y = cvtpk(o[d0][4 * g4 + 2] * rstd, o[d0][4 * g4 + 3] * rstd);
                *(LAS u32x2_t*)(S + r32 * SPITCH + (32 * d0 + 8 * g4 + 4 * hi) * 2) = w; }
        asm volatile("s_waitcnt lgkmcnt(0)" ::: "memory");
        const int ch = lane & 15; const float g = 1.0f - lambda_init(L);
        float anw[8];
#pragma unroll
        for (int k = 0; k < 8; ++k) anw[k] = a.a_norm_w[L * 128 + 8 * ch + k] * g;
#pragma unroll
        for (int it = 0; it < 8; ++it) { const int row = it * 4 + (lane >> 4);
            const u32x4_t sv = *(const LAS u32x4_t*)(S + row * SPITCH + ch * 16);
            const size_t grow = rowbase + q0 + rb * 32 + row;
            const u32x4_t zv = *(const u32x4_t*)(PROJ + grow * 4096 + C_AZ + h * 128 + 8 * ch);
            float v[8], z[8];
#pragma unroll
            for (int k = 0; k < 4; ++k) { v[2 * k] = __uint_as_float(sv[k] << 16); v[2 * k + 1] = __uint_as_float(sv[k] & 0xffff0000u); z[2 * k] = __uint_as_float(zv[k] << 16); z[2 * k + 1] = __uint_as_float(zv[k] & 0xffff0000u); }
            u32x4_t ov;
#pragma unroll
            for (int k = 0; k < 4; ++k) ov[k] = cvtpk(v[2 * k] * anw[2 * k] * silu_f(z[2 * k]), v[2 * k + 1] * anw[2 * k + 1] * silu_f(z[2 * k + 1]));
            *(u32x4_t*)(Y + grow * 1024 + 512 + h * 128 + 8 * ch) = ov; }
    }
    ATT_WAIT_BAR(0);
#undef ATT_DMA
}
}

namespace ml {
using att::bf16x8; using att::s16x4; using att::f32x16; using att::glds16; using att::cvtpk; using att::vtr; using att::swap_add;
constexpr int NCH = 32;
constexpr float LOG2E = 1.4426950408889634f;
constexpr size_t WS_CROW = 26 * MiB, WS_BROW = WS_CROW + 256 * 1024, WS_PMROW = WS_BROW + 256 * 1024;
constexpr size_t WS_GCH = 27 * MiB, WS_BLCH = WS_GCH + 4096, WS_MST = WS_BLCH + 4096;
constexpr size_t WS_DN = 27 * MiB + 256 * 1024, WS_NST = WS_DN + 128 * 1024;
constexpr int B1_KW = 0, B1_V = 65536, B1_SC = 131072;
#define ML_WAIT_BAR(N) asm volatile("s_waitcnt vmcnt(" #N ") lgkmcnt(0)\n\ts_barrier" ::: "memory")
__device__ __forceinline__ bf16x8 trfrag(const LAS char* p) { const s16x4 lo = vtr(p), hh = vtr(p + 512); return (bf16x8){lo[0], lo[1], lo[2], lo[3], hh[0], hh[1], hh[2], hh[3]}; }
__device__ __forceinline__ void unpack8(const u32x4_t v, float (&f)[8]) {
#pragma unroll
    for (int k = 0; k < 4; ++k) { f[2 * k] = __uint_as_float(v[k] << 16); f[2 * k + 1] = __uint_as_float(v[k] & 0xffff0000u); } }

__device__ __forceinline__ void b1_unit(const Frame& F, const Args& a, const int L, const int bh, const int c) {
    const int tid = F.tid, lane = F.lane, wid = F.wave, hi = lane >> 5, r32 = lane & 31;
    const int b = bh >> 2, h = bh & 3; const size_t row0 = (size_t)b * SEQ + (size_t)c * 256;
    const bf16* PROJ = (const bf16*)(F.ws + WS_PROJ); const float* GATES = (const float*)(F.ws + WS_GATES);
    bf16* QC = (bf16*)(F.ws + WS_QC); bf16* KC = (bf16*)(F.ws + WS_KC);
    const unsigned lds0 = (unsigned)(uintptr_t)F.lds;
    LAS float* wl = (LAS float*)(F.lds + B1_SC); LAS float* wsum = wl + 256; LAS float* wmax = wsum + 8;
    { const bf16* vs = PROJ + (row0 + 16 * (wid & 3) + (lane >> 2)) * 4096 + C_MV + h * 128 + (wid >> 2) * 32 + (lane & 3) * 8; unsigned vd = lds0 + B1_V + wid * 1024;
#pragma unroll 1
      for (int i = 0; i < 4; ++i) { glds16(vs, (unsigned)__builtin_amdgcn_readfirstlane(vd)); glds16(vs + 64, (unsigned)__builtin_amdgcn_readfirstlane(vd + 8192)); vs += 64 * 4096; vd += 16384; } }
    float bl = 0.f, cl = 0.f, pm = 0.f;
    if (tid < 256) {
        const float lf = GATES[(row0 + tid) * 8 + 4 + h], li = GATES[(row0 + tid) * 8 + h];
        bl = lf;
#pragma unroll
        for (int off = 1; off < 64; off <<= 1) { const float t = __shfl_up(bl, off); if (lane >= off) bl += t; }
        if (lane == 63) wsum[wid] = bl;
    }
    __syncthreads();
    if (tid < 256) {
        float offs = 0.f;
#pragma unroll
        for (int w = 0; w < 4; ++w) offs += (w < wid) ? wsum[w] : 0.f;
        bl += offs;
        const float li = GATES[(row0 + tid) * 8 + h];
        cl = li - bl; pm = cl;
#pragma unroll
        for (int off = 1; off < 64; off <<= 1) { const float t = __shfl_up(pm, off); if (lane >= off) pm = fmaxf(pm, t); }
        if (lane == 63) wmax[wid] = pm;
    }
    __syncthreads();
    if (tid < 256) {
        float pmo = -INFINITY;
#pragma unroll
        for (int w = 0; w < 4; ++w) pmo = (w < wid) ? fmaxf(pmo, wmax[w]) : pmo;
        pm = fmaxf(pm, pmo);
        const float G = fmaxf(fmaxf(wmax[0], wmax[1]), fmaxf(wmax[2], wmax[3]));
        wl[tid] = expf(cl - G);
        float* CROW = (float*)(F.ws + WS_CROW); float* BROW = (float*)(F.ws + WS_BROW); float* PMROW = (float*)(F.ws + WS_PMROW);
        CROW[(row0 + tid) * 4 + h] = cl; BROW[(row0 + tid) * 4 + h] = bl; PMROW[(row0 + tid) * 4 + h] = pm;
        if (tid == 255) { ((float*)(F.ws + WS_GCH))[bh * NCH + c] = G; ((float*)(F.ws + WS_BLCH))[bh * NCH + c] = bl; }
    }
    __syncthreads();
    {
        const int ch8 = tid & 15, run = tid >> 4, r0 = run * 8;
        const float* cw = a.conv_w + (size_t)L * 4 * 1024; const float* cb = a.conv_b + (size_t)L * 1024;
#pragma unroll 1
        for (int which = 0; which < 2; ++which) {
            const int cch = which * 512 + h * 128 + ch8 * 8;
            const bf16* src = PROJ + row0 * 4096 + (which ? C_MK : C_MQ) + h * 128 + ch8 * 8;
            float w[4][8], bs[8];
#pragma unroll
            for (int k = 0; k < 4; ++k) { const f32x4 w0 = *(const f32x4*)(cw + k * 1024 + cch), w1 = *(const f32x4*)(cw + k * 1024 + cch + 4);
                w[k][0] = w0[0]; w[k][1] = w0[1]; w[k][2] = w0[2]; w[k][3] = w0[3]; w[k][4] = w1[0]; w[k][5] = w1[1]; w[k][6] = w1[2]; w[k][7] = w1[3]; }
            { const f32x4 b0 = *(const f32x4*)(cb + cch), b1 = *(const f32x4*)(cb + cch + 4); bs[0] = b0[0]; bs[1] = b0[1]; bs[2] = b0[2]; bs[3] = b0[3]; bs[4] = b1[0]; bs[5] = b1[1]; bs[6] = b1[2]; bs[7] = b1[3]; }
            u32x4_t xr[11];
#pragma unroll
            for (int i = 0; i < 11; ++i) { const int rr = r0 - 3 + i; xr[i] = (c > 0 || rr >= 0) ? *(const u32x4_t*)(src + (long)rr * 4096) : (u32x4_t){0u, 0u, 0u, 0u}; }
            float x0[8], x1[8], x2[8], x3[8];
            unpack8(xr[0], x0); unpack8(xr[1], x1); unpack8(xr[2], x2);
#pragma unroll
            for (int r = 0; r < 8; ++r) {
                unpack8(xr[r + 3], x3);
                float y[8];
#pragma unroll
                for (int k = 0; k < 8; ++k) { y[k] = silu_f(bs[k] + w[0][k] * x0[k] + w[1][k] * x1[k] + w[2][k] * x2[k] + w[3][k] * x3[k]); x0[k] = x1[k]; x1[k] = x2[k]; x2[k] = x3[k]; }
                const size_t orow = row0 + r0 + r;
                if (which == 0) {
                    u32x4_t o; o[0] = cvtpk(y[0], y[1]); o[1] = cvtpk(y[2], y[3]); o[2] = cvtpk(y[4], y[5]); o[3] = cvtpk(y[6], y[7]);
                    *(u32x4_t*)(QC + orow * 512 + h * 128 + ch8 * 8) = o;
                } else {
#pragma unroll
                    for (int k = 0; k < 8; ++k) y[k] *= KSCALE;
                    u32x4_t o; o[0] = cvtpk(y[0], y[1]); o[1] = cvtpk(y[2], y[3]); o[2] = cvtpk(y[4], y[5]); o[3] = cvtpk(y[6], y[7]);
                    *(u32x4_t*)(KC + orow * 512 + h * 128 + ch8 * 8) = o;
                    const int l = r0 + r; const float wv = wl[l];
                    u32x4_t ow; ow[0] = cvtpk(y[0] * wv, y[1] * wv); ow[1] = cvtpk(y[2] * wv, y[3] * wv); ow[2] = cvtpk(y[4] * wv, y[5] * wv); ow[3] = cvtpk(y[6] * wv, y[7] * wv);
                    *(LAS u32x4_t*)(F.lds + B1_KW + (l >> 6) * 16384 + ((ch8 >> 2) * 4 + ((l >> 4) & 3)) * 1024 + (l & 15) * 64 + (ch8 & 3) * 16) = ow;
                }
            }
        }
    }
    asm volatile("s_waitcnt vmcnt(0)" ::: "memory");
    __syncthreads();
    {
        const int td = wid & 3, tep = wid >> 2;
        const LAS char* fb = (const LAS char*)F.lds + ((lane >> 4) & 1) * 32 + (lane & 3) * 8 + (4 * hi + ((lane & 15) >> 2)) * 64;
        f32x16 acc0 = f32x16{}, acc1 = f32x16{}, accn = f32x16{};
        const bf16x8 ones = (bf16x8){(short)0x3f80, (short)0x3f80, (short)0x3f80, (short)0x3f80, (short)0x3f80, (short)0x3f80, (short)0x3f80, (short)0x3f80};
#pragma unroll 4
        for (int s16 = 0; s16 < 16; ++s16) { const int off = (s16 >> 2) * 16384 + (s16 & 3) * 1024;
            const bf16x8 kwf = trfrag(fb + B1_KW + off + td * 4096);
            const bf16x8 v0 = trfrag(fb + B1_V + off + (2 * tep) * 4096), v1 = trfrag(fb + B1_V + off + (2 * tep + 1) * 4096);
            acc0 = __builtin_amdgcn_mfma_f32_32x32x16_bf16(v0, kwf, acc0, 0, 0, 0);
            acc1 = __builtin_amdgcn_mfma_f32_32x32x16_bf16(v1, kwf, acc1, 0, 0, 0);
            if (tep == 0) accn = __builtin_amdgcn_mfma_f32_32x32x16_bf16(ones, kwf, accn, 0, 0, 0);
        }
        float* DCT = (float*)(F.ws + WS_DC) + (size_t)(bh * NCH + c) * 16384;
#pragma unroll
        for (int r = 0; r < 16; ++r) { const int er = (r & 3) + 8 * (r >> 2) + 4 * hi;
            DCT[(size_t)((2 * tep) * 32 + er) * 128 + td * 32 + r32] = acc0[r];
            DCT[(size_t)((2 * tep + 1) * 32 + er) * 128 + td * 32 + r32] = acc1[r]; }
        if (tep == 0 && hi == 0) ((float*)(F.ws + WS_DN))[(size_t)(bh * NCH + c) * 128 + td * 32 + r32] = accn[0];
    }
    __syncthreads();
}

__device__ __forceinline__ void b2_scan(const Frame& F) {
    const int gid = F.vcu * 512 + F.tid;
    if (gid >= 8 * 16384) return;
    const int bh = gid >> 14, el = gid & 16383;
    const float* DCT = (const float*)(F.ws + WS_DC) + (size_t)bh * NCH * 16384 + el;
    const float* G = (const float*)(F.ws + WS_GCH) + bh * NCH; const float* BL = (const float*)(F.ws + WS_BLCH) + bh * NCH;
    bf16* CST = (bf16*)(F.ws + WS_CST) + (size_t)bh * NCH * 16384 + el;
    float d[NCH];
#pragma unroll
    for (int c = 0; c < NCH; ++c) d[c] = DCT[(size_t)c * 16384];
    float dn[NCH];
    const bool has_n = el < 128;
    if (has_n) {
        const float* DN = (const float*)(F.ws + WS_DN) + (size_t)bh * NCH * 128 + el;
#pragma unroll
        for (int c = 0; c < NCH; ++c) dn[c] = DN[c * 128];
    }
    float C = 0.f, n = 0.f, m = 0.f;
    float* NST = (float*)(F.ws + WS_NST) + (size_t)bh * NCH * 128 + el; float* MST = (float*)(F.ws + WS_MST) + bh * NCH;
#pragma unroll
    for (int c = 0; c < NCH; ++c) {
        CST[(size_t)c * 16384] = (bf16)f2bf(C);
        if (has_n) NST[c * 128] = n;
        if (el == 0) MST[c] = m;
        const float g = G[c], Ml = fmaxf(m, g), ac = expf(m - Ml), gc = expf(g - Ml);
        C = ac * C + gc * d[c];
        if (has_n) n = ac * n + gc * dn[c];
        m = BL[c] + Ml;
    }
}

constexpr int B3_CT = 0, B3_NV = 32768, B3_K = 0, B3_V = 65536, B3_CL = 131072, B3_S = 0, B3_SPITCH = 272;
__device__ __forceinline__ void b3_unit(const Frame& F, const Args& a, const int L, const int bh, const int c) {
    const int tid = F.tid, lane = F.lane, wid = F.wave, hi = lane >> 5, r32 = lane & 31;
    const int b = bh >> 2, h = bh & 3; const size_t row0 = (size_t)b * SEQ + (size_t)c * 256;
    const bf16* PROJ = (const bf16*)(F.ws + WS_PROJ); const bf16* QC = (const bf16*)(F.ws + WS_QC); const bf16* KC = (const bf16*)(F.ws + WS_KC); bf16* Y = (bf16*)(F.ws + WS_XN);
    const unsigned lds0 = (unsigned)(uintptr_t)F.lds;
    const size_t myrow = row0 + wid * 32 + r32;
    bf16x8 qr[8];
#pragma unroll
    for (int s = 0; s < 8; ++s) qr[s] = *(const bf16x8*)(QC + myrow * 512 + h * 128 + 16 * s + 8 * hi);
    const float c_i = ((const float*)(F.ws + WS_CROW))[myrow * 4 + h], b_i = ((const float*)(F.ws + WS_BROW))[myrow * 4 + h], pm_i = ((const float*)(F.ws + WS_PMROW))[myrow * 4 + h];
    const float m0 = ((const float*)(F.ws + WS_MST))[bh * NCH + c];
    const float M_i = fmaxf(m0, pm_i), M2 = M_i * LOG2E, w_inter = expf(m0 - M_i);
    (void)c_i;
    LAS float* nv = (LAS float*)(F.lds + B3_NV); LAS float* cl2 = (LAS float*)(F.lds + B3_CL);
    if (tid < 128) nv[tid] = ((const float*)(F.ws + WS_NST))[(size_t)(bh * NCH + c) * 128 + tid];
    if (tid < 256) cl2[tid] = ((const float*)(F.ws + WS_CROW))[(row0 + tid) * 4 + h] * LOG2E;
    asm volatile("s_waitcnt vmcnt(0)" ::: "memory");
    { const bf16* CST = (const bf16*)(F.ws + WS_CST) + (size_t)(bh * NCH + c) * 16384;
#pragma unroll
      for (int i = 0; i < 4; ++i) { const int p = wid + 8 * i, chunk = p >> 1, g = p & 1;
          glds16(CST + (size_t)(g * 64 + lane) * 128 + chunk * 8, (unsigned)__builtin_amdgcn_readfirstlane(lds0 + B3_CT + chunk * 2048 + g * 1024)); } }
    ML_WAIT_BAR(0);
    f32x16 acc[4];
#pragma unroll
    for (int te = 0; te < 4; ++te) { acc[te] = f32x16{};
#pragma unroll
        for (int s = 0; s < 8; ++s) { const bf16x8 cf = *(const LAS bf16x8*)(F.lds + B3_CT + (2 * s + hi) * 2048 + (te * 32 + r32) * 16);
            acc[te] = __builtin_amdgcn_mfma_f32_32x32x16_bf16(cf, qr[s], acc[te], 0, 0, 0); }
        __builtin_amdgcn_sched_barrier(0); }
    float qn = 0.f;
#pragma unroll
    for (int s = 0; s < 8; ++s) { float qf[8]; unpack8(__builtin_bit_cast(u32x4_t, qr[s]), qf);
        const f32x4 n0 = *(const LAS f32x4*)(nv + 16 * s + 8 * hi), n1 = *(const LAS f32x4*)(nv + 16 * s + 8 * hi + 4);
        qn += (qf[0] * n0[0] + qf[1] * n0[1]) + (qf[2] * n0[2] + qf[3] * n0[3]) + (qf[4] * n1[0] + qf[5] * n1[1]) + (qf[6] * n1[2] + qf[7] * n1[3]); }
    qn = swap_add(qn);
    ML_WAIT_BAR(0);
    {
      const bf16* ks = KC + (row0 + (wid & 3) * 64 + lane) * 512 + h * 128 + (wid >> 2) * 8; unsigned kd = lds0 + B3_K + (wid >> 2) * 4096 + (wid & 3) * 1024;
#pragma unroll 1
      for (int i = 0; i < 8; ++i) { glds16(ks, (unsigned)__builtin_amdgcn_readfirstlane(kd)); ks += 16; kd += 8192; }
      const bf16* vs = PROJ + (row0 + 16 * (wid & 3) + (lane >> 2)) * 4096 + C_MV + h * 128 + (wid >> 2) * 32 + (lane & 3) * 8; unsigned vd = lds0 + B3_V + wid * 1024;
#pragma unroll 1
      for (int i = 0; i < 4; ++i) { glds16(vs, (unsigned)__builtin_amdgcn_readfirstlane(vd)); glds16(vs + 64, (unsigned)__builtin_amdgcn_readfirstlane(vd + 8192)); vs += 64 * 4096; vd += 16384; } }
#pragma unroll
    for (int te = 0; te < 4; ++te)
#pragma unroll
        for (int r = 0; r < 16; ++r) acc[te][r] *= w_inter;
    float rowsum = 0.f;
    ML_WAIT_BAR(0);
    const LAS char* vb = (const LAS char*)F.lds + B3_V + ((lane >> 4) & 1) * 32 + (lane & 3) * 8 + (4 * hi + ((lane & 15) >> 2)) * 64;
    for (int hf = 0; hf <= wid; ++hf) {
        f32x16 p = f32x16{};
#pragma unroll
        for (int s = 0; s < 8; ++s) { const bf16x8 kf = *(const LAS bf16x8*)(F.lds + B3_K + (2 * s + hi) * 4096 + (32 * hf + r32) * 16);
            p = __builtin_amdgcn_mfma_f32_32x32x16_bf16(kf, qr[s], p, 0, 0, 0); }
        __builtin_amdgcn_sched_barrier(0);
        const bool diag = (hf == wid);
#pragma unroll
        for (int g4 = 0; g4 < 4; ++g4) { const f32x4 cc = *(const LAS f32x4*)(cl2 + 32 * hf + 8 * g4 + 4 * hi);
#pragma unroll
            for (int i = 0; i < 4; ++i) { const int r = 4 * g4 + i; const int kl = 8 * g4 + 4 * hi + i;
                const float wgt = __builtin_amdgcn_exp2f(cc[i] - M2);
                float v = p[r] * wgt; if (diag && kl > r32) v = 0.f; p[r] = v; rowsum += v; } }
        bf16x8 pw0, pw1;
        { u32x4_t w0 = {cvtpk(p[0], p[1]), cvtpk(p[2], p[3]), cvtpk(p[4], p[5]), cvtpk(p[6], p[7])}; pw0 = __builtin_bit_cast(bf16x8, w0);
          u32x4_t w1 = {cvtpk(p[8], p[9]), cvtpk(p[10], p[11]), cvtpk(p[12], p[13]), cvtpk(p[14], p[15])}; pw1 = __builtin_bit_cast(bf16x8, w1); }
        const LAS char* vt = vb + (hf >> 1) * 16384 + (2 * (hf & 1)) * 1024;
        __builtin_amdgcn_sched_barrier(0);
#pragma unroll
        for (int te = 0; te < 4; ++te) {
            acc[te] = __builtin_amdgcn_mfma_f32_32x32x16_bf16(trfrag(vt + te * 4096), pw0, acc[te], 0, 0, 0);
            acc[te] = __builtin_amdgcn_mfma_f32_32x32x16_bf16(trfrag(vt + te * 4096 + 1024), pw1, acc[te], 0, 0, 0);
        }
        __builtin_amdgcn_sched_barrier(0);
    }
    const float den = w_inter * qn + swap_add(rowsum);
    const float hden = 1.0f / fmaxf(fabsf(den), exp2f(-(b_i * LOG2E + M2)));
    float ssq = 0.f;
#pragma unroll
    for (int te = 0; te < 4; ++te)
#pragma unroll
        for (int r = 0; r < 16; ++r) { const float v = acc[te][r] * hden; acc[te][r] = v; ssq += v * v; }
    const float rstd = 1.0f / sqrtf(swap_add(ssq) * (1.0f / 128.0f) + EPS);
    ML_WAIT_BAR(0);
    LAS char* S = (LAS char*)F.lds + B3_S + wid * 32 * B3_SPITCH;
#pragma unroll
    for (int te = 0; te < 4; ++te)
#pragma unroll
        for (int g4 = 0; g4 < 4; ++g4) { u32x2_t w; w.x = cvtpk(acc[te][4 * g4] * rstd, acc[te][4 * g4 + 1] * rstd); w.y = cvtpk(acc[te][4 * g4 + 2] * rstd, acc[te][4 * g4 + 3] * rstd);
            *(LAS u32x2_t*)(S + r32 * B3_SPITCH + (32 * te + 8 * g4 + 4 * hi) * 2) = w; }
    asm volatile("s_waitcnt lgkmcnt(0)" ::: "memory");
    { const int ch = lane & 15; float mnw[8], msk[8];
#pragma unroll
      for (int k = 0; k < 8; ++k) { mnw[k] = a.m_norm_w[L * 512 + h * 128 + 8 * ch + k]; msk[k] = a.m_skip[L * 512 + h * 128 + 8 * ch + k]; }
#pragma unroll
      for (int it = 0; it < 8; ++it) { const int row = it * 4 + (lane >> 4); const size_t grow = row0 + wid * 32 + row;
          const u32x4_t sv = *(const LAS u32x4_t*)(S + row * B3_SPITCH + ch * 16);
          const u32x4_t qv = *(const u32x4_t*)(QC + grow * 512 + h * 128 + 8 * ch), zv = *(const u32x4_t*)(PROJ + grow * 4096 + C_MZ + h * 128 + 8 * ch);
          float v[8], q[8], z[8]; unpack8(sv, v); unpack8(qv, q); unpack8(zv, z);
          u32x4_t ov;
#pragma unroll
          for (int k = 0; k < 4; ++k) ov[k] = cvtpk((v[2 * k] * mnw[2 * k] + msk[2 * k] * q[2 * k]) * silu_f(z[2 * k]), (v[2 * k + 1] * mnw[2 * k + 1] + msk[2 * k + 1] * q[2 * k + 1]) * silu_f(z[2 * k + 1]));
          *(u32x4_t*)(Y + grow * 1024 + h * 128 + 8 * ch) = ov; } }
    ML_WAIT_BAR(0);
}
}

constexpr int N_PHASES = 1 + 6 * DEPTH;
#ifndef NAIVE_MIX
#define NAIVE_MIX 0
#endif
#ifndef NAIVE_ATTN
#define NAIVE_ATTN 0
#endif
constexpr bool HAS_B12 = (NAIVE_MIX == 0);
#define PH_IN(k) (lo <= (k) && (k) < hi)
#define PH_SYNC(k) do { if (lo <= (k) && (k) + 1 < hi) cg::this_grid().sync(); } while (0)
template <int L> __device__ __forceinline__ void layer_phases(const Frame& F, const Args& a, const int lo, const int hi) {
    constexpr int base = 1 + 6 * L;
    bf16* XN = (bf16*)(a.ws + WS_XN); bf16* PROJ = (bf16*)(a.ws + WS_PROJ); float* GATES = (float*)(a.ws + WS_GATES);
    if (PH_IN(base + 0)) {
        pg8::Gemm g{XN, (const bf16*)(a.ws + WS_WIN) + (size_t)L * NPROJ * DMODEL, TOK, NPROJ, DMODEL}; pg8::StaticOrder S; S.init(TOK, NPROJ, F.G, (int)blockIdx.x);
        pg8::EpiProj E{PROJ, (const float*)(a.ws + WS_COS), (const float*)(a.ws + WS_SIN), C2};
        pg8::gemm_phase<pg8::EpiProj, pg8::StaticOrder, true, true>(F.lds, g, S, E);
    }
    PH_SYNC(base + 0);
    if (HAS_B12) {
#ifndef NO_B1
        if (PH_IN(base + 1)) { ml::b1_unit(F, a, L, F.vcu >> 5, F.vcu & 31); }
#endif
        PH_SYNC(base + 1);
#ifndef NO_B2
        if (PH_IN(base + 2)) ml::b2_scan(F);
#endif
        PH_SYNC(base + 2);
    }
    if (PH_IN(base + 3)) {
#if NAIVE_MIX
        if (F.vcu < 8) naive_mlstm_unit(F, a, L, F.vcu);
#else
#ifndef NO_B3
        ml::b3_unit(F, a, L, F.vcu >> 5, F.vcu & 31);
#endif
#endif
#if NAIVE_ATTN
        for (int u = F.vcu; u < 512; u += F.G) naive_attn_unit(F, a, L, u);
#else
        { const int bh = F.vcu >> 5, s_ = F.vcu & 31;
#ifndef NO_AT
          att::attn_unit(F, a, L, bh >> 2, bh & 3, s_);
          att::attn_unit(F, a, L, bh >> 2, bh & 3, 63 - s_);
#endif
 }
#endif
    }
    PH_SYNC(base + 3);
    if (PH_IN(base + 4)) {
        pg8::Gemm g{XN  , (const bf16*)(a.ws + WS_WOUT) + (size_t)L * DMODEL * DMODEL, TOK, DMODEL, DMODEL}; pg8::StaticOrder S; S.init(TOK, DMODEL, F.G, (int)blockIdx.x);
        pg8::EpiRes E{L == 0 ? a.x : a.out, a.out};
        pg8::gemm_phase<pg8::EpiRes, pg8::StaticOrder, false, true>(F.lds, g, S, E);
    }
    PH_SYNC(base + 4);
    if (PH_IN(base + 5)) {
        if (L + 1 < DEPTH) phase_rownorm(F, a.out, a.norm_w + (L + 1) * DMODEL, a.w_in + (size_t)(L + 1) * DMODEL * DIN, a.i_bias + (L + 1) * 4, a.f_bias + (L + 1) * 4, XN, GATES, nullptr);
        else phase_rownorm(F, a.out, a.fnw, nullptr, nullptr, nullptr, nullptr, nullptr, a.out);
    }
    if (L + 1 < DEPTH) PH_SYNC(base + 5);
}
__global__ void __launch_bounds__(512, 2) fwd_kernel(Args a) {
    extern __shared__ __attribute__((aligned(16))) unsigned char lds_raw[];
    Frame F; F.lds = (LAS unsigned char*)lds_raw; F.tid = threadIdx.x; F.lane = F.tid & 63; F.wave = __builtin_amdgcn_readfirstlane(F.tid >> 6);
    F.G = gridDim.x; { const int bx = blockIdx.x; F.vcu = (F.G % 8 == 0) ? (bx % 8) * (F.G / 8) + bx / 8 : bx; }
    F.ws = a.ws;
    const int lo = a.ph_lo, hi = a.ph_hi;
    if (PH_IN(0)) {
        phase_prologue(F, a);
        phase_rownorm(F, a.x, a.norm_w, a.w_in, a.i_bias, a.f_bias, (bf16*)(a.ws + WS_XN), (float*)(a.ws + WS_GATES), nullptr);
    }
    PH_SYNC(0);
    layer_phases<0>(F, a, lo, hi);
    layer_phases<1>(F, a, lo, hi);
}

extern "C" void kernel_launch(void* const* d_in, const int* in_sizes, int n_in, void* d_out, int out_size, void* d_ws, size_t ws_size, hipStream_t stream) {
    static int grid = 0;
    if (grid == 0) {
        if (n_in != 16 || in_sizes[0] != TOK * DMODEL || out_size != TOK * DMODEL || ws_size < WS_END) { fprintf(stderr, "kernel_launch: unexpected shapes (n_in %d, in0 %d, out %d, ws %zu)\n", n_in, n_in > 0 ? in_sizes[0] : -1, out_size, ws_size); grid = -1; return; }
        int dev = 0, cus = 0, per_cu = 0;
        hipGetDevice(&dev); hipDeviceGetAttribute(&cus, hipDeviceAttributeMultiprocessorCount, dev);
        if (hipFuncSetAttribute((const void*)fwd_kernel, hipFuncAttributeMaxDynamicSharedMemorySize, LDS_BYTES) != hipSuccess) { fprintf(stderr, "kernel_launch: hipFuncSetAttribute failed\n"); grid = -1; return; }
        hipOccupancyMaxActiveBlocksPerMultiprocessor(&per_cu, (const void*)fwd_kernel, 512, LDS_BYTES);
        (void)hipGetLastError();
        if (per_cu < 1) { fprintf(stderr, "kernel_launch: occupancy query says %d blocks per CU\n", per_cu); grid = -1; return; }
        grid = cus;
        if (grid != 256) { fprintf(stderr, "kernel_launch: this kernel's static schedules need exactly 256 CUs (got %d); nothing launched\n", grid); grid = -1; return; }
    }
    if (grid < 0) return;
    Args a{};
    a.x = (const float*)d_in[0]; a.norm_w = (const float*)d_in[1]; a.w_in = (const float*)d_in[2]; a.conv_w = (const float*)d_in[3]; a.conv_b = (const float*)d_in[4];
    a.i_bias = (const float*)d_in[5]; a.f_bias = (const float*)d_in[6]; a.m_norm_w = (const float*)d_in[7]; a.m_skip = (const float*)d_in[8];
    a.lq1 = (const float*)d_in[9]; a.lk1 = (const float*)d_in[10]; a.lq2 = (const float*)d_in[11]; a.lk2 = (const float*)d_in[12]; a.a_norm_w = (const float*)d_in[13];
    a.w_out = (const float*)d_in[14]; a.fnw = (const float*)d_in[15]; a.out = (float*)d_out; a.ws = (unsigned char*)d_ws;
#if MK_ONE_LAUNCH
    a.ph_lo = 0; a.ph_hi = N_PHASES;
    void* args[] = {&a};
    hipError_t e = hipLaunchCooperativeKernel((const void*)fwd_kernel, dim3(grid), dim3(512), args, LDS_BYTES, stream);
    if (e != hipSuccess) fprintf(stderr, "cooperative launch failed: %s (grid %d)\n", hipGetErrorString(e), grid);
#else
    for (int ph = 0; ph < N_PHASES; ++ph) {
        if (ph > 0) { const int s = (ph - 1) % 6; if (!HAS_B12 && (s == 1 || s == 2)) continue; }
        a.ph_lo = ph; a.ph_hi = ph + 1;
        hipLaunchKernelGGL(fwd_kernel, dim3(grid), dim3(512), LDS_BYTES, stream, a);
    }
#endif
}
```

```cpp
#include <hip/hip_runtime.h>
#include <hip/hip_cooperative_groups.h>
#include <cstdio>
#include <cstdint>
namespace cg = cooperative_groups;

#ifndef MK_ONE_LAUNCH
#define MK_ONE_LAUNCH 1
#endif

namespace pg8 {
#define PG8_LAS __attribute__((address_space(3)))
typedef unsigned short bf16_t;
typedef short bf16x8 __attribute__((ext_vector_type(8)));
typedef float f32x4 __attribute__((ext_vector_type(4)));
typedef unsigned u32x4 __attribute__((ext_vector_type(4)));
constexpr int BM = 256, BK = 64, HALF = 128, HTB = HALF * BK * 2  , STAGE_BYTES = 8 * HTB, NXCD = 8, WGM = 8;

__host__ __device__ __forceinline__ int lds_byte(int r, int c) { const int st = (r >> 4) * 2 + (c >> 5), rr = r & 15, cc = c & 31, ob = rr * 64 + cc * 2; return st * 1024 + (ob ^ (((ob >> 9) & 1) << 5)); }
__host__ __device__ __forceinline__ void stage_rc(int b, int& R, int& C) { const int st = b / 1024, sb = b % 1024, swz = sb ^ (((sb >> 9) & 1) << 5); R = (st >> 1) * 16 + swz / 64; C = (st & 1) * 32 + (swz % 64) / 2; }
__host__ __device__ __forceinline__ int perm32(int rho) { const int n = rho >> 4, i = rho & 15; return 8 * (i >> 2) + 4 * n + (i & 3); }

struct Unit { int pm, pn; };
struct Gemm { const bf16_t* A; const bf16_t* Bt; int M, N, K; };

struct StaticOrder {
    int nM, nN, nwg, G, c;
    __host__ __device__ void init(int M, int N, int G_, int c_) { nM = M / BM; nN = N / BM; nwg = nM * nN; G = G_; c = c_; }
    __host__ __device__ bool next(int i, Unit& u) const {
        const long L = (long)i * G + c; if (L >= nwg) return false;
        int wgid = (int)L; { const int q = nwg / NXCD, r = nwg % NXCD, xcd = wgid % NXCD, off = wgid / NXCD; wgid = (xcd < r ? xcd * (q + 1) : r * (q + 1) + (xcd - r) * q) + off; }
        const int nig = WGM * nN, gid = wgid / nig, fm = gid * WGM, gsz = (nM - fm) < WGM ? (nM - fm) : WGM;
        u.pm = fm + ((wgid % nig) % gsz); u.pn = (wgid % nig) / gsz; return true;
    }
    __device__ __forceinline__ void a_ready(const Unit&) const {}
    __device__ __forceinline__ void done(const Unit&) const {}
};


__device__ __forceinline__ unsigned cvt_pk_bf16(float lo, float hi) { unsigned r; asm volatile("v_cvt_pk_bf16_f32 %0, %1, %2" : "=v"(r) : "v"(lo), "v"(hi)); return r; }
typedef unsigned u32x2 __attribute__((ext_vector_type(2)));

struct EpiProj {
    static constexpr bool PERM = true, AFTER_DRAIN = false;
    bf16_t* P; const float* cosT; const float* sinT; float c2;
    __device__ __forceinline__ void operator()(const f32x4 (&acc)[2][2][4][2], const Unit& u, int wr, int wc, int fr, int fq) const {
        const int row0 = u.pm * BM + wr * 64 + fr;
        const int kind = (u.pn >= 8 && u.pn < 12) ? (u.pn < 10 ? 1 : 2) : 0;
        if (kind == 0) {
            const int col0 = u.pn * BM + wc * 32 + 8 * fq;
#pragma unroll
            for (int ai = 0; ai < 2; ++ai)
#pragma unroll
                for (int m = 0; m < 4; ++m) { bf16_t* rowp = P + (size_t)(row0 + ai * HALF + m * 16) * 4096 + col0;
#pragma unroll
                    for (int bj = 0; bj < 2; ++bj) { const f32x4 v0 = acc[ai][bj][m][0], v1 = acc[ai][bj][m][1];
                        u32x4 w; w.x = cvt_pk_bf16(v0[0], v0[1]); w.y = cvt_pk_bf16(v0[2], v0[3]); w.z = cvt_pk_bf16(v1[0], v1[1]); w.w = cvt_pk_bf16(v1[2], v1[3]);
                        *(u32x4*)(rowp + bj * HALF) = w; } }
        } else {
            const float sc = (kind == 1) ? c2 : 1.0f;
#pragma unroll
            for (int ai = 0; ai < 2; ++ai)
#pragma unroll
                for (int m = 0; m < 4; ++m) { const int row = row0 + ai * HALF + m * 16; const int pos = row & 8191;
#pragma unroll
                    for (int bj = 0; bj < 2; ++bj) { const f32x4 v0 = acc[ai][bj][m][0], v1 = acc[ai][bj][m][1];
                        const int cg_ = u.pn * BM + bj * HALF + wc * 32 + 8 * fq; const int i0 = (cg_ & 63) >> 1; const int gb = cg_ & ~63;
                        const f32x4 cs = *(const f32x4*)(cosT + pos * 32 + i0), sn = *(const f32x4*)(sinT + pos * 32 + i0);
                        const f32x4 x1 = (f32x4){v0[0], v0[2], v1[0], v1[2]}, x2 = (f32x4){v0[1], v0[3], v1[1], v1[3]};
                        const f32x4 o1 = (x1 * cs - x2 * sn) * sc, o2 = (x2 * cs + x1 * sn) * sc;
                        u32x2 w1, w2; w1.x = cvt_pk_bf16(o1[0], o1[1]); w1.y = cvt_pk_bf16(o1[2], o1[3]); w2.x = cvt_pk_bf16(o2[0], o2[1]); w2.y = cvt_pk_bf16(o2[2], o2[3]);
                        bf16_t* dst = P + (size_t)row * 4096 + gb + i0;
                        *(u32x2*)dst = w1; *(u32x2*)(dst + 32) = w2; } }
        }
    }
};
struct EpiRes {
    static constexpr bool PERM = false, AFTER_DRAIN = false;
    const float* base; float* out;
    __device__ __forceinline__ void operator()(const f32x4 (&acc)[2][2][4][2], const Unit& u, int wr, int wc, int fr, int fq) const {
        const int row0 = u.pm * BM + wr * 64 + fr, col0 = u.pn * BM + wc * 32 + 4 * fq;
#pragma unroll
        for (int ai = 0; ai < 2; ++ai)
#pragma unroll
            for (int m = 0; m < 4; ++m) { const size_t off = (size_t)(row0 + ai * HALF + m * 16) * 1024 + col0;
#pragma unroll
                for (int bj = 0; bj < 2; ++bj)
#pragma unroll
                    for (int n = 0; n < 2; ++n) { const f32x4 bs = *(const f32x4*)(base + off + bj * HALF + n * 16); *(f32x4*)(out + off + bj * HALF + n * 16) = bs + acc[ai][bj][m][n]; }
                if (m & 1) asm volatile("" ::: "memory"); }
    }
};

template <class Epi, class Sched, bool ALIGN_EPI = false, bool SP2 = false>
__device__ __forceinline__ void gemm_phase(PG8_LAS unsigned char* lds, const Gemm g, const Sched& S, const Epi& E) {
    const int tid = threadIdx.x, wid = __builtin_amdgcn_readfirstlane(tid >> 6), lane = tid & 63, wr = wid >> 2, wc = wid & 3, fr = lane & 15, fq = lane >> 4;
    const int K = g.K, nt = K / BK;
    unsigned voffA[2], voffB[2];
#pragma unroll
    for (int i = 0; i < 2; ++i) { int R, C; stage_rc(tid * 16 + i * 8192, R, C); const int Rb = Epi::PERM ? ((R & ~31) + perm32(R & 31)) : R;
        voffA[i] = (unsigned)(R * K + C) * 2u; voffB[i] = (unsigned)(Rb * K + C) * 2u; }
    const size_t kstep = (size_t)(BK * 2);
    const size_t hstep = (size_t)HALF * K * 2;
    const size_t tstep = 2 * hstep;
    const unsigned ldsw = (unsigned)wid * 1024u;
    const int aoff = lds_byte(wr * 64 + fr, fq * 8), boff = lds_byte(wc * 32 + fr, fq * 8);
#define PG8_SA(b, h) (((b) * 2 + (h)) * HTB)
#define PG8_SB(b, h) ((4 + (b) * 2 + (h)) * HTB)
#define PG8_STAGE(bufoff, gbase, voff) do { _Pragma("unroll") for (int _i = 0; _i < 2; ++_i) \
        __builtin_amdgcn_global_load_lds((const unsigned*)((const char*)(gbase) + (voff)[_i]), (PG8_LAS unsigned*)(lds + (bufoff) + ldsw + _i * 8192), 16, 0, 0); } while (0)
#define PG8_LDA(dst, b, h) do { _Pragma("unroll") for (int m = 0; m < 4; ++m) _Pragma("unroll") for (int k = 0; k < 2; ++k) dst[m][k] = *(const PG8_LAS bf16x8*)(lds + PG8_SA(b, h) + aoff + m * 2048 + k * 1024); } while (0)
#define PG8_LDB(dst, b, h) do { _Pragma("unroll") for (int n = 0; n < 2; ++n) _Pragma("unroll") for (int k = 0; k < 2; ++k) dst[n][k] = *(const PG8_LAS bf16x8*)(lds + PG8_SB(b, h) + boff + n * 2048 + k * 1024); } while (0)
#define PG8_MMA(ai, bj, At, Bt) do { __builtin_amdgcn_s_setprio(1); _Pragma("unroll") for (int m = 0; m < 4; ++m) _Pragma("unroll") for (int n = 0; n < 2; ++n) _Pragma("unroll") for (int k = 0; k < 2; ++k) \
        acc[ai][bj][m][n] = __builtin_amdgcn_mfma_f32_16x16x32_bf16(Bt[n][k], At[m][k], acc[ai][bj][m][n], 0, 0, 0); __builtin_amdgcn_s_setprio(0); } while (0)
#define PG8_WAIT_V(n) asm volatile("s_waitcnt vmcnt(" #n ")" ::: "memory")
#define PG8_WAIT_L(n) asm volatile("s_waitcnt lgkmcnt(" #n ")" ::: "memory")
#define PG8_BAR __builtin_amdgcn_s_barrier()
#define PG8_SCHED __builtin_amdgcn_sched_barrier(0)
    Unit cur, nxt; int ui = 0;
    if (!S.next(0, cur)) return;
    f32x4 acc[2][2][4][2];
#pragma unroll
    for (int a = 0; a < 2; ++a)
#pragma unroll
        for (int b = 0; b < 2; ++b)
#pragma unroll
            for (int m = 0; m < 4; ++m)
#pragma unroll
                for (int n = 0; n < 2; ++n) acc[a][b][m][n] = (f32x4){0.f, 0.f, 0.f, 0.f};
    bf16x8 At[4][2], B0[2][2], B1[2][2];
    const char* cA = (const char*)g.A + (size_t)cur.pm * tstep; const char* cB = (const char*)g.Bt + (size_t)cur.pn * tstep;
    S.a_ready(cur);
    if constexpr (SP2) {
        PG8_STAGE(PG8_SB(0, 0), cB, voffB); PG8_STAGE(PG8_SB(0, 1), cB + hstep, voffB); PG8_STAGE(PG8_SA(0, 0), cA, voffA); PG8_STAGE(PG8_SA(0, 1), cA + hstep, voffA);
        if (wr == 1) PG8_BAR;
        PG8_WAIT_V(2); PG8_BAR;
        PG8_STAGE(PG8_SB(1, 0), cB + kstep, voffB); PG8_STAGE(PG8_SA(1, 0), cA + kstep, voffA); PG8_STAGE(PG8_SB(1, 1), cB + hstep + kstep, voffB);
        PG8_WAIT_V(6); PG8_BAR;
    } else {
        PG8_STAGE(PG8_SB(0, 0), cB, voffB); PG8_STAGE(PG8_SA(0, 0), cA, voffA); PG8_STAGE(PG8_SB(0, 1), cB + hstep, voffB); PG8_STAGE(PG8_SA(0, 1), cA + hstep, voffA);
        if (wr == 1) PG8_BAR;
        PG8_WAIT_V(4); PG8_BAR;
        PG8_STAGE(PG8_SB(1, 0), cB + kstep, voffB); PG8_STAGE(PG8_SA(1, 0), cA + kstep, voffA); PG8_STAGE(PG8_SB(1, 1), cB + hstep + kstep, voffB);
        PG8_WAIT_V(6); PG8_BAR;
    }
    for (;;) {
        const bool has_next = S.next(ui + 1, nxt);
        const char* nA = has_next ? (const char*)g.A + (size_t)nxt.pm * tstep : cA; const char* nB = has_next ? (const char*)g.Bt + (size_t)nxt.pn * tstep : cB;
        for (int t = 0; t < nt; t += 2) {
            const bool last = (t == nt - 2);
            const char* a1 = cA + (size_t)(t + 1) * kstep;
            const char* a2 = last ? nA : cA + (size_t)(t + 2) * kstep; const char* b2 = last ? nB : cB + (size_t)(t + 2) * kstep;
            const char* a3 = a2 + kstep; const char* b3 = b2 + kstep;
            if (last && has_next) S.a_ready(nxt);
            if constexpr (SP2) {
            PG8_LDB(B0, 0, 0); PG8_LDB(B1, 0, 1); PG8_SCHED; PG8_LDA(At, 0, 0); PG8_STAGE(PG8_SA(1, 1), a1 + hstep, voffA);
            PG8_WAIT_V(8); PG8_WAIT_L(0); PG8_BAR; PG8_MMA(0, 0, At, B0); PG8_MMA(0, 1, At, B1); PG8_BAR; PG8_SCHED;
            PG8_LDA(At, 0, 1); PG8_STAGE(PG8_SB(0, 0), b2, voffB); PG8_STAGE(PG8_SB(0, 1), b2 + hstep, voffB); PG8_STAGE(PG8_SA(0, 0), a2, voffA);
            PG8_WAIT_V(8); PG8_WAIT_L(0); PG8_BAR; PG8_MMA(1, 0, At, B0); PG8_MMA(1, 1, At, B1); PG8_BAR; PG8_SCHED;
            PG8_LDB(B0, 1, 0); PG8_LDB(B1, 1, 1); PG8_SCHED; PG8_LDA(At, 1, 0); PG8_STAGE(PG8_SA(0, 1), a2 + hstep, voffA);
            PG8_WAIT_V(8); PG8_WAIT_L(0); PG8_BAR; PG8_MMA(0, 0, At, B0); PG8_MMA(0, 1, At, B1); PG8_BAR; PG8_SCHED;
            PG8_LDA(At, 1, 1); PG8_STAGE(PG8_SB(1, 0), b3, voffB); PG8_STAGE(PG8_SB(1, 1), b3 + hstep, voffB); PG8_STAGE(PG8_SA(1, 0), a3, voffA);
            PG8_WAIT_V(8); PG8_WAIT_L(0); PG8_BAR; PG8_MMA(1, 0, At, B0); PG8_MMA(1, 1, At, B1); PG8_BAR; PG8_SCHED;
            } else {
            PG8_LDB(B0, 0, 0); PG8_SCHED; PG8_LDA(At, 0, 0); PG8_STAGE(PG8_SA(1, 1), a1 + hstep, voffA);
            PG8_WAIT_L(8); PG8_BAR; PG8_WAIT_L(0); PG8_MMA(0, 0, At, B0); PG8_BAR; PG8_SCHED;
            PG8_LDB(B1, 0, 1); PG8_STAGE(PG8_SB(0, 0), b2, voffB);
            PG8_BAR; PG8_WAIT_L(0); PG8_MMA(0, 1, At, B1); PG8_BAR;
            PG8_LDA(At, 0, 1); PG8_STAGE(PG8_SA(0, 0), a2, voffA);
            PG8_BAR; PG8_WAIT_L(0); PG8_MMA(1, 0, At, B0); PG8_BAR; PG8_SCHED;
            PG8_STAGE(PG8_SB(0, 1), b2 + hstep, voffB);
            PG8_WAIT_V(6); PG8_BAR; PG8_MMA(1, 1, At, B1); PG8_BAR;
            PG8_LDB(B0, 1, 0); PG8_SCHED; PG8_LDA(At, 1, 0); PG8_STAGE(PG8_SA(0, 1), a2 + hstep, voffA);
            PG8_WAIT_L(8); PG8_BAR; PG8_WAIT_L(0); PG8_MMA(0, 0, At, B0); PG8_BAR; PG8_SCHED;
            PG8_LDB(B1, 1, 1); PG8_STAGE(PG8_SB(1, 0), b3, voffB);
            PG8_BAR; PG8_WAIT_L(0); PG8_MMA(0, 1, At, B1); PG8_BAR;
            PG8_LDA(At, 1, 1); PG8_STAGE(PG8_SA(1, 0), a3, voffA);
            PG8_BAR; PG8_WAIT_L(0); PG8_MMA(1, 0, At, B0); PG8_BAR; PG8_SCHED;
            PG8_STAGE(PG8_SB(1, 1), b3 + hstep, voffB);
            PG8_WAIT_V(6); PG8_BAR; PG8_MMA(1, 1, At, B1); PG8_BAR;
            }
        }
        if constexpr (ALIGN_EPI) { if (wr == 0) PG8_BAR; }
        if constexpr (!Epi::AFTER_DRAIN) { E(acc, cur, wr, wc, fr, fq); S.done(cur); }
        if (!has_next) break;
#pragma unroll
        for (int a = 0; a < 2; ++a)
#pragma unroll
            for (int b = 0; b < 2; ++b)
#pragma unroll
                for (int m = 0; m < 4; ++m)
#pragma unroll
                    for (int n = 0; n < 2; ++n) acc[a][b][m][n] = (f32x4){0.f, 0.f, 0.f, 0.f};
        cur = nxt; cA = nA; cB = nB; ++ui;
        if constexpr (ALIGN_EPI) { if (wr == 1) PG8_BAR; }
    }
    PG8_WAIT_V(0);
    if constexpr (!ALIGN_EPI) { if (wr == 0) PG8_BAR; }
    PG8_BAR;
    if constexpr (Epi::AFTER_DRAIN) { E.fused(acc, cur, wr, wc, fr, fq, lds, wid, lane); S.done(cur); }
#undef PG8_SA
#undef PG8_SB
#undef PG8_STAGE
#undef PG8_LDA
#undef PG8_LDB
#undef PG8_MMA
#undef PG8_WAIT_V
#undef PG8_WAIT_L
#undef PG8_BAR
#undef PG8_SCHED
}
}

constexpr int BATCH = 2, SEQ = 8192, DMODEL = 1024, DEPTH = 2, TOK = BATCH * SEQ;
constexpr int DIN = 4104, NPROJ = 4096;
constexpr int C_MQ = 0, C_MK = 512, C_MV = 1024, C_MZ = 1536, C_AQ = 2048, C_AK = 2560, C_AV = 3072, C_AZ = 3584;
constexpr float EPS = 1e-6f;
constexpr float C2 = 0.125f * 1.4426950408889634f;
constexpr float KSCALE = 0.08838834764831845f;
__constant__ float INVF[32] = {1.000000000e+00f, 7.498942018e-01f, 5.623413324e-01f, 4.216965139e-01f, 3.162277639e-01f, 2.371373624e-01f, 1.778279394e-01f, 1.333521456e-01f, 1.000000015e-01f, 7.498941571e-02f, 5.623412877e-02f, 4.216964915e-02f, 3.162277862e-02f, 2.371373586e-02f, 1.778279431e-02f, 1.333521493e-02f, 9.999999776e-03f, 7.498942316e-03f, 5.623413250e-03f, 4.216964822e-03f, 3.162277862e-03f, 2.371373819e-03f, 1.778279431e-03f, 1.333521446e-03f, 1.000000047e-03f, 7.498941850e-04f, 5.623413017e-04f, 4.216964880e-04f, 3.162277862e-04f, 2.371373848e-04f, 1.778279402e-04f, 1.333521504e-04f};
__device__ __forceinline__ float lambda_init(int l) { return l == 0 ? 0.2f : 0.35550906759096934f; }

constexpr size_t MiB = 1u << 20;
constexpr size_t WS_CTL = 0, CTL_ZERO_BYTES = 1 * MiB;
constexpr size_t WS_WIN = 2 * MiB;
constexpr size_t WS_WOUT = 18 * MiB;
constexpr size_t WS_COS = 22 * MiB, WS_SIN = 23 * MiB;
constexpr size_t WS_LAM = 24 * MiB;
constexpr size_t WS_GATES = 25 * MiB;
constexpr size_t WS_DC = 32 * MiB, WS_CST = 48 * MiB;
constexpr size_t WS_XN = 56 * MiB;
constexpr size_t WS_PROJ = 88 * MiB;
constexpr size_t WS_QC = 216 * MiB, WS_KC = 232 * MiB, WS_END = 248 * MiB;

constexpr int RING_BYTES = 131072, LDS_BYTES = 147456, MISC_OFF = 147200;

typedef unsigned short bf16;
typedef float f32x4 __attribute__((ext_vector_type(4)));
typedef unsigned v4u __attribute__((ext_vector_type(4)));
typedef unsigned u32x4_t __attribute__((ext_vector_type(4)));
typedef unsigned u32x2_t __attribute__((ext_vector_type(2)));
#define LAS __attribute__((address_space(3)))
__device__ __forceinline__ float bf2f(unsigned short u) { return __uint_as_float((unsigned)u << 16); }
__device__ __forceinline__ unsigned f2bf(float f) { unsigned u = __builtin_bit_cast(unsigned, f); return (u + 0x7fffu + ((u >> 16) & 1u)) >> 16; }
__device__ __forceinline__ unsigned pk2(float lo, float hi) { return f2bf(lo) | (f2bf(hi) << 16); }
__device__ __forceinline__ float wave_sum(float v) {
#pragma unroll
    for (int o = 1; o < 64; o <<= 1) v += __shfl_xor(v, o);
    return v;
}
__device__ __forceinline__ float silu_f(float x) { return x / (1.0f + __expf(-x)); }
__device__ __forceinline__ float logsigmoid_f(float x) { return fminf(x, 0.f) - log1pf(expf(-fabsf(x))); }

struct Args {
    const float* x; const float* norm_w; const float* w_in; const float* conv_w; const float* conv_b; const float* i_bias; const float* f_bias; const float* m_norm_w;
    const float* m_skip; const float* lq1; const float* lk1; const float* lq2; const float* lk2; const float* a_norm_w; const float* w_out; const float* fnw;
    float* out; unsigned char* ws; int ph_lo, ph_hi;
};

__device__ __forceinline__ int src_col(int g) {
    if (g < 1536) return g;
    if (g < 2048) return g + 8;
    if (g < 3072) { const int base = (g < 2560) ? 2056 : 2568; const int j = (g - 2048) & 511; const int grp = j >> 6, jj = j & 63; return base + grp * 64 + (jj >> 1) + 32 * (jj & 1); }
    return g + 8;
}
template <bool MAP> __device__ __forceinline__ void transpose_item(const float* W, int ldw, int K, int N, bf16* WT, LAS float* scr, int item, int lane) {
    const int nblk = N / 32, kb = item / nblk, nb = item % nblk, k0 = 64 * kb, n0 = 32 * nb;
    const int sc = MAP ? src_col(n0 + (lane & 31)) : (n0 + (lane & 31));
#pragma unroll 8
    for (int i = 0; i < 32; ++i) { const int kk = 2 * i + (lane >> 5); scr[kk * 33 + (lane & 31)] = W[(size_t)(k0 + kk) * ldw + sc]; }
    asm volatile("s_waitcnt lgkmcnt(0)" ::: "memory");
    const int c = lane & 7;
#pragma unroll
    for (int j = 0; j < 4; ++j) { const int n = (lane >> 3) + 8 * j; const LAS float* s = scr + (8 * c) * 33 + n;
        v4u o; o.x = pk2(s[0 * 33], s[1 * 33]); o.y = pk2(s[2 * 33], s[3 * 33]); o.z = pk2(s[4 * 33], s[5 * 33]); o.w = pk2(s[6 * 33], s[7 * 33]);
        *(v4u*)(WT + (size_t)(n0 + n) * K + k0 + 8 * c) = o; }
    asm volatile("s_waitcnt lgkmcnt(0)" ::: "memory");
}
__device__ __forceinline__ void sincos_acc(float xf, float& s, float& c) {
    const double x = (double)xf; const double k = __builtin_rint(x * 0.63661977236758134308);
    const double r = (x - k * 1.57079632679489655800) - k * 6.123233995736766e-17; const double r2 = r * r;
    double sp = r2 * (-1.0 / 6227020800.0) + (1.0 / 39916800.0); sp = sp * r2 - (1.0 / 362880.0); sp = sp * r2 + (1.0 / 5040.0); sp = sp * r2 - (1.0 / 120.0); sp = sp * r2 + (1.0 / 6.0); sp = r - r * r2 * sp;
    double cp = r2 * (1.0 / 87178291200.0) - (1.0 / 479001600.0); cp = cp * r2 + (1.0 / 3628800.0); cp = cp * r2 - (1.0 / 40320.0); cp = cp * r2 + (1.0 / 720.0); cp = cp * r2 - (1.0 / 24.0); cp = cp * r2 + 0.5; cp = 1.0 - r2 * cp;
    const int q = ((int)k) & 3;
    const double ss = (q == 0) ? sp : (q == 1) ? cp : (q == 2) ? -sp : -cp;
    const double cc = (q == 0) ? cp : (q == 1) ? -sp : (q == 2) ? -cp : sp;
    s = (float)ss; c = (float)cc;
}

struct Frame {
    LAS unsigned char* lds; int tid, lane, wave, vcu, G;
    unsigned char* ws;
};

__device__ __forceinline__ void phase_prologue(const Frame& F, const Args& a) {
    LAS float* scr = (LAS float*)(F.lds + F.wave * 16384);
    const int gw = F.vcu * 8 + F.wave, NGW = F.G * 8;
    constexpr int I_IN = (DMODEL / 64) * (NPROJ / 32), I_OUT = (DMODEL / 64) * (DMODEL / 32);
    constexpr int NITEMS = DEPTH * (I_IN + I_OUT);
    for (int it = gw; it < NITEMS; it += NGW) {
        int r = it; const int l = r / (I_IN + I_OUT); r -= l * (I_IN + I_OUT);
        if (r < I_IN) transpose_item<true>(a.w_in + (size_t)l * DMODEL * DIN, DIN, DMODEL, NPROJ, (bf16*)(F.ws + WS_WIN) + (size_t)l * NPROJ * DMODEL, scr, r, F.lane);
        else transpose_item<false>(a.w_out + (size_t)l * DMODEL * DMODEL, DMODEL, DMODEL, DMODEL, (bf16*)(F.ws + WS_WOUT) + (size_t)l * DMODEL * DMODEL, scr, r - I_IN, F.lane);
    }
    float* cosT = (float*)(F.ws + WS_COS); float* sinT = (float*)(F.ws + WS_SIN);
    for (int idx = (F.vcu * 512 + F.tid); idx < SEQ * 32; idx += F.G * 512) {
        const int pos = idx >> 5, i = idx & 31; const float ang = (float)pos * INVF[i]; float s, c; sincos_acc(ang, s, c); cosT[idx] = c; sinT[idx] = s;
    }
    if (F.vcu == 0 && F.wave < DEPTH) {
        const int l = F.wave;
        const float p1 = wave_sum(a.lq1[l * 64 + F.lane] * a.lk1[l * 64 + F.lane]), p2 = wave_sum(a.lq2[l * 64 + F.lane] * a.lk2[l * 64 + F.lane]);
        if (F.lane == 0) ((float*)(F.ws + WS_LAM))[l] = expf(p1) - expf(p2) + lambda_init(l);
    }
}

__device__ __forceinline__ void phase_rownorm(const Frame& F, const float* xin, const float* nw, const float* wg_src, const float* ib, const float* fb, bf16* XN, float* GATES, float* fout) {
    LAS float* WG = (LAS float*)F.lds;
    __syncthreads();
    if (wg_src) {
        for (int idx = F.tid; idx < 8192; idx += 512) { const int k = idx >> 3, g = idx & 7; WG[g * 1024 + k] = wg_src[(size_t)k * DIN + 1536 + g]; }
    }
    __syncthreads();
    const int gw = F.vcu * 8 + F.wave, NGW = F.G * 8;
    f32x4 nwv[4];
#pragma unroll
    for (int j = 0; j < 4; ++j) nwv[j] = ((const f32x4*)nw)[64 * j + F.lane];
    for (int row = gw; row < TOK; row += NGW) {
        const f32x4* xr = (const f32x4*)(xin + (size_t)row * DMODEL) + F.lane;
        f32x4 v[4]; float s = 0.f;
#pragma unroll
        for (int j = 0; j < 4; ++j) { v[j] = xr[64 * j]; s += (v[j].x * v[j].x + v[j].y * v[j].y) + (v[j].z * v[j].z + v[j].w * v[j].w); }
        const float rstd = 1.0f / sqrtf(wave_sum(s) * (1.0f / DMODEL) + EPS);
#pragma unroll
        for (int j = 0; j < 4; ++j) v[j] = v[j] * rstd * nwv[j];
        if (fout) {
            f32x4* o = (f32x4*)(fout + (size_t)row * DMODEL) + F.lane;
#pragma unroll
            for (int j = 0; j < 4; ++j) o[64 * j] = v[j];
        } else {
            unsigned long long* o8 = (unsigned long long*)(XN + (size_t)row * DMODEL) + F.lane;
#pragma unroll
            for (int j = 0; j < 4; ++j) o8[64 * j] = (unsigned long long)pk2(v[j].x, v[j].y) | ((unsigned long long)pk2(v[j].z, v[j].w) << 32);
            float gs[8];
#pragma unroll
            for (int g = 0; g < 8; ++g) { float t = 0.f;
#pragma unroll
                for (int j = 0; j < 4; ++j) { const f32x4 w = *(const LAS f32x4*)(WG + g * 1024 + 256 * j + 4 * F.lane); t += (v[j].x * w.x + v[j].y * w.y) + (v[j].z * w.z + v[j].w * w.w); }
                gs[g] = wave_sum(t); }
            float mine = gs[0];
#pragma unroll
            for (int g = 1; g < 8; ++g) mine = (F.lane == g) ? gs[g] : mine;
            if (F.lane < 4) GATES[(size_t)row * 8 + F.lane] = mine + ib[F.lane];
            else if (F.lane < 8) GATES[(size_t)row * 8 + F.lane] = logsigmoid_f(mine + fb[F.lane - 4]);
        }
    }
    __syncthreads();
}

__device__ __forceinline__ void naive_mlstm_unit(const Frame& F, const Args& a, int l, int bh) {
    const int b = bh >> 2, h = bh & 3, e = F.tid & 127; const bool act = F.tid < 128;
    LAS float* qs = (LAS float*)F.lds; LAS float* ks = qs + 128; LAS float* red = ks + 128; LAS float* red2 = red + 8;
    const bf16* PROJ = (const bf16*)(F.ws + WS_PROJ); const float* GATES = (const float*)(F.ws + WS_GATES); bf16* Y = (bf16*)(F.ws + WS_XN);
    const float* cw = a.conv_w + (size_t)l * 4 * 1024; const float* cb = a.conv_b + (size_t)l * 1024;
    const int cq = h * 128 + e, ck = 512 + h * 128 + e;
    const float wq0 = cw[cq], wq1 = cw[1024 + cq], wq2 = cw[2048 + cq], wq3 = cw[3072 + cq], bq = cb[cq];
    const float wk0 = cw[ck], wk1 = cw[1024 + ck], wk2 = cw[2048 + ck], wk3 = cw[3072 + ck], bk = cb[ck];
    const float mnw = a.m_norm_w[l * 512 + cq], msk = a.m_skip[l * 512 + cq];
    float C[128];
#pragma unroll
    for (int d = 0; d < 128; ++d) C[d] = 0.f;
    float n_e = 0.f, m = 0.f, xq1 = 0.f, xq2 = 0.f, xq3 = 0.f, xk1 = 0.f, xk2 = 0.f, xk3 = 0.f;
    for (int t = 0; t < SEQ; ++t) {
        const size_t row = (size_t)b * SEQ + t; const bf16* pr = PROJ + row * 4096;
        float qc = 0.f, ve = 0.f, mz = 0.f, a_ = 0.f, bb = 0.f;
        if (act) {
            const float xq0 = bf2f(pr[C_MQ + cq]), xk0 = bf2f(pr[C_MK + cq]); ve = bf2f(pr[C_MV + cq]); mz = bf2f(pr[C_MZ + cq]);
            const float li = GATES[row * 8 + h], lf = GATES[row * 8 + 4 + h];
            qc = silu_f(bq + wq0 * xq3 + wq1 * xq2 + wq2 * xq1 + wq3 * xq0);
            const float kc = silu_f(bk + wk0 * xk3 + wk1 * xk2 + wk2 * xk1 + wk3 * xk0) * KSCALE;
            xq3 = xq2; xq2 = xq1; xq1 = xq0; xk3 = xk2; xk2 = xk1; xk1 = xk0;
            const float m_new = fmaxf(lf + m, li); a_ = expf(lf + m - m_new); bb = expf(li - m_new); m = m_new;
            n_e = a_ * n_e + bb * kc;
            qs[e] = qc; ks[e] = kc;
            const float dp = wave_sum(n_e * qc); if (F.lane == 0) red[F.wave] = dp;
        }
        __syncthreads();
        float hval = 0.f;
        if (act) {
            const float den = red[0] + red[1]; const float bv = bb * ve; float acc = 0.f;
#pragma unroll
            for (int d = 0; d < 128; ++d) { C[d] = a_ * C[d] + bv * ks[d]; acc += C[d] * qs[d]; }
            hval = acc / fmaxf(fabsf(den), expf(-m));
            const float sq = wave_sum(hval * hval); if (F.lane == 0) red2[F.wave] = sq;
        }
        __syncthreads();
        if (act) {
            const float ssq = red2[0] + red2[1];
            const float hm = hval * (1.0f / sqrtf(ssq * (1.0f / 128.0f) + EPS)) * mnw;
            const float ym = (hm + msk * qc) * silu_f(mz);
            Y[row * 1024 + cq] = (bf16)f2bf(ym);
        }
    }
    __syncthreads();
}

__device__ __forceinline__ void naive_attn_unit(const Frame& F, const Args& a, int l, int unit) {
    const int blk = unit & 63, h = (unit >> 6) & 3, b = unit >> 8;
    const int r = F.tid & 127, map = (F.tid >> 7) & 1, half = F.tid >> 8;
    const int q0 = blk * 128, c0 = q0 >> 6, myc = c0 + (r >> 6);
    LAS float* Kf = (LAS float*)F.lds; LAS float* Vf = Kf + 64 * 128; LAS float* Cb = Kf; LAS float* red = Kf + 2 * 64 * 128;
    const bf16* PROJ = (const bf16*)(F.ws + WS_PROJ); bf16* Y = (bf16*)(F.ws + WS_XN);
    const size_t row = (size_t)b * SEQ + q0 + r;
    float q[64], o[64];
    { const bf16* qp = PROJ + row * 4096 + C_AQ + h * 128 + map * 64;
#pragma unroll
      for (int d = 0; d < 64; ++d) q[d] = bf2f(qp[d]); }
#pragma unroll
    for (int e = 0; e < 64; ++e) o[e] = 0.f;
    float m = -1e30f, lsum = 0.f;
    for (int kt = 0; kt <= c0 + 1; ++kt) {
        __syncthreads();
#pragma unroll
        for (int i = 0; i < 2; ++i) { const int id = F.tid + 512 * i, key = id >> 4, c8 = id & 15;
            const bf16* kp = PROJ + ((size_t)b * SEQ + kt * 64 + key) * 4096 + h * 128 + c8 * 8;
            const v4u kk = *(const v4u*)(kp + C_AK), vv = *(const v4u*)(kp + C_AV);
            LAS float* kd = Kf + key * 128 + c8 * 8; LAS float* vd = Vf + key * 128 + c8 * 8;
            kd[0] = __uint_as_float(kk.x << 16); kd[1] = __uint_as_float(kk.x & 0xffff0000u); kd[2] = __uint_as_float(kk.y << 16); kd[3] = __uint_as_float(kk.y & 0xffff0000u);
            kd[4] = __uint_as_float(kk.z << 16); kd[5] = __uint_as_float(kk.z & 0xffff0000u); kd[6] = __uint_as_float(kk.w << 16); kd[7] = __uint_as_float(kk.w & 0xffff0000u);
            vd[0] = __uint_as_float(vv.x << 16); vd[1] = __uint_as_float(vv.x & 0xffff0000u); vd[2] = __uint_as_float(vv.y << 16); vd[3] = __uint_as_float(vv.y & 0xffff0000u);
            vd[4] = __uint_as_float(vv.z << 16); vd[5] = __uint_as_float(vv.z & 0xffff0000u); vd[6] = __uint_as_float(vv.w << 16); vd[7] = __uint_as_float(vv.w & 0xffff0000u); }
        __syncthreads();
        if (kt <= myc) {
            for (int j = 0; j < 64; ++j) {
                const LAS float* kr = Kf + j * 128 + map * 64; const LAS float* vr = Vf + j * 128 + half * 64;
                float s = 0.f;
#pragma unroll
                for (int d = 0; d < 64; ++d) s += q[d] * kr[d];
                const float m_new = fmaxf(m, s), alpha = exp2f(m - m_new), p = exp2f(s - m_new);
                lsum = lsum * alpha + p; m = m_new;
#pragma unroll
                for (int e = 0; e < 64; ++e) o[e] = o[e] * alpha + p * vr[e];
            }
        }
    }
    __syncthreads();
    const float inv_l = 1.0f / lsum; const float lam = ((const float*)(F.ws + WS_LAM))[l];
    if (map == 1) {
#pragma unroll
        for (int e = 0; e < 64; ++e) Cb[r * 128 + half * 64 + e] = lam * o[e] * inv_l;
    }
    __syncthreads();
    float ssq = 0.f;
    if (map == 0) {
#pragma unroll
        for (int e = 0; e < 64; ++e) { o[e] = o[e] * inv_l - Cb[r * 128 + half * 64 + e]; ssq += o[e] * o[e]; }
        red[half * 128 + r] = ssq;
    }
    __syncthreads();
    if (map == 0) {
        const float rstd = 1.0f / sqrtf((red[r] + red[128 + r]) * (1.0f / 128.0f) + EPS); const float g = 1.0f - lambda_init(l);
        const bf16* azp = PROJ + row * 4096 + C_AZ + h * 128 + half * 64; bf16* yp = Y + row * 1024 + 512 + h * 128 + half * 64; const float* anw = a.a_norm_w + l * 128 + half * 64;
#pragma unroll
        for (int e = 0; e < 64; ++e) yp[e] = (bf16)f2bf(o[e] * rstd * anw[e] * g * silu_f(bf2f(azp[e])));
    }
    __syncthreads();
}

namespace att {
typedef short bf16x8 __attribute__((ext_vector_type(8)));
typedef short s16x4 __attribute__((ext_vector_type(4)));
typedef float f32x16 __attribute__((ext_vector_type(16)));
typedef float f32x2_t __attribute__((ext_vector_type(2))); typedef __bf16 bf16x2_t __attribute__((ext_vector_type(2)));
typedef short v4i16_t __attribute__((ext_vector_type(4)));
constexpr int SLOT = 16384, LDS_K = 0, LDS_V = 3 * SLOT, LDS_X = 0, LDS_S = 6 * SLOT, SPITCH = 272, LDS_END = LDS_S + 4 * 32 * SPITCH;
constexpr float THR = 8.0f;
__device__ __forceinline__ void glds16(const void* gsrc, unsigned lds_dst) { unsigned keep;
    asm volatile("s_mov_b32 %0, m0\n\ts_mov_b32 m0, %2\n\ts_nop 0\n\tglobal_load_lds_dwordx4 %1, off\n\ts_mov_b32 m0, %0" : "=&s"(keep) : "v"(gsrc), "s"(lds_dst) : "memory"); }
__device__ __forceinline__ unsigned cvtpk(float lo, float hi) { f32x2_t v = {lo, hi}; bf16x2_t b = __builtin_convertvector(v, bf16x2_t); return __builtin_bit_cast(unsigned, b); }
__device__ __forceinline__ s16x4 vtr(const LAS char* p) { return __builtin_bit_cast(s16x4, __builtin_amdgcn_ds_read_tr16_b64_v4i16((LAS v4i16_t*)p)); }
__device__ __forceinline__ float swap_max(float m) { auto rr = __builtin_amdgcn_permlane32_swap(__float_as_uint(m), __float_as_uint(m), false, false); return fmaxf(__uint_as_float(rr[0]), __uint_as_float(rr[1])); }
__device__ __forceinline__ float swap_add(float m) { auto rr = __builtin_amdgcn_permlane32_swap(__float_as_uint(m), __float_as_uint(m), false, false); return __uint_as_float(rr[0]) + __uint_as_float(rr[1]); }
#define ATT_WAIT_BAR(N) asm volatile("s_waitcnt vmcnt(" #N ") lgkmcnt(0)\n\ts_barrier" ::: "memory")

__device__ __forceinline__ void attn_unit(const Frame& F, const Args& a, const int L, const int b, const int h, const int j) {
    const int lane = F.lane, r32 = lane & 31, hi = lane >> 5, wid = F.wave, rb = wid & 3, map = wid >> 2;
    const bf16* PROJ = (const bf16*)(F.ws + WS_PROJ); bf16* Y = (bf16*)(F.ws + WS_XN);
    const size_t rowbase = (size_t)b * SEQ; const int q0 = j * 128;
    const int NT = 2 * j + 2, myNT = 2 * j + 1 + (rb >> 1);
    const unsigned lds0 = (unsigned)(uintptr_t)F.lds;
    bf16x8 qr[4];
    { const bf16* qp = PROJ + (rowbase + q0 + rb * 32 + r32) * 4096 + C_AQ + h * 128 + map * 64 + hi * 8;
#pragma unroll
      for (int d0 = 0; d0 < 4; ++d0) qr[d0] = *(const bf16x8*)(qp + d0 * 16); }
    asm volatile("s_waitcnt vmcnt(0)" ::: "memory");
    const bf16* ksrc0 = PROJ + (rowbase + lane) * 4096 + C_AK + h * 128 + wid * 8; const bf16* ksrc1 = ksrc0 + 64;
    const bf16* vsrc0 = PROJ + (rowbase + 16 * (wid & 3) + (lane >> 2)) * 4096 + C_AV + h * 128 + (wid >> 2) * 32 + (lane & 3) * 8; const bf16* vsrc1 = vsrc0 + 64;
    const unsigned kdst = lds0 + LDS_K + wid * 1024, vdst = lds0 + LDS_V + wid * 1024;
#define ATT_DMA(t, slot) do { const size_t to_ = (size_t)(t) * 64 * 4096; const unsigned so_ = (unsigned)(slot) * SLOT; \
        glds16(ksrc0 + to_, (unsigned)__builtin_amdgcn_readfirstlane(kdst + so_)); glds16(ksrc1 + to_, (unsigned)__builtin_amdgcn_readfirstlane(kdst + so_ + 8192)); \
        glds16(vsrc0 + to_, (unsigned)__builtin_amdgcn_readfirstlane(vdst + so_)); glds16(vsrc1 + to_, (unsigned)__builtin_amdgcn_readfirstlane(vdst + so_ + 8192)); } while (0)
    ATT_DMA(0, 0); ATT_DMA(1, 1);
    f32x16 o[4]; o[0] = f32x16{}; o[1] = f32x16{}; o[2] = f32x16{}; o[3] = f32x16{};
    f32x16 negm = f32x16{}; float mhat = 0.f, lsum = 0.f;
    const LAS char* kfrag = (const LAS char*)F.lds + LDS_K + map * 8192 + hi * 1024 + r32 * 16;
    const LAS char* vfrag = (const LAS char*)F.lds + LDS_V + ((lane >> 4) & 1) * 32 + (lane & 3) * 8 + (4 * hi + ((lane & 15) >> 2)) * 64;
    int slot = 0;
    for (int t = 0; t < NT; ++t) {
        if (t + 1 < NT) ATT_WAIT_BAR(4); else ATT_WAIT_BAR(0);
        if (t + 2 < NT) { const int s2 = (slot >= 1) ? slot - 1 : 2; ATT_DMA(t + 2, s2); }
        if (t < myNT) {
            const LAS char* kb = kfrag + slot * SLOT; const LAS char* vb = vfrag + slot * SLOT;
            f32x16 p0, p1;
#pragma unroll
            for (int d0 = 0; d0 < 4; ++d0) {
                const bf16x8 b0 = *(const LAS bf16x8*)(kb + d0 * 2048), b1 = *(const LAS bf16x8*)(kb + d0 * 2048 + 512);
                p0 = __builtin_amdgcn_mfma_f32_32x32x16_bf16(b0, qr[d0], d0 == 0 ? negm : p0, 0, 0, 0);
                p1 = __builtin_amdgcn_mfma_f32_32x32x16_bf16(b1, qr[d0], d0 == 0 ? negm : p1, 0, 0, 0);
            }
            float rm = fmaxf(p0[0], p1[0]);
#pragma unroll
            for (int r = 1; r < 16; ++r) rm = fmaxf(rm, fmaxf(p0[r], p1[r]));
            rm = swap_max(rm);
            if (t == 0 || __any(rm > THR)) {
                const float dl = (t == 0) ? rm : fmaxf(rm, 0.f); mhat += dl;
#pragma unroll
                for (int r = 0; r < 16; ++r) { p0[r] -= dl; p1[r] -= dl; negm[r] = -mhat; }
                const float f = exp2f(-dl); lsum *= f;
#pragma unroll
                for (int d0 = 0; d0 < 4; ++d0)
#pragma unroll
                    for (int r = 0; r < 16; ++r) o[d0][r] *= f;
            }
            float sacc = 0.f;
#pragma unroll
            for (int r = 0; r < 16; ++r) { p0[r] = __builtin_amdgcn_exp2f(p0[r]); p1[r] = __builtin_amdgcn_exp2f(p1[r]); sacc += p0[r] + p1[r]; }
            lsum += sacc;
            bf16x8 pw[4];
            { u32x4_t w0 = {cvtpk(p0[0], p0[1]), cvtpk(p0[2], p0[3]), cvtpk(p0[4], p0[5]), cvtpk(p0[6], p0[7])}; pw[0] = __builtin_bit_cast(bf16x8, w0);
              u32x4_t w1 = {cvtpk(p0[8], p0[9]), cvtpk(p0[10], p0[11]), cvtpk(p0[12], p0[13]), cvtpk(p0[14], p0[15])}; pw[1] = __builtin_bit_cast(bf16x8, w1);
              u32x4_t w2 = {cvtpk(p1[0], p1[1]), cvtpk(p1[2], p1[3]), cvtpk(p1[4], p1[5]), cvtpk(p1[6], p1[7])}; pw[2] = __builtin_bit_cast(bf16x8, w2);
              u32x4_t w3 = {cvtpk(p1[8], p1[9]), cvtpk(p1[10], p1[11]), cvtpk(p1[12], p1[13]), cvtpk(p1[14], p1[15])}; pw[3] = __builtin_bit_cast(bf16x8, w3); }
#pragma unroll
            for (int d0 = 0; d0 < 4; ++d0) {
#pragma unroll
                for (int ks = 0; ks < 4; ++ks) {
                    const s16x4 lo = vtr(vb + d0 * 4096 + ks * 1024), hh = vtr(vb + d0 * 4096 + ks * 1024 + 512);
                    const bf16x8 vf = (bf16x8){lo[0], lo[1], lo[2], lo[3], hh[0], hh[1], hh[2], hh[3]};
                    o[d0] = __builtin_amdgcn_mfma_f32_32x32x16_bf16(vf, pw[ks], o[d0], 0, 0, 0);
                }
            }
        }
        slot = (slot == 2) ? 0 : slot + 1;
    }
    const float inv = 1.0f / swap_add(lsum);
    ATT_WAIT_BAR(0);
    LAS float* X = (LAS float*)(F.lds + LDS_X) + rb * 4096 + lane;
    if (map == 1) {
        const float sc = inv * ((const float*)(F.ws + WS_LAM))[L];
#pragma unroll
        for (int d0 = 0; d0 < 4; ++d0)
#pragma unroll
            for (int r = 0; r < 16; ++r) X[(d0 * 16 + r) * 64] = o[d0][r] * sc;
    }
    ATT_WAIT_BAR(0);
    if (map == 0) {
        float ssq = 0.f;
#pragma unroll
        for (int d0 = 0; d0 < 4; ++d0)
#pragma unroll
            for (int r = 0; r < 16; ++r) { const float v = o[d0][r] * inv - X[(d0 * 16 + r) * 64]; o[d0][r] = v; ssq += v * v; }
        const float rstd = 1.0f / sqrtf(swap_add(ssq) * (1.0f / 128.0f) + EPS);
        LAS char* S = (LAS char*)F.lds + LDS_S + rb * 32 * SPITCH;
#pragma unroll
        for (int d0 = 0; d0 < 4; ++d0)
#pragma unroll
            for (int g4 = 0; g4 < 4; ++g4) { u32x2_t w; w.x = cvtpk(o[d0][4 * g4] * rstd, o[d0][4 * g4 + 1] * rstd); w.y = cvtpk(o[d0][4 * g4 + 2] * rstd, o[d0][4 * g4 + 3] * rstd);
                *(LAS u32x2_t*)(S + r32 * SPITCH + (32 * d0 + 8 * g4 + 4 * hi) * 2) = w; }
        asm volatile("s_waitcnt lgkmcnt(0)" ::: "memory");
        const int ch = lane & 15; const float g = 1.0f - lambda_init(L);
        float anw[8];
#pragma unroll
        for (int k = 0; k < 8; ++k) anw[k] = a.a_norm_w[L * 128 + 8 * ch + k] * g;
#pragma unroll
        for (int it = 0; it < 8; ++it) { const int row = it * 4 + (lane >> 4);
            const u32x4_t sv = *(const LAS u32x4_t*)(S + row * SPITCH + ch * 16);
            const size_t grow = rowbase + q0 + rb * 32 + row;
            const u32x4_t zv = *(const u32x4_t*)(PROJ + grow * 4096 + C_AZ + h * 128 + 8 * ch);
            float v[8], z[8];
#pragma unroll
            for (int k = 0; k < 4; ++k) { v[2 * k] = __uint_as_float(sv[k] << 16); v[2 * k + 1] = __uint_as_float(sv[k] & 0xffff0000u); z[2 * k] = __uint_as_float(zv[k] << 16); z[2 * k + 1] = __uint_as_float(zv[k] & 0xffff0000u); }
            u32x4_t ov;
#pragma unroll
            for (int k = 0; k < 4; ++k) ov[k] = cvtpk(v[2 * k] * anw[2 * k] * silu_f(z[2 * k]), v[2 * k + 1] * anw[2 * k + 1] * silu_f(z[2 * k + 1]));
            *(u32x4_t*)(Y + grow * 1024 + 512 + h * 128 + 8 * ch) = ov; }
    }
    ATT_WAIT_BAR(0);
#undef ATT_DMA
}
}

namespace ml {
using att::bf16x8; using att::s16x4; using att::f32x16; using att::glds16; using att::cvtpk; using att::vtr; using att::swap_add;
constexpr int NCH = 32;
constexpr float LOG2E = 1.4426950408889634f;
constexpr size_t WS_CROW = 26 * MiB, WS_BROW = WS_CROW + 256 * 1024, WS_PMROW = WS_BROW + 256 * 1024;
constexpr size_t WS_GCH = 27 * MiB, WS_BLCH = WS_GCH + 4096, WS_MST = WS_BLCH + 4096;
constexpr size_t WS_DN = 27 * MiB + 256 * 1024, WS_NST = WS_DN + 128 * 1024;
constexpr int B1_KW = 0, B1_V = 65536, B1_SC = 131072;
#define ML_WAIT_BAR(N) asm volatile("s_waitcnt vmcnt(" #N ") lgkmcnt(0)\n\ts_barrier" ::: "memory")
__device__ __forceinline__ bf16x8 trfrag(const LAS char* p) { const s16x4 lo = vtr(p), hh = vtr(p + 512); return (bf16x8){lo[0], lo[1], lo[2], lo[3], hh[0], hh[1], hh[2], hh[3]}; }
__device__ __forceinline__ void unpack8(const u32x4_t v, float (&f)[8]) {
#pragma unroll
    for (int k = 0; k < 4; ++k) { f[2 * k] = __uint_as_float(v[k] << 16); f[2 * k + 1] = __uint_as_float(v[k] & 0xffff0000u); } }

__device__ __forceinline__ void b1_unit(const Frame& F, const Args& a, const int L, const int bh, const int c) {
    const int tid = F.tid, lane = F.lane, wid = F.wave, hi = lane >> 5, r32 = lane & 31;
    const int b = bh >> 2, h = bh & 3; const size_t row0 = (size_t)b * SEQ + (size_t)c * 256;
    const bf16* PROJ = (const bf16*)(F.ws + WS_PROJ); const float* GATES = (const float*)(F.ws + WS_GATES);
    bf16* QC = (bf16*)(F.ws + WS_QC); bf16* KC = (bf16*)(F.ws + WS_KC);
    const unsigned lds0 = (unsigned)(uintptr_t)F.lds;
    LAS float* wl = (LAS float*)(F.lds + B1_SC); LAS float* wsum = wl + 256; LAS float* wmax = wsum + 8;
    { const bf16* vs = PROJ + (row0 + 16 * (wid & 3) + (lane >> 2)) * 4096 + C_MV + h * 128 + (wid >> 2) * 32 + (lane & 3) * 8; unsigned vd = lds0 + B1_V + wid * 1024;
#pragma unroll 1
      for (int i = 0; i < 4; ++i) { glds16(vs, (unsigned)__builtin_amdgcn_readfirstlane(vd)); glds16(vs + 64, (unsigned)__builtin_amdgcn_readfirstlane(vd + 8192)); vs += 64 * 4096; vd += 16384; } }
    float bl = 0.f, cl = 0.f, pm = 0.f;
    if (tid < 256) {
        const float lf = GATES[(row0 + tid) * 8 + 4 + h], li = GATES[(row0 + tid) * 8 + h];
        bl = lf;
#pragma unroll
        for (int off = 1; off < 64; off <<= 1) { const float t = __shfl_up(bl, off); if (lane >= off) bl += t; }
        if (lane == 63) wsum[wid] = bl;
    }
    __syncthreads();
    if (tid < 256) {
        float offs = 0.f;
#pragma unroll
        for (int w = 0; w < 4; ++w) offs += (w < wid) ? wsum[w] : 0.f;
        bl += offs;
        const float li = GATES[(row0 + tid) * 8 + h];
        cl = li - bl; pm = cl;
#pragma unroll
        for (int off = 1; off < 64; off <<= 1) { const float t = __shfl_up(pm, off); if (lane >= off) pm = fmaxf(pm, t); }
        if (lane == 63) wmax[wid] = pm;
    }
    __syncthreads();
    if (tid < 256) {
        float pmo = -INFINITY;
#pragma unroll
        for (int w = 0; w < 4; ++w) pmo = (w < wid) ? fmaxf(pmo, wmax[w]) : pmo;
        pm = fmaxf(pm, pmo);
        const float G = fmaxf(fmaxf(wmax[0], wmax[1]), fmaxf(wmax[2], wmax[3]));
        wl[tid] = expf(cl - G);
        float* CROW = (float*)(F.ws + WS_CROW); float* BROW = (float*)(F.ws + WS_BROW); float* PMROW = (float*)(F.ws + WS_PMROW);
        CROW[(row0 + tid) * 4 + h] = cl; BROW[(row0 + tid) * 4 + h] = bl; PMROW[(row0 + tid) * 4 + h] = pm;
        if (tid == 255) { ((float*)(F.ws + WS_GCH))[bh * NCH + c] = G; ((float*)(F.ws + WS_BLCH))[bh * NCH + c] = bl; }
    }
    __syncthreads();
    {
        const int ch8 = tid & 15, run = tid >> 4, r0 = run * 8;
        const float* cw = a.conv_w + (size_t)L * 4 * 1024; const float* cb = a.conv_b + (size_t)L * 1024;
#pragma unroll 1
        for (int which = 0; which < 2; ++which) {
            const int cch = which * 512 + h * 128 + ch8 * 8;
            const bf16* src = PROJ + row0 * 4096 + (which ? C_MK : C_MQ) + h * 128 + ch8 * 8;
            float w[4][8], bs[8];
#pragma unroll
            for (int k = 0; k < 4; ++k) { const f32x4 w0 = *(const f32x4*)(cw + k * 1024 + cch), w1 = *(const f32x4*)(cw + k * 1024 + cch + 4);
                w[k][0] = w0[0]; w[k][1] = w0[1]; w[k][2] = w0[2]; w[k][3] = w0[3]; w[k][4] = w1[0]; w[k][5] = w1[1]; w[k][6] = w1[2]; w[k][7] = w1[3]; }
            { const f32x4 b0 = *(const f32x4*)(cb + cch), b1 = *(const f32x4*)(cb + cch + 4); bs[0] = b0[0]; bs[1] = b0[1]; bs[2] = b0[2]; bs[3] = b0[3]; bs[4] = b1[0]; bs[5] = b1[1]; bs[6] = b1[2]; bs[7] = b1[3]; }
            u32x4_t xr[11];
#pragma unroll
            for (int i = 0; i < 11; ++i) { const int rr = r0 - 3 + i; xr[i] = (c > 0 || rr >= 0) ? *(const u32x4_t*)(src + (long)rr * 4096) : (u32x4_t){0u, 0u, 0u, 0u}; }
            float x0[8], x1[8], x2[8], x3[8];
            unpack8(xr[0], x0); unpack8(xr[1], x1); unpack8(xr[2], x2);
#pragma unroll
            for (int r = 0; r < 8; ++r) {
                unpack8(xr[r + 3], x3);
                float y[8];
#pragma unroll
                for (int k = 0; k < 8; ++k) { y[k] = silu_f(bs[k] + w[0][k] * x0[k] + w[1][k] * x1[k] + w[2][k] * x2[k] + w[3][k] * x3[k]); x0[k] = x1[k]; x1[k] = x2[k]; x2[k] = x3[k]; }
                const size_t orow = row0 + r0 + r;
                if (which == 0) {
                    u32x4_t o; o[0] = cvtpk(y[0], y[1]); o[1] = cvtpk(y[2], y[3]); o[2] = cvtpk(y[4], y[5]); o[3] = cvtpk(y[6], y[7]);
                    *(u32x4_t*)(QC + orow * 512 + h * 128 + ch8 * 8) = o;
                } else {
#pragma unroll
                    for (int k = 0; k < 8; ++k) y[k] *= KSCALE;
                    u32x4_t o; o[0] = cvtpk(y[0], y[1]); o[1] = cvtpk(y[2], y[3]); o[2] = cvtpk(y[4], y[5]); o[3] = cvtpk(y[6], y[7]);
                    *(u32x4_t*)(KC + orow * 512 + h * 128 + ch8 * 8) = o;
                    const int l = r0 + r; const float wv = wl[l];
                    u32x4_t ow; ow[0] = cvtpk(y[0] * wv, y[1] * wv); ow[1] = cvtpk(y[2] * wv, y[3] * wv); ow[2] = cvtpk(y[4] * wv, y[5] * wv); ow[3] = cvtpk(y[6] * wv, y[7] * wv);
                    *(LAS u32x4_t*)(F.lds + B1_KW + (l >> 6) * 16384 + ((ch8 >> 2) * 4 + ((l >> 4) & 3)) * 1024 + (l & 15) * 64 + (ch8 & 3) * 16) = ow;
                }
            }
        }
    }
    asm volatile("s_waitcnt vmcnt(0)" ::: "memory");
    __syncthreads();
    {
        const int td = wid & 3, tep = wid >> 2;
        const LAS char* fb = (const LAS char*)F.lds + ((lane >> 4) & 1) * 32 + (lane & 3) * 8 + (4 * hi + ((lane & 15) >> 2)) * 64;
        f32x16 acc0 = f32x16{}, acc1 = f32x16{}, accn = f32x16{};
        const bf16x8 ones = (bf16x8){(short)0x3f80, (short)0x3f80, (short)0x3f80, (short)0x3f80, (short)0x3f80, (short)0x3f80, (short)0x3f80, (short)0x3f80};
#pragma unroll 4
        for (int s16 = 0; s16 < 16; ++s16) { const int off = (s16 >> 2) * 16384 + (s16 & 3) * 1024;
            const bf16x8 kwf = trfrag(fb + B1_KW + off + td * 4096);
            const bf16x8 v0 = trfrag(fb + B1_V + off + (2 * tep) * 4096), v1 = trfrag(fb + B1_V + off + (2 * tep + 1) * 4096);
            acc0 = __builtin_amdgcn_mfma_f32_32x32x16_bf16(v0, kwf, acc0, 0, 0, 0);
            acc1 = __builtin_amdgcn_mfma_f32_32x32x16_bf16(v1, kwf, acc1, 0, 0, 0);
            if (tep == 0) accn = __builtin_amdgcn_mfma_f32_32x32x16_bf16(ones, kwf, accn, 0, 0, 0);
        }
        float* DCT = (float*)(F.ws + WS_DC) + (size_t)(bh * NCH + c) * 16384;
#pragma unroll
        for (int r = 0; r < 16; ++r) { const int er = (r & 3) + 8 * (r >> 2) + 4 * hi;
            DCT[(size_t)((2 * tep) * 32 + er) * 128 + td * 32 + r32] = acc0[r];
            DCT[(size_t)((2 * tep + 1) * 32 + er) * 128 + td * 32 + r32] = acc1[r]; }
        if (tep == 0 && hi == 0) ((float*)(F.ws + WS_DN))[(size_t)(bh * NCH + c) * 128 + td * 32 + r32] = accn[0];
    }
    __syncthreads();
}

__device__ __forceinline__ void b2_scan(const Frame& F) {
    const int gid = F.vcu * 512 + F.tid;
    if (gid >= 8 * 16384) return;
    const int bh = gid >> 14, el = gid & 16383;
    const float* DCT = (const float*)(F.ws + WS_DC) + (size_t)bh * NCH * 16384 + el;
    const float* G = (const float*)(F.ws + WS_GCH) + bh * NCH; const float* BL = (const float*)(F.ws + WS_BLCH) + bh * NCH;
    bf16* CST = (bf16*)(F.ws + WS_CST) + (size_t)bh * NCH * 16384 + el;
    float d[NCH];
#pragma unroll
    for (int c = 0; c < NCH; ++c) d[c] = DCT[(size_t)c * 16384];
    float dn[NCH];
    const bool has_n = el < 128;
    if (has_n) {
        const float* DN = (const float*)(F.ws + WS_DN) + (size_t)bh * NCH * 128 + el;
#pragma unroll
        for (int c = 0; c < NCH; ++c) dn[c] = DN[c * 128];
    }
    float C = 0.f, n = 0.f, m = 0.f;
    float* NST = (float*)(F.ws + WS_NST) + (size_t)bh * NCH * 128 + el; float* MST = (float*)(F.ws + WS_MST) + bh * NCH;
#pragma unroll
    for (int c = 0; c < NCH; ++c) {
        CST[(size_t)c * 16384] = (bf16)f2bf(C);
        if (has_n) NST[c * 128] = n;
        if (el == 0) MST[c] = m;
        const float g = G[c], Ml = fmaxf(m, g), ac = expf(m - Ml), gc = expf(g - Ml);
        C = ac * C + gc * d[c];
        if (has_n) n = ac * n + gc * dn[c];
        m = BL[c] + Ml;
    }
}

constexpr int B3_CT = 0, B3_NV = 32768, B3_K = 0, B3_V = 65536, B3_CL = 131072, B3_S = 0, B3_SPITCH = 272;
__device__ __forceinline__ void b3_unit(const Frame& F, const Args& a, const int L, const int bh, const int c) {
    const int tid = F.tid, lane = F.lane, wid = F.wave, hi = lane >> 5, r32 = lane & 31;
    const int b = bh >> 2, h = bh & 3; const size_t row0 = (size_t)b * SEQ + (size_t)c * 256;
    const bf16* PROJ = (const bf16*)(F.ws + WS_PROJ); const bf16* QC = (const bf16*)(F.ws + WS_QC); const bf16* KC = (const bf16*)(F.ws + WS_KC); bf16* Y = (bf16*)(F.ws + WS_XN);
    const unsigned lds0 = (unsigned)(uintptr_t)F.lds;
    const size_t myrow = row0 + wid * 32 + r32;
    bf16x8 qr[8];
#pragma unroll
    for (int s = 0; s < 8; ++s) qr[s] = *(const bf16x8*)(QC + myrow * 512 + h * 128 + 16 * s + 8 * hi);
    const float c_i = ((const float*)(F.ws + WS_CROW))[myrow * 4 + h], b_i = ((const float*)(F.ws + WS_BROW))[myrow * 4 + h], pm_i = ((const float*)(F.ws + WS_PMROW))[myrow * 4 + h];
    const float m0 = ((const float*)(F.ws + WS_MST))[bh * NCH + c];
    const float M_i = fmaxf(m0, pm_i), M2 = M_i * LOG2E, w_inter = expf(m0 - M_i);
    (void)c_i;
    LAS float* nv = (LAS float*)(F.lds + B3_NV); LAS float* cl2 = (LAS float*)(F.lds + B3_CL);
    if (tid < 128) nv[tid] = ((const float*)(F.ws + WS_NST))[(size_t)(bh * NCH + c) * 128 + tid];
    if (tid < 256) cl2[tid] = ((const float*)(F.ws + WS_CROW))[(row0 + tid) * 4 + h] * LOG2E;
    asm volatile("s_waitcnt vmcnt(0)" ::: "memory");
    { const bf16* CST = (const bf16*)(F.ws + WS_CST) + (size_t)(bh * NCH + c) * 16384;
#pragma unroll
      for (int i = 0; i < 4; ++i) { const int p = wid + 8 * i, chunk = p >> 1, g = p & 1;
          glds16(CST + (size_t)(g * 64 + lane) * 128 + chunk * 8, (unsigned)__builtin_amdgcn_readfirstlane(lds0 + B3_CT + chunk * 2048 + g * 1024)); } }
    ML_WAIT_BAR(0);
    f32x16 acc[4];
#pragma unroll
    for (int te = 0; te < 4; ++te) { acc[te] = f32x16{};
#pragma unroll
        for (int s = 0; s < 8; ++s) { const bf16x8 cf = *(const LAS bf16x8*)(F.lds + B3_CT + (2 * s + hi) * 2048 + (te * 32 + r32) * 16);
            acc[te] = __builtin_amdgcn_mfma_f32_32x32x16_bf16(cf, qr[s], acc[te], 0, 0, 0); }
        __builtin_amdgcn_sched_barrier(0); }
    float qn = 0.f;
#pragma unroll
    for (int s = 0; s < 8; ++s) { float qf[8]; unpack8(__builtin_bit_cast(u32x4_t, qr[s]), qf);
        const f32x4 n0 = *(const LAS f32x4*)(nv + 16 * s + 8 * hi), n1 = *(const LAS f32x4*)(nv + 16 * s + 8 * hi + 4);
        qn += (qf[0] * n0[0] + qf[1] * n0[1]) + (qf[2] * n0[2] + qf[3] * n0[3]) + (qf[4] * n1[0] + qf[5] * n1[1]) + (qf[6] * n1[2] + qf[7] * n1[3]); }
    qn = swap_add(qn);
    ML_WAIT_BAR(0);
    {
      const bf16* ks = KC + (row0 + (wid & 3) * 64 + lane) * 512 + h * 128 + (wid >> 2) * 8; unsigned kd = lds0 + B3_K + (wid >> 2) * 4096 + (wid & 3) * 1024;
#pragma unroll 1
      for (int i = 0; i < 8; ++i) { glds16(ks, (unsigned)__builtin_amdgcn_readfirstlane(kd)); ks += 16; kd += 8192; }
      const bf16* vs = PROJ + (row0 + 16 * (wid & 3) + (lane >> 2)) * 4096 + C_MV + h * 128 + (wid >> 2) * 32 + (lane & 3) * 8; unsigned vd = lds0 + B3_V + wid * 1024;
#pragma unroll 1
      for (int i = 0; i < 4; ++i) { glds16(vs, (unsigned)__builtin_amdgcn_readfirstlane(vd)); glds16(vs + 64, (unsigned)__builtin_amdgcn_readfirstlane(vd + 8192)); vs += 64 * 4096; vd += 16384; } }
#pragma unroll
    for (int te = 0; te < 4; ++te)
#pragma unroll
        for (int r = 0; r < 16; ++r) acc[te][r] *= w_inter;
    float rowsum = 0.f;
    ML_WAIT_BAR(0);
    const LAS char* vb = (const LAS char*)F.lds + B3_V + ((lane >> 4) & 1) * 32 + (lane & 3) * 8 + (4 * hi + ((lane & 15) >> 2)) * 64;
    for (int hf = 0; hf <= wid; ++hf) {
        f32x16 p = f32x16{};
#pragma unroll
        for (int s = 0; s < 8; ++s) { const bf16x8 kf = *(const LAS bf16x8*)(F.lds + B3_K + (2 * s + hi) * 4096 + (32 * hf + r32) * 16);
            p = __builtin_amdgcn_mfma_f32_32x32x16_bf16(kf, qr[s], p, 0, 0, 0); }
        __builtin_amdgcn_sched_barrier(0);
        const bool diag = (hf == wid);
#pragma unroll
        for (int g4 = 0; g4 < 4; ++g4) { const f32x4 cc = *(const LAS f32x4*)(cl2 + 32 * hf + 8 * g4 + 4 * hi);
#pragma unroll
            for (int i = 0; i < 4; ++i) { const int r = 4 * g4 + i; const int kl = 8 * g4 + 4 * hi + i;
                const float wgt = __builtin_amdgcn_exp2f(cc[i] - M2);
                float v = p[r] * wgt; if (diag && kl > r32) v = 0.f; p[r] = v; rowsum += v; } }
        bf16x8 pw0, pw1;
        { u32x4_t w0 = {cvtpk(p[0], p[1]), cvtpk(p[2], p[3]), cvtpk(p[4], p[5]), cvtpk(p[6], p[7])}; pw0 = __builtin_bit_cast(bf16x8, w0);
          u32x4_t w1 = {cvtpk(p[8], p[9]), cvtpk(p[10], p[11]), cvtpk(p[12], p[13]), cvtpk(p[14], p[15])}; pw1 = __builtin_bit_cast(bf16x8, w1); }
        const LAS char* vt = vb + (hf >> 1) * 16384 + (2 * (hf & 1)) * 1024;
        __builtin_amdgcn_sched_barrier(0);
#pragma unroll
        for (int te = 0; te < 4; ++te) {
            acc[te] = __builtin_amdgcn_mfma_f32_32x32x16_bf16(trfrag(vt + te * 4096), pw0, acc[te], 0, 0, 0);
            acc[te] = __builtin_amdgcn_mfma_f32_32x32x16_bf16(trfrag(vt + te * 4096 + 1024), pw1, acc[te], 0, 0, 0);
        }
        __builtin_amdgcn_sched_barrier(0);
    }
    const float den = w_inter * qn + swap_add(rowsum);
    const float hden = 1.0f / fmaxf(fabsf(den), exp2f(-(b_i * LOG2E + M2)));
    float ssq = 0.f;
#pragma unroll
    for (int te = 0; te < 4; ++te)
#pragma unroll
        for (int r = 0; r < 16; ++r) { const float v = acc[te][r] * hden; acc[te][r] = v; ssq += v * v; }
    const float rstd = 1.0f / sqrtf(swap_add(ssq) * (1.0f / 128.0f) + EPS);
    ML_WAIT_BAR(0);
    LAS char* S = (LAS char*)F.lds + B3_S + wid * 32 * B3_SPITCH;
#pragma unroll
    for (int te = 0; te < 4; ++te)
#pragma unroll
        for (int g4 = 0; g4 < 4; ++g4) { u32x2_t w; w.x = cvtpk(acc[te][4 * g4] * rstd, acc[te][4 * g4 + 1] * rstd); w.y = cvtpk(acc[te][4 * g4 + 2] * rstd, acc[te][4 * g4 + 3] * rstd);
            *(LAS u32x2_t*)(S + r32 * B3_SPITCH + (32 * te + 8 * g4 + 4 * hi) * 2) = w; }
    asm volatile("s_waitcnt lgkmcnt(0)" ::: "memory");
    { const int ch = lane & 15; float mnw[8], msk[8];
#pragma unroll
      for (int k = 0; k < 8; ++k) { mnw[k] = a.m_norm_w[L * 512 + h * 128 + 8 * ch + k]; msk[k] = a.m_skip[L * 512 + h * 128 + 8 * ch + k]; }
#pragma unroll
      for (int it = 0; it < 8; ++it) { const int row = it * 4 + (lane >> 4); const size_t grow = row0 + wid * 32 + row;
          const u32x4_t sv = *(const LAS u32x4_t*)(S + row * B3_SPITCH + ch * 16);
          const u32x4_t qv = *(const u32x4_t*)(QC + grow * 512 + h * 128 + 8 * ch), zv = *(const u32x4_t*)(PROJ + grow * 4096 + C_MZ + h * 128 + 8 * ch);
          float v[8], q[8], z[8]; unpack8(sv, v); unpack8(qv, q); unpack8(zv, z);
          u32x4_t ov;
#pragma unroll
          for (int k = 0; k < 4; ++k) ov[k] = cvtpk((v[2 * k] * mnw[2 * k] + msk[2 * k] * q[2 * k]) * silu_f(z[2 * k]), (v[2 * k + 1] * mnw[2 * k + 1] + msk[2 * k + 1] * q[2 * k + 1]) * silu_f(z[2 * k + 1]));
          *(u32x4_t*)(Y + grow * 1024 + h * 128 + 8 * ch) = ov; } }
    ML_WAIT_BAR(0);
}
}


typedef __attribute__((address_space(1))) unsigned gu32;
#define XB_TMO      128
#define XB_XCNT(j)  (256  + 64 * (j))
#define XB_XSUB(j)  (1280 + 64 * (j))
#define XB_XGEN(j)  (2304 + 64 * (j))
#define XB_TOP      3328
#define XB_TOPGEN   3392
#define XCD_BAR_WORDS 3456
#define XB_SPIN_CAP (1u << 18)

__device__ __forceinline__ unsigned xb_ld(unsigned* p)              { return __hip_atomic_load(p, __ATOMIC_RELAXED, __HIP_MEMORY_SCOPE_AGENT); }
__device__ __forceinline__ unsigned xb_add(unsigned* p, unsigned v) { return __hip_atomic_fetch_add(p, v, __ATOMIC_RELAXED, __HIP_MEMORY_SCOPE_AGENT); }
__device__ __forceinline__ unsigned xb_xcc_id() { return (unsigned)__builtin_amdgcn_s_getreg((3 << 11) | 20) & 0xFu; }
#define XB_SPIN(cond, bar) do { unsigned _sp = 0; while (cond) { __builtin_amdgcn_s_sleep(1); \
    if ((++_sp & 255u) == 0u) { if (xb_ld(&(bar)[XB_TMO])) break; if (_sp > XB_SPIN_CAP) { atomicAdd(&(bar)[XB_TMO], 1u); break; } } } } while (0)

struct XcdBarrier {
    unsigned* bar; unsigned x;
    volatile LAS unsigned* st;
};

__device__ __forceinline__ XcdBarrier xcd_barrier_post(unsigned* bar, volatile LAS unsigned* st) {
    XcdBarrier b; b.bar = bar; b.x = xb_xcc_id(); b.st = st;
    if (threadIdx.x == 0) (void)xb_add(&bar[XB_XCNT(b.x)], 1u);
    return b;
}
__device__ __forceinline__ void xcd_barrier_complete(unsigned* bar, unsigned x, unsigned& nloc, unsigned& nx) {
    const unsigned G = gridDim.x * gridDim.y * gridDim.z;
    unsigned sum, cnt, mine, sp = 0u;
    for (;;) {
        sum = 0u; cnt = 0u; mine = 0u;
#pragma unroll
        for (unsigned j = 0; j < 16; ++j) { const unsigned c = xb_ld(&bar[XB_XCNT(j)]); sum += c; cnt += (c > 0u) ? 1u : 0u; mine = (j == x) ? c : mine; }
        if (sum == G) break;
        __builtin_amdgcn_s_sleep(1);
        if ((++sp & 255u) == 0u) { if (xb_ld(&bar[XB_TMO])) break; if (sp > XB_SPIN_CAP) { atomicAdd(&bar[XB_TMO], 1u); break; } }
    }
    nloc = mine > 0u ? mine : 1u; nx = cnt > 0u ? cnt : 1u;
}

__device__ __forceinline__ void xcd_barrier(const XcdBarrier& b) {
    asm volatile("s_waitcnt vmcnt(0)" ::: "memory");
    __syncthreads();
    if (threadIdx.x == 0) {
        unsigned* bar = b.bar;
        __builtin_amdgcn_s_waitcnt(0);
        unsigned nloc = b.st[0], nx = b.st[1];
        if (nloc == 0u) { xcd_barrier_complete(bar, b.x, nloc, nx); b.st[0] = nloc; b.st[1] = nx; }
        const unsigned old = xb_add(&bar[XB_XSUB(b.x)], 1u);
        const unsigned gen = old / nloc;
        if (old + 1u == (gen + 1u) * nloc) {
            __builtin_amdgcn_fence(__ATOMIC_RELEASE, "agent");
            asm volatile("s_waitcnt vmcnt(0)" ::: "memory");
            const unsigned og = xb_add(&bar[XB_TOP], 1u);
            const unsigned tg = og / nx;
            if (og + 1u == (tg + 1u) * nx) xb_add(&bar[XB_TOPGEN], 1u);
            else XB_SPIN(xb_ld(&bar[XB_TOPGEN]) == tg, bar);
            __builtin_amdgcn_fence(__ATOMIC_ACQUIRE, "agent");
            xb_add(&bar[XB_XGEN(b.x)], 1u);
            asm volatile("s_waitcnt vmcnt(0)" ::: "memory");
        } else {
            XB_SPIN(xb_ld(&bar[XB_XGEN(b.x)]) == gen, bar);
            __builtin_amdgcn_fence(__ATOMIC_ACQUIRE, "agent");
            asm volatile("s_waitcnt vmcnt(0)" ::: "memory");
        }
    }
    __syncthreads();
}

constexpr int N_PHASES = 1 + 6 * DEPTH;
#ifndef NAIVE_MIX
#define NAIVE_MIX 0
#endif
#ifndef NAIVE_ATTN
#define NAIVE_ATTN 0
#endif
constexpr bool HAS_B12 = (NAIVE_MIX == 0);
#define PH_IN(k) (lo <= (k) && (k) < hi)
#ifndef USE_XCD_BAR
#define USE_XCD_BAR 1
#endif
#if USE_XCD_BAR
#define PH_SYNC(k) do { if (lo <= (k) && (k) + 1 < hi) { if ((k) == 0) cg::this_grid().sync(); else xcd_barrier(bar); } } while (0)
#else
#define PH_SYNC(k) do { if (lo <= (k) && (k) + 1 < hi) cg::this_grid().sync(); } while (0)
#endif
template <int L> __device__ __forceinline__ void layer_phases(const Frame& F, const Args& a, const int lo, const int hi, const XcdBarrier& bar) {
    constexpr int base = 1 + 6 * L;
    bf16* XN = (bf16*)(a.ws + WS_XN); bf16* PROJ = (bf16*)(a.ws + WS_PROJ); float* GATES = (float*)(a.ws + WS_GATES);
    if (PH_IN(base + 0)) {
        pg8::Gemm g{XN, (const bf16*)(a.ws + WS_WIN) + (size_t)L * NPROJ * DMODEL, TOK, NPROJ, DMODEL}; pg8::StaticOrder S; S.init(TOK, NPROJ, F.G, (int)blockIdx.x);
        pg8::EpiProj E{PROJ, (const float*)(a.ws + WS_COS), (const float*)(a.ws + WS_SIN), C2};
        pg8::gemm_phase<pg8::EpiProj, pg8::StaticOrder, true, true>(F.lds, g, S, E);
    }
    PH_SYNC(base + 0);
    if (HAS_B12) {
#ifndef NO_B1
        if (PH_IN(base + 1)) { ml::b1_unit(F, a, L, F.vcu >> 5, F.vcu & 31); }
#endif
        PH_SYNC(base + 1);
#ifndef NO_B2
        if (PH_IN(base + 2)) ml::b2_scan(F);
#endif
        PH_SYNC(base + 2);
    }
    if (PH_IN(base + 3)) {
#if NAIVE_MIX
        if (F.vcu < 8) naive_mlstm_unit(F, a, L, F.vcu);
#else
#ifndef NO_B3
        ml::b3_unit(F, a, L, F.vcu >> 5, F.vcu & 31);
#endif
#endif
#if NAIVE_ATTN
        for (int u = F.vcu; u < 512; u += F.G) naive_attn_unit(F, a, L, u);
#else
        { const int bh = F.vcu >> 5, s_ = F.vcu & 31;
#ifndef NO_AT
          att::attn_unit(F, a, L, bh >> 2, bh & 3, s_);
          att::attn_unit(F, a, L, bh >> 2, bh & 3, 63 - s_);
#endif
 }
#endif
    }
    PH_SYNC(base + 3);
    if (PH_IN(base + 4)) {
        pg8::Gemm g{XN  , (const bf16*)(a.ws + WS_WOUT) + (size_t)L * DMODEL * DMODEL, TOK, DMODEL, DMODEL}; pg8::StaticOrder S; S.init(TOK, DMODEL, F.G, (int)blockIdx.x);
        pg8::EpiRes E{L == 0 ? a.x : a.out, a.out};
        pg8::gemm_phase<pg8::EpiRes, pg8::StaticOrder, false, true>(F.lds, g, S, E);
    }
    PH_SYNC(base + 4);
    if (PH_IN(base + 5)) {
        if (L + 1 < DEPTH) phase_rownorm(F, a.out, a.norm_w + (L + 1) * DMODEL, a.w_in + (size_t)(L + 1) * DMODEL * DIN, a.i_bias + (L + 1) * 4, a.f_bias + (L + 1) * 4, XN, GATES, nullptr);
        else phase_rownorm(F, a.out, a.fnw, nullptr, nullptr, nullptr, nullptr, nullptr, a.out);
    }
    if (L + 1 < DEPTH) PH_SYNC(base + 5);
}
__global__ void __launch_bounds__(512, 2) fwd_kernel(Args a) {
    extern __shared__ __attribute__((aligned(16))) unsigned char lds_raw[];
    Frame F; F.lds = (LAS unsigned char*)lds_raw; F.tid = threadIdx.x; F.lane = F.tid & 63; F.wave = __builtin_amdgcn_readfirstlane(F.tid >> 6);
    F.G = gridDim.x; { const int bx = blockIdx.x; F.vcu = (F.G % 8 == 0) ? (bx % 8) * (F.G / 8) + bx / 8 : bx; }
    F.ws = a.ws;
    const int lo = a.ph_lo, hi = a.ph_hi;
    volatile LAS unsigned* MISC = (volatile LAS unsigned*)(F.lds + MISC_OFF);
    if (F.tid < 16) MISC[F.tid] = 0u;
    __syncthreads();
    XcdBarrier bar = xcd_barrier_post((unsigned*)(a.ws + WS_CTL) + 4096, MISC + 8);
    if (PH_IN(0)) {
        phase_prologue(F, a);
        phase_rownorm(F, a.x, a.norm_w, a.w_in, a.i_bias, a.f_bias, (bf16*)(a.ws + WS_XN), (float*)(a.ws + WS_GATES), nullptr);
    }
    PH_SYNC(0);
    layer_phases<0>(F, a, lo, hi, bar);
    layer_phases<1>(F, a, lo, hi, bar);
}

extern "C" void kernel_launch(void* const* d_in, const int* in_sizes, int n_in, void* d_out, int out_size, void* d_ws, size_t ws_size, hipStream_t stream) {
    static int grid = 0;
    if (grid == 0) {
        if (n_in != 16 || in_sizes[0] != TOK * DMODEL || out_size != TOK * DMODEL || ws_size < WS_END) { fprintf(stderr, "kernel_launch: unexpected shapes (n_in %d, in0 %d, out %d, ws %zu)\n", n_in, n_in > 0 ? in_sizes[0] : -1, out_size, ws_size); grid = -1; return; }
        int dev = 0, cus = 0, per_cu = 0;
        hipGetDevice(&dev); hipDeviceGetAttribute(&cus, hipDeviceAttributeMultiprocessorCount, dev);
        if (hipFuncSetAttribute((const void*)fwd_kernel, hipFuncAttributeMaxDynamicSharedMemorySize, LDS_BYTES) != hipSuccess) { fprintf(stderr, "kernel_launch: hipFuncSetAttribute failed\n"); grid = -1; return; }
        hipOccupancyMaxActiveBlocksPerMultiprocessor(&per_cu, (const void*)fwd_kernel, 512, LDS_BYTES);
        (void)hipGetLastError();
        if (per_cu < 1) { fprintf(stderr, "kernel_launch: occupancy query says %d blocks per CU\n", per_cu); grid = -1; return; }
        grid = cus;
        if (grid != 256) { fprintf(stderr, "kernel_launch: this kernel's static schedules need exactly 256 CUs (got %d); nothing launched\n", grid); grid = -1; return; }
    }
    if (grid < 0) return;
    Args a{};
    a.x = (const float*)d_in[0]; a.norm_w = (const float*)d_in[1]; a.w_in = (const float*)d_in[2]; a.conv_w = (const float*)d_in[3]; a.conv_b = (const float*)d_in[4];
    a.i_bias = (const float*)d_in[5]; a.f_bias = (const float*)d_in[6]; a.m_norm_w = (const float*)d_in[7]; a.m_skip = (const float*)d_in[8];
    a.lq1 = (const float*)d_in[9]; a.lk1 = (const float*)d_in[10]; a.lq2 = (const float*)d_in[11]; a.lk2 = (const float*)d_in[12]; a.a_norm_w = (const float*)d_in[13];
    a.w_out = (const float*)d_in[14]; a.fnw = (const float*)d_in[15]; a.out = (float*)d_out; a.ws = (unsigned char*)d_ws;
#if MK_ONE_LAUNCH
    if (hipMemsetAsync((char*)d_ws + WS_CTL, 0, 65536, stream) != hipSuccess) { fprintf(stderr, "kernel_launch: hipMemsetAsync failed\n"); return; }
    a.ph_lo = 0; a.ph_hi = N_PHASES;
    void* args[] = {&a};
    hipError_t e = hipLaunchCooperativeKernel((const void*)fwd_kernel, dim3(grid), dim3(512), args, LDS_BYTES, stream);
    if (e != hipSuccess) fprintf(stderr, "cooperative launch failed: %s (grid %d)\n", hipGetErrorString(e), grid);
#else
    for (int ph = 0; ph < N_PHASES; ++ph) {
        if (ph > 0) { const int s = (ph - 1) % 6; if (!HAS_B12 && (s == 1 || s == 2)) continue; }
        a.ph_lo = ph; a.ph_hi = ph + 1;
        hipLaunchKernelGGL(fwd_kernel, dim3(grid), dim3(512), LDS_BYTES, stream, a);
    }
#endif
}
```

```cpp
#include <hip/hip_runtime.h>
#include <hip/hip_cooperative_groups.h>
#include <cstdio>
#include <cstdint>
namespace cg = cooperative_groups;

#ifndef MK_ONE_LAUNCH
#define MK_ONE_LAUNCH 1
#endif

namespace pg8 {
#define PG8_LAS __attribute__((address_space(3)))
typedef unsigned short bf16_t;
typedef short bf16x8 __attribute__((ext_vector_type(8)));
typedef float f32x4 __attribute__((ext_vector_type(4)));
typedef unsigned u32x4 __attribute__((ext_vector_type(4)));
constexpr int BM = 256, BK = 64, HALF = 128, HTB = HALF * BK * 2  , STAGE_BYTES = 8 * HTB, NXCD = 8, WGM = 8;

__host__ __device__ __forceinline__ int lds_byte(int r, int c) { const int st = (r >> 4) * 2 + (c >> 5), rr = r & 15, cc = c & 31, ob = rr * 64 + cc * 2; return st * 1024 + (ob ^ (((ob >> 9) & 1) << 5)); }
__host__ __device__ __forceinline__ void stage_rc(int b, int& R, int& C) { const int st = b / 1024, sb = b % 1024, swz = sb ^ (((sb >> 9) & 1) << 5); R = (st >> 1) * 16 + swz / 64; C = (st & 1) * 32 + (swz % 64) / 2; }
__host__ __device__ __forceinline__ int perm32(int rho) { const int n = rho >> 4, i = rho & 15; return 8 * (i >> 2) + 4 * n + (i & 3); }

struct Unit { int pm, pn; };
struct Gemm { const bf16_t* A; const bf16_t* Bt; int M, N, K; };

struct StaticOrder {
    int nM, nN, nwg, G, c;
    __host__ __device__ void init(int M, int N, int G_, int c_) { nM = M / BM; nN = N / BM; nwg = nM * nN; G = G_; c = c_; }
    __host__ __device__ bool next(int i, Unit& u) const {
        const long L = (long)i * G + c; if (L >= nwg) return false;
        int wgid = (int)L; { const int q = nwg / NXCD, r = nwg % NXCD, xcd = wgid % NXCD, off = wgid / NXCD; wgid = (xcd < r ? xcd * (q + 1) : r * (q + 1) + (xcd - r) * q) + off; }
        const int nig = WGM * nN, gid = wgid / nig, fm = gid * WGM, gsz = (nM - fm) < WGM ? (nM - fm) : WGM;
        u.pm = fm + ((wgid % nig) % gsz); u.pn = (wgid % nig) / gsz; return true;
    }
    __device__ __forceinline__ void a_ready(const Unit&) const {}
    __device__ __forceinline__ void done(const Unit&) const {}
};


__device__ __forceinline__ unsigned cvt_pk_bf16(float lo, float hi) { unsigned r; asm volatile("v_cvt_pk_bf16_f32 %0, %1, %2" : "=v"(r) : "v"(lo), "v"(hi)); return r; }
typedef unsigned u32x2 __attribute__((ext_vector_type(2)));

struct EpiProj {
    static constexpr bool PERM = true, AFTER_DRAIN = false;
    bf16_t* P; const float* cosT; const float* sinT; float c2;
    __device__ __forceinline__ void operator()(const f32x4 (&acc)[2][2][4][2], const Unit& u, int wr, int wc, int fr, int fq) const {
        const int row0 = u.pm * BM + wr * 64 + fr;
        const int kind = (u.pn >= 8 && u.pn < 12) ? (u.pn < 10 ? 1 : 2) : 0;
        if (kind == 0) {
            const int col0 = u.pn * BM + wc * 32 + 8 * fq;
#pragma unroll
            for (int ai = 0; ai < 2; ++ai)
#pragma unroll
                for (int m = 0; m < 4; ++m) { bf16_t* rowp = P + (size_t)(row0 + ai * HALF + m * 16) * 4096 + col0;
#pragma unroll
                    for (int bj = 0; bj < 2; ++bj) { const f32x4 v0 = acc[ai][bj][m][0], v1 = acc[ai][bj][m][1];
                        u32x4 w; w.x = cvt_pk_bf16(v0[0], v0[1]); w.y = cvt_pk_bf16(v0[2], v0[3]); w.z = cvt_pk_bf16(v1[0], v1[1]); w.w = cvt_pk_bf16(v1[2], v1[3]);
                        *(u32x4*)(rowp + bj * HALF) = w; } }
        } else {
            const float sc = (kind == 1) ? c2 : 1.0f;
#pragma unroll
            for (int ai = 0; ai < 2; ++ai)
#pragma unroll
                for (int m = 0; m < 4; ++m) { const int row = row0 + ai * HALF + m * 16; const int pos = row & 8191;
#pragma unroll
                    for (int bj = 0; bj < 2; ++bj) { const f32x4 v0 = acc[ai][bj][m][0], v1 = acc[ai][bj][m][1];
                        const int cg_ = u.pn * BM + bj * HALF + wc * 32 + 8 * fq; const int i0 = (cg_ & 63) >> 1; const int gb = cg_ & ~63;
                        const f32x4 cs = *(const f32x4*)(cosT + pos * 32 + i0), sn = *(const f32x4*)(sinT + pos * 32 + i0);
                        const f32x4 x1 = (f32x4){v0[0], v0[2], v1[0], v1[2]}, x2 = (f32x4){v0[1], v0[3], v1[1], v1[3]};
                        const f32x4 o1 = (x1 * cs - x2 * sn) * sc, o2 = (x2 * cs + x1 * sn) * sc;
                        u32x2 w1, w2; w1.x = cvt_pk_bf16(o1[0], o1[1]); w1.y = cvt_pk_bf16(o1[2], o1[3]); w2.x = cvt_pk_bf16(o2[0], o2[1]); w2.y = cvt_pk_bf16(o2[2], o2[3]);
                        bf16_t* dst = P + (size_t)row * 4096 + gb + i0;
                        *(u32x2*)dst = w1; *(u32x2*)(dst + 32) = w2; } }
        }
    }
};
struct EpiRes {
    static constexpr bool PERM = false, AFTER_DRAIN = false;
    const float* base; float* out;
    __device__ __forceinline__ void operator()(const f32x4 (&acc)[2][2][4][2], const Unit& u, int wr, int wc, int fr, int fq) const {
        const int row0 = u.pm * BM + wr * 64 + fr, col0 = u.pn * BM + wc * 32 + 4 * fq;
#pragma unroll
        for (int ai = 0; ai < 2; ++ai)
#pragma unroll
            for (int m = 0; m < 4; ++m) { const size_t off = (size_t)(row0 + ai * HALF + m * 16) * 1024 + col0;
#pragma unroll
                for (int bj = 0; bj < 2; ++bj)
#pragma unroll
                    for (int n = 0; n < 2; ++n) { const f32x4 bs = *(const f32x4*)(base + off + bj * HALF + n * 16); *(f32x4*)(out + off + bj * HALF + n * 16) = bs + acc[ai][bj][m][n]; }
                if (m & 1) asm volatile("" ::: "memory"); }
    }
};

template <class Epi, class Sched, bool ALIGN_EPI = false, bool SP2 = false>
__device__ __forceinline__ void gemm_phase(PG8_LAS unsigned char* lds, const Gemm g, const Sched& S, const Epi& E) {
    const int tid = threadIdx.x, wid = __builtin_amdgcn_readfirstlane(tid >> 6), lane = tid & 63, wr = wid >> 2, wc = wid & 3, fr = lane & 15, fq = lane >> 4;
    const int K = g.K, nt = K / BK;
    unsigned voffA[2], voffB[2];
#pragma unroll
    for (int i = 0; i < 2; ++i) { int R, C; stage_rc(tid * 16 + i * 8192, R, C); const int Rb = Epi::PERM ? ((R & ~31) + perm32(R & 31)) : R;
        voffA[i] = (unsigned)(R * K + C) * 2u; voffB[i] = (unsigned)(Rb * K + C) * 2u; }
    const size_t kstep = (size_t)(BK * 2);
    const size_t hstep = (size_t)HALF * K * 2;
    const size_t tstep = 2 * hstep;
    const unsigned ldsw = (unsigned)wid * 1024u;
    const int aoff = lds_byte(wr * 64 + fr, fq * 8), boff = lds_byte(wc * 32 + fr, fq * 8);
#define PG8_SA(b, h) (((b) * 2 + (h)) * HTB)
#define PG8_SB(b, h) ((4 + (b) * 2 + (h)) * HTB)
#define PG8_STAGE(bufoff, gbase, voff) do { _Pragma("unroll") for (int _i = 0; _i < 2; ++_i) \
        __builtin_amdgcn_global_load_lds((const unsigned*)((const char*)(gbase) + (voff)[_i]), (PG8_LAS unsigned*)(lds + (bufoff) + ldsw + _i * 8192), 16, 0, 0); } while (0)
#define PG8_LDA(dst, b, h) do { _Pragma("unroll") for (int m = 0; m < 4; ++m) _Pragma("unroll") for (int k = 0; k < 2; ++k) dst[m][k] = *(const PG8_LAS bf16x8*)(lds + PG8_SA(b, h) + aoff + m * 2048 + k * 1024); } while (0)
#define PG8_LDB(dst, b, h) do { _Pragma("unroll") for (int n = 0; n < 2; ++n) _Pragma("unroll") for (int k = 0; k < 2; ++k) dst[n][k] = *(const PG8_LAS bf16x8*)(lds + PG8_SB(b, h) + boff + n * 2048 + k * 1024); } while (0)
#define PG8_MMA(ai, bj, At, Bt) do { __builtin_amdgcn_s_setprio(1); _Pragma("unroll") for (int m = 0; m < 4; ++m) _Pragma("unroll") for (int n = 0; n < 2; ++n) _Pragma("unroll") for (int k = 0; k < 2; ++k) \
        acc[ai][bj][m][n] = __builtin_amdgcn_mfma_f32_16x16x32_bf16(Bt[n][k], At[m][k], acc[ai][bj][m][n], 0, 0, 0); __builtin_amdgcn_s_setprio(0); } while (0)
#define PG8_WAIT_V(n) asm volatile("s_waitcnt vmcnt(" #n ")" ::: "memory")
#define PG8_WAIT_L(n) asm volatile("s_waitcnt lgkmcnt(" #n ")" ::: "memory")
#define PG8_BAR __builtin_amdgcn_s_barrier()
#define PG8_SCHED __builtin_amdgcn_sched_barrier(0)
    Unit cur, nxt; int ui = 0;
    if (!S.next(0, cur)) return;
    f32x4 acc[2][2][4][2];
#pragma unroll
    for (int a = 0; a < 2; ++a)
#pragma unroll
        for (int b = 0; b < 2; ++b)
#pragma unroll
            for (int m = 0; m < 4; ++m)
#pragma unroll
                for (int n = 0; n < 2; ++n) acc[a][b][m][n] = (f32x4){0.f, 0.f, 0.f, 0.f};
    bf16x8 At[4][2], B0[2][2], B1[2][2];
    const char* cA = (const char*)g.A + (size_t)cur.pm * tstep; const char* cB = (const char*)g.Bt + (size_t)cur.pn * tstep;
    S.a_ready(cur);
    if constexpr (SP2) {
        PG8_STAGE(PG8_SB(0, 0), cB, voffB); PG8_STAGE(PG8_SB(0, 1), cB + hstep, voffB); PG8_STAGE(PG8_SA(0, 0), cA, voffA); PG8_STAGE(PG8_SA(0, 1), cA + hstep, voffA);
        if (wr == 1) PG8_BAR;
        PG8_WAIT_V(2); PG8_BAR;
        PG8_STAGE(PG8_SB(1, 0), cB + kstep, voffB); PG8_STAGE(PG8_SA(1, 0), cA + kstep, voffA); PG8_STAGE(PG8_SB(1, 1), cB + hstep + kstep, voffB);
        PG8_WAIT_V(6); PG8_BAR;
    } else {
        PG8_STAGE(PG8_SB(0, 0), cB, voffB); PG8_STAGE(PG8_SA(0, 0), cA, voffA); PG8_STAGE(PG8_SB(0, 1), cB + hstep, voffB); PG8_STAGE(PG8_SA(0, 1), cA + hstep, voffA);
        if (wr == 1) PG8_BAR;
        PG8_WAIT_V(4); PG8_BAR;
        PG8_STAGE(PG8_SB(1, 0), cB + kstep, voffB); PG8_STAGE(PG8_SA(1, 0), cA + kstep, voffA); PG8_STAGE(PG8_SB(1, 1), cB + hstep + kstep, voffB);
        PG8_WAIT_V(6); PG8_BAR;
    }
    for (;;) {
        const bool has_next = S.next(ui + 1, nxt);
        const char* nA = has_next ? (const char*)g.A + (size_t)nxt.pm * tstep : cA; const char* nB = has_next ? (const char*)g.Bt + (size_t)nxt.pn * tstep : cB;
        for (int t = 0; t < nt; t += 2) {
            const bool last = (t == nt - 2);
            const char* a1 = cA + (size_t)(t + 1) * kstep;
            const char* a2 = last ? nA : cA + (size_t)(t + 2) * kstep; const char* b2 = last ? nB : cB + (size_t)(t + 2) * kstep;
            const char* a3 = a2 + kstep; const char* b3 = b2 + kstep;
            if (last && has_next) S.a_ready(nxt);
            if constexpr (SP2) {
            PG8_LDB(B0, 0, 0); PG8_LDB(B1, 0, 1); PG8_SCHED; PG8_LDA(At, 0, 0); PG8_STAGE(PG8_SA(1, 1), a1 + hstep, voffA);
            PG8_WAIT_V(8); PG8_WAIT_L(0); PG8_BAR; PG8_MMA(0, 0, At, B0); PG8_MMA(0, 1, At, B1); PG8_BAR; PG8_SCHED;
            PG8_LDA(At, 0, 1); PG8_STAGE(PG8_SB(0, 0), b2, voffB); PG8_STAGE(PG8_SB(0, 1), b2 + hstep, voffB); PG8_STAGE(PG8_SA(0, 0), a2, voffA);
            PG8_WAIT_V(8); PG8_WAIT_L(0); PG8_BAR; PG8_MMA(1, 0, At, B0); PG8_MMA(1, 1, At, B1); PG8_BAR; PG8_SCHED;
            PG8_LDB(B0, 1, 0); PG8_LDB(B1, 1, 1); PG8_SCHED; PG8_LDA(At, 1, 0); PG8_STAGE(PG8_SA(0, 1), a2 + hstep, voffA);
            PG8_WAIT_V(8); PG8_WAIT_L(0); PG8_BAR; PG8_MMA(0, 0, At, B0); PG8_MMA(0, 1, At, B1); PG8_BAR; PG8_SCHED;
            PG8_LDA(At, 1, 1); PG8_STAGE(PG8_SB(1, 0), b3, voffB); PG8_STAGE(PG8_SB(1, 1), b3 + hstep, voffB); PG8_STAGE(PG8_SA(1, 0), a3, voffA);
            PG8_WAIT_V(8); PG8_WAIT_L(0); PG8_BAR; PG8_MMA(1, 0, At, B0); PG8_MMA(1, 1, At, B1); PG8_BAR; PG8_SCHED;
            } else {
            PG8_LDB(B0, 0, 0); PG8_SCHED; PG8_LDA(At, 0, 0); PG8_STAGE(PG8_SA(1, 1), a1 + hstep, voffA);
            PG8_WAIT_L(8); PG8_BAR; PG8_WAIT_L(0); PG8_MMA(0, 0, At, B0); PG8_BAR; PG8_SCHED;
            PG8_LDB(B1, 0, 1); PG8_STAGE(PG8_SB(0, 0), b2, voffB);
            PG8_BAR; PG8_WAIT_L(0); PG8_MMA(0, 1, At, B1); PG8_BAR;
            PG8_LDA(At, 0, 1); PG8_STAGE(PG8_SA(0, 0), a2, voffA);
            PG8_BAR; PG8_WAIT_L(0); PG8_MMA(1, 0, At, B0); PG8_BAR; PG8_SCHED;
            PG8_STAGE(PG8_SB(0, 1), b2 + hstep, voffB);
            PG8_WAIT_V(6); PG8_BAR; PG8_MMA(1, 1, At, B1); PG8_BAR;
            PG8_LDB(B0, 1, 0); PG8_SCHED; PG8_LDA(At, 1, 0); PG8_STAGE(PG8_SA(0, 1), a2 + hstep, voffA);
            PG8_WAIT_L(8); PG8_BAR; PG8_WAIT_L(0); PG8_MMA(0, 0, At, B0); PG8_BAR; PG8_SCHED;
            PG8_LDB(B1, 1, 1); PG8_STAGE(PG8_SB(1, 0), b3, voffB);
            PG8_BAR; PG8_WAIT_L(0); PG8_MMA(0, 1, At, B1); PG8_BAR;
            PG8_LDA(At, 1, 1); PG8_STAGE(PG8_SA(1, 0), a3, voffA);
            PG8_BAR; PG8_WAIT_L(0); PG8_MMA(1, 0, At, B0); PG8_BAR; PG8_SCHED;
            PG8_STAGE(PG8_SB(1, 1), b3 + hstep, voffB);
            PG8_WAIT_V(6); PG8_BAR; PG8_MMA(1, 1, At, B1); PG8_BAR;
            }
        }
        if constexpr (ALIGN_EPI) { if (wr == 0) PG8_BAR; }
        if constexpr (!Epi::AFTER_DRAIN) { E(acc, cur, wr, wc, fr, fq); S.done(cur); }
        if (!has_next) break;
#pragma unroll
        for (int a = 0; a < 2; ++a)
#pragma unroll
            for (int b = 0; b < 2; ++b)
#pragma unroll
                for (int m = 0; m < 4; ++m)
#pragma unroll
                    for (int n = 0; n < 2; ++n) acc[a][b][m][n] = (f32x4){0.f, 0.f, 0.f, 0.f};
        cur = nxt; cA = nA; cB = nB; ++ui;
        if constexpr (ALIGN_EPI) { if (wr == 1) PG8_BAR; }
    }
    PG8_WAIT_V(0);
    if constexpr (!ALIGN_EPI) { if (wr == 0) PG8_BAR; }
    PG8_BAR;
    if constexpr (Epi::AFTER_DRAIN) { E.fused(acc, cur, wr, wc, fr, fq, lds, wid, lane); S.done(cur); }
#undef PG8_SA
#undef PG8_SB
#undef PG8_STAGE
#undef PG8_LDA
#undef PG8_LDB
#undef PG8_MMA
#undef PG8_WAIT_V
#undef PG8_WAIT_L
#undef PG8_BAR
#undef PG8_SCHED
}
}

constexpr int BATCH = 2, SEQ = 8192, DMODEL = 1024, DEPTH = 2, TOK = BATCH * SEQ;
constexpr int DIN = 4104, NPROJ = 4096;
constexpr int C_MQ = 0, C_MK = 512, C_MV = 1024, C_MZ = 1536, C_AQ = 2048, C_AK = 2560, C_AV = 3072, C_AZ = 3584;
constexpr float EPS = 1e-6f;
constexpr float C2 = 0.125f * 1.4426950408889634f;
constexpr float KSCALE = 0.08838834764831845f;
__constant__ float INVF[32] = {1.000000000e+00f, 7.498942018e-01f, 5.623413324e-01f, 4.216965139e-01f, 3.162277639e-01f, 2.371373624e-01f, 1.778279394e-01f, 1.333521456e-01f, 1.000000015e-01f, 7.498941571e-02f, 5.623412877e-02f, 4.216964915e-02f, 3.162277862e-02f, 2.371373586e-02f, 1.778279431e-02f, 1.333521493e-02f, 9.999999776e-03f, 7.498942316e-03f, 5.623413250e-03f, 4.216964822e-03f, 3.162277862e-03f, 2.371373819e-03f, 1.778279431e-03f, 1.333521446e-03f, 1.000000047e-03f, 7.498941850e-04f, 5.623413017e-04f, 4.216964880e-04f, 3.162277862e-04f, 2.371373848e-04f, 1.778279402e-04f, 1.333521504e-04f};
__device__ __forceinline__ float lambda_init(int l) { return l == 0 ? 0.2f : 0.35550906759096934f; }

constexpr size_t MiB = 1u << 20;
constexpr size_t WS_CTL = 0, CTL_ZERO_BYTES = 1 * MiB;
constexpr size_t WS_WIN = 2 * MiB;
constexpr size_t WS_WOUT = 18 * MiB;
constexpr size_t WS_COS = 22 * MiB, WS_SIN = 23 * MiB;
constexpr size_t WS_LAM = 24 * MiB;
constexpr size_t WS_GATES = 25 * MiB;
constexpr size_t WS_DC = 32 * MiB, WS_CST = 48 * MiB;
constexpr size_t WS_XN = 56 * MiB;
constexpr size_t WS_PROJ = 88 * MiB;
constexpr size_t WS_QC = 216 * MiB, WS_KC = 232 * MiB, WS_END = 248 * MiB;

constexpr int RING_BYTES = 131072, LDS_BYTES = 147456, MISC_OFF = 147200;

typedef unsigned short bf16;
typedef float f32x4 __attribute__((ext_vector_type(4)));
typedef unsigned v4u __attribute__((ext_vector_type(4)));
typedef unsigned u32x4_t __attribute__((ext_vector_type(4)));
typedef unsigned u32x2_t __attribute__((ext_vector_type(2)));
#define LAS __attribute__((address_space(3)))
__device__ __forceinline__ float bf2f(unsigned short u) { return __uint_as_float((unsigned)u << 16); }
__device__ __forceinline__ unsigned f2bf(float f) { unsigned u = __builtin_bit_cast(unsigned, f); return (u + 0x7fffu + ((u >> 16) & 1u)) >> 16; }
__device__ __forceinline__ unsigned pk2(float lo, float hi) { return f2bf(lo) | (f2bf(hi) << 16); }
__device__ __forceinline__ float wave_sum(float v) {
#pragma unroll
    for (int o = 1; o < 64; o <<= 1) v += __shfl_xor(v, o);
    return v;
}
__device__ __forceinline__ float silu_f(float x) { return x / (1.0f + __expf(-x)); }
__device__ __forceinline__ float logsigmoid_f(float x) { return fminf(x, 0.f) - log1pf(expf(-fabsf(x))); }

struct Args {
    const float* x; const float* norm_w; const float* w_in; const float* conv_w; const float* conv_b; const float* i_bias; const float* f_bias; const float* m_norm_w;
    const float* m_skip; const float* lq1; const float* lk1; const float* lq2; const float* lk2; const float* a_norm_w; const float* w_out; const float* fnw;
    float* out; unsigned char* ws; int ph_lo, ph_hi;
};

__device__ __forceinline__ int src_col(int g) {
    if (g < 1536) return g;
    if (g < 2048) return g + 8;
    if (g < 3072) { const int base = (g < 2560) ? 2056 : 2568; const int j = (g - 2048) & 511; const int grp = j >> 6, jj = j & 63; return base + grp * 64 + (jj >> 1) + 32 * (jj & 1); }
    return g + 8;
}
template <bool MAP> __device__ __forceinline__ void transpose_item(const float* W, int ldw, int K, int N, bf16* WT, LAS float* scr, int item, int lane) {
    const int nblk = N / 32, kb = item / nblk, nb = item % nblk, k0 = 64 * kb, n0 = 32 * nb;
    const int sc = MAP ? src_col(n0 + (lane & 31)) : (n0 + (lane & 31));
#pragma unroll 8
    for (int i = 0; i < 32; ++i) { const int kk = 2 * i + (lane >> 5); scr[kk * 33 + (lane & 31)] = W[(size_t)(k0 + kk) * ldw + sc]; }
    asm volatile("s_waitcnt lgkmcnt(0)" ::: "memory");
    const int c = lane & 7;
#pragma unroll
    for (int j = 0; j < 4; ++j) { const int n = (lane >> 3) + 8 * j; const LAS float* s = scr + (8 * c) * 33 + n;
        v4u o; o.x = pk2(s[0 * 33], s[1 * 33]); o.y = pk2(s[2 * 33], s[3 * 33]); o.z = pk2(s[4 * 33], s[5 * 33]); o.w = pk2(s[6 * 33], s[7 * 33]);
        *(v4u*)(WT + (size_t)(n0 + n) * K + k0 + 8 * c) = o; }
    asm volatile("s_waitcnt lgkmcnt(0)" ::: "memory");
}
__device__ __forceinline__ void sincos_acc(float xf, float& s, float& c) {
    const double x = (double)xf; const double k = __builtin_rint(x * 0.63661977236758134308);
    const double r = (x - k * 1.57079632679489655800) - k * 6.123233995736766e-17; const double r2 = r * r;
    double sp = r2 * (-1.0 / 6227020800.0) + (1.0 / 39916800.0); sp = sp * r2 - (1.0 / 362880.0); sp = sp * r2 + (1.0 / 5040.0); sp = sp * r2 - (1.0 / 120.0); sp = sp * r2 + (1.0 / 6.0); sp = r - r * r2 * sp;
    double cp = r2 * (1.0 / 87178291200.0) - (1.0 / 479001600.0); cp = cp * r2 + (1.0 / 3628800.0); cp = cp * r2 - (1.0 / 40320.0); cp = cp * r2 + (1.0 / 720.0); cp = cp * r2 - (1.0 / 24.0); cp = cp * r2 + 0.5; cp = 1.0 - r2 * cp;
    const int q = ((int)k) & 3;
    const double ss = (q == 0) ? sp : (q == 1) ? cp : (q == 2) ? -sp : -cp;
    const double cc = (q == 0) ? cp : (q == 1) ? -sp : (q == 2) ? -cp : sp;
    s = (float)ss; c = (float)cc;
}

struct Frame {
    LAS unsigned char* lds; int tid, lane, wave, vcu, G;
    unsigned char* ws;
};

__device__ __forceinline__ void phase_prologue(const Frame& F, const Args& a) {
    LAS float* scr = (LAS float*)(F.lds + F.wave * 16384);
    const int gw = F.vcu * 8 + F.wave, NGW = F.G * 8;
    constexpr int I_IN = (DMODEL / 64) * (NPROJ / 32), I_OUT = (DMODEL / 64) * (DMODEL / 32);
    constexpr int NITEMS = DEPTH * (I_IN + I_OUT);
    for (int it = gw; it < NITEMS; it += NGW) {
        int r = it; const int l = r / (I_IN + I_OUT); r -= l * (I_IN + I_OUT);
        if (r < I_IN) transpose_item<true>(a.w_in + (size_t)l * DMODEL * DIN, DIN, DMODEL, NPROJ, (bf16*)(F.ws + WS_WIN) + (size_t)l * NPROJ * DMODEL, scr, r, F.lane);
        else transpose_item<false>(a.w_out + (size_t)l * DMODEL * DMODEL, DMODEL, DMODEL, DMODEL, (bf16*)(F.ws + WS_WOUT) + (size_t)l * DMODEL * DMODEL, scr, r - I_IN, F.lane);
    }
    float* cosT = (float*)(F.ws + WS_COS); float* sinT = (float*)(F.ws + WS_SIN);
    for (int idx = (F.vcu * 512 + F.tid); idx < SEQ * 32; idx += F.G * 512) {
        const int pos = idx >> 5, i = idx & 31; const float ang = (float)pos * INVF[i]; float s, c; sincos_acc(ang, s, c); cosT[idx] = c; sinT[idx] = s;
    }
    if (F.vcu == 0 && F.wave < DEPTH) {
        const int l = F.wave;
        const float p1 = wave_sum(a.lq1[l * 64 + F.lane] * a.lk1[l * 64 + F.lane]), p2 = wave_sum(a.lq2[l * 64 + F.lane] * a.lk2[l * 64 + F.lane]);
        if (F.lane == 0) ((float*)(F.ws + WS_LAM))[l] = expf(p1) - expf(p2) + lambda_init(l);
    }
}

__device__ __forceinline__ void phase_rownorm(const Frame& F, const float* xin, const float* nw, const float* wg_src, const float* ib, const float* fb, bf16* XN, float* GATES, float* fout) {
    LAS float* WG = (LAS float*)F.lds;
    __syncthreads();
    if (wg_src) {
        for (int idx = F.tid; idx < 8192; idx += 512) { const int k = idx >> 3, g = idx & 7; WG[g * 1024 + k] = wg_src[(size_t)k * DIN + 1536 + g]; }
    }
    __syncthreads();
    const int gw = F.vcu * 8 + F.wave, NGW = F.G * 8;
    f32x4 nwv[4];
#pragma unroll
    for (int j = 0; j < 4; ++j) nwv[j] = ((const f32x4*)nw)[64 * j + F.lane];
    for (int row = gw; row < TOK; row += NGW) {
        const f32x4* xr = (const f32x4*)(xin + (size_t)row * DMODEL) + F.lane;
        f32x4 v[4]; float s = 0.f;
#pragma unroll
        for (int j = 0; j < 4; ++j) { v[j] = xr[64 * j]; s += (v[j].x * v[j].x + v[j].y * v[j].y) + (v[j].z * v[j].z + v[j].w * v[j].w); }
        const float rstd = 1.0f / sqrtf(wave_sum(s) * (1.0f / DMODEL) + EPS);
#pragma unroll
        for (int j = 0; j < 4; ++j) v[j] = v[j] * rstd * nwv[j];
        if (fout) {
            f32x4* o = (f32x4*)(fout + (size_t)row * DMODEL) + F.lane;
#pragma unroll
            for (int j = 0; j < 4; ++j) o[64 * j] = v[j];
        } else {
            unsigned long long* o8 = (unsigned long long*)(XN + (size_t)row * DMODEL) + F.lane;
#pragma unroll
            for (int j = 0; j < 4; ++j) o8[64 * j] = (unsigned long long)pk2(v[j].x, v[j].y) | ((unsigned long long)pk2(v[j].z, v[j].w) << 32);
            float gs[8];
#pragma unroll
            for (int g = 0; g < 8; ++g) { float t = 0.f;
#pragma unroll
                for (int j = 0; j < 4; ++j) { const f32x4 w = *(const LAS f32x4*)(WG + g * 1024 + 256 * j + 4 * F.lane); t += (v[j].x * w.x + v[j].y * w.y) + (v[j].z * w.z + v[j].w * w.w); }
                gs[g] = wave_sum(t); }
            float mine = gs[0];
#pragma unroll
            for (int g = 1; g < 8; ++g) mine = (F.lane == g) ? gs[g] : mine;
            if (F.lane < 4) GATES[(size_t)row * 8 + F.lane] = mine + ib[F.lane];
            else if (F.lane < 8) GATES[(size_t)row * 8 + F.lane] = logsigmoid_f(mine + fb[F.lane - 4]);
        }
    }
    __syncthreads();
}

__device__ __forceinline__ void naive_mlstm_unit(const Frame& F, const Args& a, int l, int bh) {
    const int b = bh >> 2, h = bh & 3, e = F.tid & 127; const bool act = F.tid < 128;
    LAS float* qs = (LAS float*)F.lds; LAS float* ks = qs + 128; LAS float* red = ks + 128; LAS float* red2 = red + 8;
    const bf16* PROJ = (const bf16*)(F.ws + WS_PROJ); const float* GATES = (const float*)(F.ws + WS_GATES); bf16* Y = (bf16*)(F.ws + WS_XN);
    const float* cw = a.conv_w + (size_t)l * 4 * 1024; const float* cb = a.conv_b + (size_t)l * 1024;
    const int cq = h * 128 + e, ck = 512 + h * 128 + e;
    const float wq0 = cw[cq], wq1 = cw[1024 + cq], wq2 = cw[2048 + cq], wq3 = cw[3072 + cq], bq = cb[cq];
    const float wk0 = cw[ck], wk1 = cw[1024 + ck], wk2 = cw[2048 + ck], wk3 = cw[3072 + ck], bk = cb[ck];
    const float mnw = a.m_norm_w[l * 512 + cq], msk = a.m_skip[l * 512 + cq];
    float C[128];
#pragma unroll
    for (int d = 0; d < 128; ++d) C[d] = 0.f;
    float n_e = 0.f, m = 0.f, xq1 = 0.f, xq2 = 0.f, xq3 = 0.f, xk1 = 0.f, xk2 = 0.f, xk3 = 0.f;
    for (int t = 0; t < SEQ; ++t) {
        const size_t row = (size_t)b * SEQ + t; const bf16* pr = PROJ + row * 4096;
        float qc = 0.f, ve = 0.f, mz = 0.f, a_ = 0.f, bb = 0.f;
        if (act) {
            const float xq0 = bf2f(pr[C_MQ + cq]), xk0 = bf2f(pr[C_MK + cq]); ve = bf2f(pr[C_MV + cq]); mz = bf2f(pr[C_MZ + cq]);
            const float li = GATES[row * 8 + h], lf = GATES[row * 8 + 4 + h];
            qc = silu_f(bq + wq0 * xq3 + wq1 * xq2 + wq2 * xq1 + wq3 * xq0);
            const float kc = silu_f(bk + wk0 * xk3 + wk1 * xk2 + wk2 * xk1 + wk3 * xk0) * KSCALE;
            xq3 = xq2; xq2 = xq1; xq1 = xq0; xk3 = xk2; xk2 = xk1; xk1 = xk0;
            const float m_new = fmaxf(lf + m, li); a_ = expf(lf + m - m_new); bb = expf(li - m_new); m = m_new;
            n_e = a_ * n_e + bb * kc;
            qs[e] = qc; ks[e] = kc;
            const float dp = wave_sum(n_e * qc); if (F.lane == 0) red[F.wave] = dp;
        }
        __syncthreads();
        float hval = 0.f;
        if (act) {
            const float den = red[0] + red[1]; const float bv = bb * ve; float acc = 0.f;
#pragma unroll
            for (int d = 0; d < 128; ++d) { C[d] = a_ * C[d] + bv * ks[d]; acc += C[d] * qs[d]; }
            hval = acc / fmaxf(fabsf(den), expf(-m));
            const float sq = wave_sum(hval * hval); if (F.lane == 0) red2[F.wave] = sq;
        }
        __syncthreads();
        if (act) {
            const float ssq = red2[0] + red2[1];
            const float hm = hval * (1.0f / sqrtf(ssq * (1.0f / 128.0f) + EPS)) * mnw;
            const float ym = (hm + msk * qc) * silu_f(mz);
            Y[row * 1024 + cq] = (bf16)f2bf(ym);
        }
    }
    __syncthreads();
}

__device__ __forceinline__ void naive_attn_unit(const Frame& F, const Args& a, int l, int unit) {
    const int blk = unit & 63, h = (unit >> 6) & 3, b = unit >> 8;
    const int r = F.tid & 127, map = (F.tid >> 7) & 1, half = F.tid >> 8;
    const int q0 = blk * 128, c0 = q0 >> 6, myc = c0 + (r >> 6);
    LAS float* Kf = (LAS float*)F.lds; LAS float* Vf = Kf + 64 * 128; LAS float* Cb = Kf; LAS float* red = Kf + 2 * 64 * 128;
    const bf16* PROJ = (const bf16*)(F.ws + WS_PROJ); bf16* Y = (bf16*)(F.ws + WS_XN);
    const size_t row = (size_t)b * SEQ + q0 + r;
    float q[64], o[64];
    { const bf16* qp = PROJ + row * 4096 + C_AQ + h * 128 + map * 64;
#pragma unroll
      for (int d = 0; d < 64; ++d) q[d] = bf2f(qp[d]); }
#pragma unroll
    for (int e = 0; e < 64; ++e) o[e] = 0.f;
    float m = -1e30f, lsum = 0.f;
    for (int kt = 0; kt <= c0 + 1; ++kt) {
        __syncthreads();
#pragma unroll
        for (int i = 0; i < 2; ++i) { const int id = F.tid + 512 * i, key = id >> 4, c8 = id & 15;
            const bf16* kp = PROJ + ((size_t)b * SEQ + kt * 64 + key) * 4096 + h * 128 + c8 * 8;
            const v4u kk = *(const v4u*)(kp + C_AK), vv = *(const v4u*)(kp + C_AV);
            LAS float* kd = Kf + key * 128 + c8 * 8; LAS float* vd = Vf + key * 128 + c8 * 8;
            kd[0] = __uint_as_float(kk.x << 16); kd[1] = __uint_as_float(kk.x & 0xffff0000u); kd[2] = __uint_as_float(kk.y << 16); kd[3] = __uint_as_float(kk.y & 0xffff0000u);
            kd[4] = __uint_as_float(kk.z << 16); kd[5] = __uint_as_float(kk.z & 0xffff0000u); kd[6] = __uint_as_float(kk.w << 16); kd[7] = __uint_as_float(kk.w & 0xffff0000u);
            vd[0] = __uint_as_float(vv.x << 16); vd[1] = __uint_as_float(vv.x & 0xffff0000u); vd[2] = __uint_as_float(vv.y << 16); vd[3] = __uint_as_float(vv.y & 0xffff0000u);
            vd[4] = __uint_as_float(vv.z << 16); vd[5] = __uint_as_float(vv.z & 0xffff0000u); vd[6] = __uint_as_float(vv.w << 16); vd[7] = __uint_as_float(vv.w & 0xffff0000u); }
        __syncthreads();
        if (kt <= myc) {
            for (int j = 0; j < 64; ++j) {
                const LAS float* kr = Kf + j * 128 + map * 64; const LAS float* vr = Vf + j * 128 + half * 64;
                float s = 0.f;
#pragma unroll
                for (int d = 0; d < 64; ++d) s += q[d] * kr[d];
                const float m_new = fmaxf(m, s), alpha = exp2f(m - m_new), p = exp2f(s - m_new);
                lsum = lsum * alpha + p; m = m_new;
#pragma unroll
                for (int e = 0; e < 64; ++e) o[e] = o[e] * alpha + p * vr[e];
            }
        }
    }
    __syncthreads();
    const float inv_l = 1.0f / lsum; const float lam = ((const float*)(F.ws + WS_LAM))[l];
    if (map == 1) {
#pragma unroll
        for (int e = 0; e < 64; ++e) Cb[r * 128 + half * 64 + e] = lam * o[e] * inv_l;
    }
    __syncthreads();
    float ssq = 0.f;
    if (map == 0) {
#pragma unroll
        for (int e = 0; e < 64; ++e) { o[e] = o[e] * inv_l - Cb[r * 128 + half * 64 + e]; ssq += o[e] * o[e]; }
        red[half * 128 + r] = ssq;
    }
    __syncthreads();
    if (map == 0) {
        const float rstd = 1.0f / sqrtf((red[r] + red[128 + r]) * (1.0f / 128.0f) + EPS); const float g = 1.0f - lambda_init(l);
        const bf16* azp = PROJ + row * 4096 + C_AZ + h * 128 + half * 64; bf16* yp = Y + row * 1024 + 512 + h * 128 + half * 64; const float* anw = a.a_norm_w + l * 128 + half * 64;
#pragma unroll
        for (int e = 0; e < 64; ++e) yp[e] = (bf16)f2bf(o[e] * rstd * anw[e] * g * silu_f(bf2f(azp[e])));
    }
    __syncthreads();
}

namespace att {
typedef short bf16x8 __attribute__((ext_vector_type(8)));
typedef short s16x4 __attribute__((ext_vector_type(4)));
typedef float f32x16 __attribute__((ext_vector_type(16)));
typedef float f32x2_t __attribute__((ext_vector_type(2))); typedef __bf16 bf16x2_t __attribute__((ext_vector_type(2)));
typedef short v4i16_t __attribute__((ext_vector_type(4)));
constexpr int SLOT = 16384, LDS_K = 0, LDS_V = 3 * SLOT, LDS_X = 0, LDS_S = 6 * SLOT, SPITCH = 272, LDS_END = LDS_S + 4 * 32 * SPITCH;
constexpr float THR = 8.0f;
__device__ __forceinline__ void glds16(const void* gsrc, unsigned lds_dst) { unsigned keep;
    asm volatile("s_mov_b32 %0, m0\n\ts_mov_b32 m0, %2\n\ts_nop 0\n\tglobal_load_lds_dwordx4 %1, off\n\ts_mov_b32 m0, %0" : "=&s"(keep) : "v"(gsrc), "s"(lds_dst) : "memory"); }
template <int IMM> __device__ __forceinline__ void glds16s(const void* sbase, unsigned voff, unsigned lds_dst_) { unsigned keep; const unsigned lds_dst = lds_dst_ - (unsigned)IMM;
    asm volatile("s_mov_b32 %0, m0\n\ts_mov_b32 m0, %3\n\ts_nop 0\n\tglobal_load_lds_dwordx4 %1, %2 offset:%c4\n\ts_mov_b32 m0, %0" : "=&s"(keep) : "v"(voff), "s"(sbase), "s"(lds_dst), "i"(IMM) : "memory"); }
__device__ __forceinline__ unsigned cvtpk(float lo, float hi) { f32x2_t v = {lo, hi}; bf16x2_t b = __builtin_convertvector(v, bf16x2_t); return __builtin_bit_cast(unsigned, b); }
__device__ __forceinline__ s16x4 vtr(const LAS char* p) { return __builtin_bit_cast(s16x4, __builtin_amdgcn_ds_read_tr16_b64_v4i16((LAS v4i16_t*)p)); }
__device__ __forceinline__ float swap_max(float m) { auto rr = __builtin_amdgcn_permlane32_swap(__float_as_uint(m), __float_as_uint(m), false, false); return fmaxf(__uint_as_float(rr[0]), __uint_as_float(rr[1])); }
__device__ __forceinline__ float swap_add(float m) { auto rr = __builtin_amdgcn_permlane32_swap(__float_as_uint(m), __float_as_uint(m), false, false); return __uint_as_float(rr[0]) + __uint_as_float(rr[1]); }
#define ATT_WAIT_BAR(N) asm volatile("s_waitcnt vmcnt(" #N ") lgkmcnt(0)\n\ts_barrier" ::: "memory")

__device__ __forceinline__ void attn_unit(const Frame& F, const Args& a, const int L, const int b, const int h, const int j) {
    const int lane = F.lane, r32 = lane & 31, hi = lane >> 5, wid = F.wave, rb = wid & 3, map = wid >> 2;
    const bf16* PROJ = (const bf16*)(F.ws + WS_PROJ); bf16* Y = (bf16*)(F.ws + WS_XN);
    const size_t rowbase = (size_t)b * SEQ; const int q0 = j * 128;
    const int NT = 2 * j + 2, myNT = 2 * j + 1 + (rb >> 1);
    const unsigned lds0 = (unsigned)(uintptr_t)F.lds;
    bf16x8 qr[4];
    { const bf16* qp = PROJ + (rowbase + q0 + rb * 32 + r32) * 4096 + C_AQ + h * 128 + map * 64 + hi * 8;
#pragma unroll
      for (int d0 = 0; d0 < 4; ++d0) qr[d0] = *(const bf16x8*)(qp + d0 * 16); }
    asm volatile("s_waitcnt vmcnt(0)" ::: "memory");
    const bf16* ksrc0 = PROJ + (rowbase + lane) * 4096 + C_AK + h * 128 + wid * 8; const bf16* ksrc1 = ksrc0 + 64;
    const bf16* vsrc0 = PROJ + (rowbase + 16 * (wid & 3) + (lane >> 2)) * 4096 + C_AV + h * 128 + (wid >> 2) * 32 + (lane & 3) * 8; const bf16* vsrc1 = vsrc0 + 64;
    const unsigned kdst = lds0 + LDS_K + wid * 1024, vdst = lds0 + LDS_V + wid * 1024;
#define ATT_DMA(t, slot) do { const size_t to_ = (size_t)(t) * 64 * 4096; const unsigned so_ = (unsigned)(slot) * SLOT; \
        glds16(ksrc0 + to_, (unsigned)__builtin_amdgcn_readfirstlane(kdst + so_)); glds16(ksrc1 + to_, (unsigned)__builtin_amdgcn_readfirstlane(kdst + so_ + 8192)); \
        glds16(vsrc0 + to_, (unsigned)__builtin_amdgcn_readfirstlane(vdst + so_)); glds16(vsrc1 + to_, (unsigned)__builtin_amdgcn_readfirstlane(vdst + so_ + 8192)); } while (0)
    ATT_DMA(0, 0); ATT_DMA(1, 1);
    f32x16 o[4]; o[0] = f32x16{}; o[1] = f32x16{}; o[2] = f32x16{}; o[3] = f32x16{};
    f32x16 negm = f32x16{}; float mhat = 0.f, lsum = 0.f;
    const LAS char* kfrag = (const LAS char*)F.lds + LDS_K + map * 8192 + hi * 1024 + r32 * 16;
    const LAS char* vfrag = (const LAS char*)F.lds + LDS_V + ((lane >> 4) & 1) * 32 + (lane & 3) * 8 + (4 * hi + ((lane & 15) >> 2)) * 64;
    int slot = 0;
    for (int t = 0; t < NT; ++t) {
        if (t + 1 < NT) ATT_WAIT_BAR(4); else ATT_WAIT_BAR(0);
        if (t + 2 < NT) { const int s2 = (slot >= 1) ? slot - 1 : 2; ATT_DMA(t + 2, s2); }
        if (t < myNT) {
            const LAS char* kb = kfrag + slot * SLOT; const LAS char* vb = vfrag + slot * SLOT;
            f32x16 p0, p1;
#pragma unroll
            for (int d0 = 0; d0 < 4; ++d0) {
                const bf16x8 b0 = *(const LAS bf16x8*)(kb + d0 * 2048), b1 = *(const LAS bf16x8*)(kb + d0 * 2048 + 512);
                p0 = __builtin_amdgcn_mfma_f32_32x32x16_bf16(b0, qr[d0], d0 == 0 ? negm : p0, 0, 0, 0);
                p1 = __builtin_amdgcn_mfma_f32_32x32x16_bf16(b1, qr[d0], d0 == 0 ? negm : p1, 0, 0, 0);
            }
            float rm = fmaxf(p0[0], p1[0]);
#pragma unroll
            for (int r = 1; r < 16; ++r) rm = fmaxf(rm, fmaxf(p0[r], p1[r]));
            rm = swap_max(rm);
            if (t == 0 || __any(rm > THR)) {
                const float dl = (t == 0) ? rm : fmaxf(rm, 0.f); mhat += dl;
#pragma unroll
                for (int r = 0; r < 16; ++r) { p0[r] -= dl; p1[r] -= dl; negm[r] = -mhat; }
                const float f = exp2f(-dl); lsum *= f;
#pragma unroll
                for (int d0 = 0; d0 < 4; ++d0)
#pragma unroll
                    for (int r = 0; r < 16; ++r) o[d0][r] *= f;
            }
            float sacc = 0.f;
#pragma unroll
            for (int r = 0; r < 16; ++r) { p0[r] = __builtin_amdgcn_exp2f(p0[r]); p1[r] = __builtin_amdgcn_exp2f(p1[r]); sacc += p0[r] + p1[r]; }
            lsum += sacc;
            bf16x8 pw[4];
            { u32x4_t w0 = {cvtpk(p0[0], p0[1]), cvtpk(p0[2], p0[3]), cvtpk(p0[4], p0[5]), cvtpk(p0[6], p0[7])}; pw[0] = __builtin_bit_cast(bf16x8, w0);
              u32x4_t w1 = {cvtpk(p0[8], p0[9]), cvtpk(p0[10], p0[11]), cvtpk(p0[12], p0[13]), cvtpk(p0[14], p0[15])}; pw[1] = __builtin_bit_cast(bf16x8, w1);
              u32x4_t w2 = {cvtpk(p1[0], p1[1]), cvtpk(p1[2], p1[3]), cvtpk(p1[4], p1[5]), cvtpk(p1[6], p1[7])}; pw[2] = __builtin_bit_cast(bf16x8, w2);
              u32x4_t w3 = {cvtpk(p1[8], p1[9]), cvtpk(p1[10], p1[11]), cvtpk(p1[12], p1[13]), cvtpk(p1[14], p1[15])}; pw[3] = __builtin_bit_cast(bf16x8, w3); }
#pragma unroll
            for (int d0 = 0; d0 < 4; ++d0) {
#pragma unroll
                for (int ks = 0; ks < 4; ++ks) {
                    const s16x4 lo = vtr(vb + d0 * 4096 + ks * 1024), hh = vtr(vb + d0 * 4096 + ks * 1024 + 512);
                    const bf16x8 vf = (bf16x8){lo[0], lo[1], lo[2], lo[3], hh[0], hh[1], hh[2], hh[3]};
                    o[d0] = __builtin_amdgcn_mfma_f32_32x32x16_bf16(vf, pw[ks], o[d0], 0, 0, 0);
                }
            }
        }
        slot = (slot == 2) ? 0 : slot + 1;
    }
    const float inv = 1.0f / swap_add(lsum);
    ATT_WAIT_BAR(0);
    LAS float* X = (LAS float*)(F.lds + LDS_X) + rb * 4096 + lane;
    if (map == 1) {
        const float sc = inv * ((const float*)(F.ws + WS_LAM))[L];
#pragma unroll
        for (int d0 = 0; d0 < 4; ++d0)
#pragma unroll
            for (int r = 0; r < 16; ++r) X[(d0 * 16 + r) * 64] = o[d0][r] * sc;
    }
    ATT_WAIT_BAR(0);
    if (map == 0) {
        float ssq = 0.f;
#pragma unroll
        for (int d0 = 0; d0 < 4; ++d0)
#pragma unroll
            for (int r = 0; r < 16; ++r) { const float v = o[d0][r] * inv - X[(d0 * 16 + r) * 64]; o[d0][r] = v; ssq += v * v; }
        const float rstd = 1.0f / sqrtf(swap_add(ssq) * (1.0f / 128.0f) + EPS);
        LAS char* S = (LAS char*)F.lds + LDS_S + rb * 32 * SPITCH;
#pragma unroll
        for (int d0 = 0; d0 < 4; ++d0)
#pragma unroll
            for (int g4 = 0; g4 < 4; ++g4) { u32x2_t w; w.x = cvtpk(o[d0][4 * g4] * rstd, o[d0][4 * g4 + 1] * rstd); w.y = cvtpk(o[d0][4 * g4 + 2] * rstd, o[d0][4 * g4 + 3] * rstd);
                *(LAS u32x2_t*)(S + r32 * SPITCH + (32 * d0 + 8 * g4 + 4 * hi) * 2) = w; }
        asm volatile("s_waitcnt lgkmcnt(0)" ::: "memory");
        const int ch = lane & 15; const float g = 1.0f - lambda_init(L);
        float anw[8];
#pragma unroll
        for (int k = 0; k < 8; ++k) anw[k] = a.a_norm_w[L * 128 + 8 * ch + k] * g;
#pragma unroll
        for (int it = 0; it < 8; ++it) { const int row = it * 4 + (lane >> 4);
            const u32x4_t sv = *(const LAS u32x4_t*)(S + row * SPITCH + ch * 16);
            const size_t grow = rowbase + q0 + rb * 32 + row;
            const u32x4_t zv = *(const u32x4_t*)(PROJ + grow * 4096 + C_AZ + h * 128 + 8 * ch);
            float v[8], z[8];
#pragma unroll
            for (int k = 0; k < 4; ++k) { v[2 * k] = __uint_as_float(sv[k] << 16); v[2 * k + 1] = __uint_as_float(sv[k] & 0xffff0000u); z[2 * k] = __uint_as_float(zv[k] << 16); z[2 * k + 1] = __uint_as_float(zv[k] & 0xffff0000u); }
            u32x4_t ov;
#pragma unroll
            for (int k = 0; k < 4; ++k) ov[k] = cvtpk(v[2 * k] * anw[2 * k] * silu_f(z[2 * k]), v[2 * k + 1] * anw[2 * k + 1] * silu_f(z[2 * k + 1]));
            *(u32x4_t*)(Y + grow * 1024 + 512 + h * 128 + 8 * ch) = ov; }
    }
    ATT_WAIT_BAR(0);
#undef ATT_DMA
}
typedef const LAS char* lds_cptr;
#define ATT_SBAR() __builtin_amdgcn_sched_barrier(0)
#define ATT_PIN(x) asm volatile("" : "+v"(x))
#define ATT_MX3(a, b, c) __builtin_fmaxf(__builtin_fmaxf((a), (b)), (c))
__device__ __forceinline__ void kload8(bf16x8* kf, lds_cptr kp) {
    kf[0] = *(const LAS bf16x8*)(kp);        kf[1] = *(const LAS bf16x8*)(kp + 512);
    kf[2] = *(const LAS bf16x8*)(kp + 2048); kf[3] = *(const LAS bf16x8*)(kp + 2560);
    kf[4] = *(const LAS bf16x8*)(kp + 4096); kf[5] = *(const LAS bf16x8*)(kp + 4608);
    kf[6] = *(const LAS bf16x8*)(kp + 6144); kf[7] = *(const LAS bf16x8*)(kp + 6656);
}
__device__ __forceinline__ void pv_tail(f32x16 (&o)[4], const u32x4_t& w0, const u32x4_t& w1, const u32x4_t& w2, const u32x4_t& w3, lds_cptr vb) {
    bf16x8 pw[4] = {__builtin_bit_cast(bf16x8, w0), __builtin_bit_cast(bf16x8, w1), __builtin_bit_cast(bf16x8, w2), __builtin_bit_cast(bf16x8, w3)};
#pragma unroll
    for (int ks = 0; ks < 4; ++ks) {
#pragma unroll
        for (int d0 = 0; d0 < 4; ++d0) {
            const s16x4 lo = vtr(vb + d0 * 4096 + ks * 1024), hh = vtr(vb + d0 * 4096 + ks * 1024 + 512);
            const bf16x8 vf = (bf16x8){lo[0], lo[1], lo[2], lo[3], hh[0], hh[1], hh[2], hh[3]};
            o[d0] = __builtin_amdgcn_mfma_f32_32x32x16_bf16(vf, pw[ks], o[d0], 0, 0, 0);
        }
    }
}

__device__ __forceinline__ void attn_unit2(const Frame& F, const Args& a, const int L, const int b, const int h, const int j) {
    const int lane = F.lane, r32 = lane & 31, hi = lane >> 5, wid = F.wave, rb = wid & 3, map = wid >> 2;
    const bf16* PROJ = (const bf16*)(F.ws + WS_PROJ); bf16* Y = (bf16*)(F.ws + WS_XN);
    const size_t rowbase = (size_t)b * SEQ; const int q0 = j * 128;
    const int NT = 2 * j + 2; const bool vis_last = (rb >> 1) != 0;
    const unsigned lds0 = (unsigned)(uintptr_t)F.lds;
    bf16x8 qr[4];
    { const bf16* qp = PROJ + (rowbase + q0 + rb * 32 + r32) * 4096 + C_AQ + h * 128 + map * 64 + hi * 8;
#pragma unroll
      for (int d0 = 0; d0 < 4; ++d0) qr[d0] = *(const bf16x8*)(qp + d0 * 16); }
    asm volatile("s_waitcnt vmcnt(0)" ::: "memory");
    const bf16* kbase = PROJ + rowbase * 4096 + C_AK + h * 128; const bf16* vbase = PROJ + rowbase * 4096 + C_AV + h * 128;
    const unsigned kvoff = (unsigned)(lane * 4096 + wid * 8) * 2u, vvoff = (unsigned)((16 * (wid & 3) + (lane >> 2)) * 4096 + (wid >> 2) * 32 + (lane & 3) * 8) * 2u;
    const unsigned kdst = lds0 + LDS_K + wid * 1024, vdst = lds0 + LDS_V + wid * 1024;
#define DMA_K(t, so) do { const bf16* sb_ = kbase + (size_t)(t) * 64 * 4096; \
        glds16s<0>(sb_, kvoff, (unsigned)__builtin_amdgcn_readfirstlane(kdst + (so))); glds16s<128>(sb_, kvoff, (unsigned)__builtin_amdgcn_readfirstlane(kdst + (so) + 8192)); } while (0)
#define DMA_V(t, so) do { const bf16* sb_ = vbase + (size_t)(t) * 64 * 4096; \
        glds16s<0>(sb_, vvoff, (unsigned)__builtin_amdgcn_readfirstlane(vdst + (so))); glds16s<128>(sb_, vvoff, (unsigned)__builtin_amdgcn_readfirstlane(vdst + (so) + 8192)); } while (0)
    const lds_cptr kp0 = (lds_cptr)F.lds + LDS_K + map * 8192 + hi * 1024 + r32 * 16;
    const lds_cptr vp0 = (lds_cptr)F.lds + LDS_V + ((lane >> 4) & 1) * 32 + (lane & 3) * 8 + (4 * hi + ((lane & 15) >> 2)) * 64;
    DMA_K(0, 0); DMA_V(0, 0); DMA_K(1, SLOT); if (NT > 2) DMA_K(2, 2 * SLOT);
    float mhat = 0.f, l_reg = 0.f; f32x16 o[4]; o[0] = f32x16{}; o[1] = f32x16{}; o[2] = f32x16{}; o[3] = f32x16{};
    f32x16 negm = f32x16{}; asm volatile("" : "+v"(negm));
    bool resc = false; float fres = 1.f;
    f32x16 c0, c1; bf16x8 kf[8]; u32x4_t pwa0, pwa1, pwa2, pwa3, pwb0, pwb1, pwb2, pwb3;
    int sl_prev = 0, sl_cur = 0, sl_next = SLOT;
#define ROT() do { sl_prev = sl_cur; sl_cur = sl_next; sl_next = (sl_next == 2 * SLOT) ? 0 : sl_next + SLOT; } while (0)
#define RESC() do { if (resc) { _Pragma("unroll") for (int d_ = 0; d_ < 4; ++d_) _Pragma("unroll") for (int r = 0; r < 16; ++r) o[d_][r] *= fres; } } while (0)
    if (NT > 2) ATT_WAIT_BAR(6); else ATT_WAIT_BAR(4);
    { kload8(kf, kp0);
#pragma unroll
      for (int d0 = 0; d0 < 4; ++d0) {
          c0 = __builtin_amdgcn_mfma_f32_32x32x16_bf16(kf[2 * d0], qr[d0], d0 == 0 ? negm : c0, 0, 0, 0);
          c1 = __builtin_amdgcn_mfma_f32_32x32x16_bf16(kf[2 * d0 + 1], qr[d0], d0 == 0 ? negm : c1, 0, 0, 0); }
      float rm = fmaxf(c0[0], c1[0]);
#pragma unroll
      for (int r = 1; r < 16; ++r) rm = fmaxf(rm, fmaxf(c0[r], c1[r]));
      rm = swap_max(rm); mhat = rm; float sacc = 0.f;
#pragma unroll
      for (int r = 0; r < 16; ++r) { c0[r] = __builtin_amdgcn_exp2f(c0[r] - rm); c1[r] = __builtin_amdgcn_exp2f(c1[r] - rm); sacc += c0[r] + c1[r]; negm[r] = -mhat; }
      l_reg = sacc; asm volatile("" : "+v"(negm));
      pwa0 = (u32x4_t){cvtpk(c0[0], c0[1]), cvtpk(c0[2], c0[3]), cvtpk(c0[4], c0[5]), cvtpk(c0[6], c0[7])}; pwa1 = (u32x4_t){cvtpk(c0[8], c0[9]), cvtpk(c0[10], c0[11]), cvtpk(c0[12], c0[13]), cvtpk(c0[14], c0[15])};
      pwa2 = (u32x4_t){cvtpk(c1[0], c1[1]), cvtpk(c1[2], c1[3]), cvtpk(c1[4], c1[5]), cvtpk(c1[6], c1[7])}; pwa3 = (u32x4_t){cvtpk(c1[8], c1[9]), cvtpk(c1[10], c1[11]), cvtpk(c1[12], c1[13]), cvtpk(c1[14], c1[15])}; }
    ATT_WAIT_BAR(0);
    if (NT > 3) DMA_K(3, 0);
    DMA_V(1, SLOT);
    ROT();
    kload8(kf, kp0 + sl_cur);
    if (NT > 3) ATT_WAIT_BAR(4); else ATT_WAIT_BAR(0);
    s16x4 vlo[4], vhi[4];
#define VFR(i) (bf16x8){vlo[i][0], vlo[i][1], vlo[i][2], vlo[i][3], vhi[i][0], vhi[i][1], vhi[i][2], vhi[i][3]}
#define VRD(f, buf) do { vlo[buf] = vtr(vp_ + (((f) & 3) * 4096 + ((f) >> 2) * 1024)); vhi[buf] = vtr(vp_ + (((f) & 3) * 4096 + ((f) >> 2) * 1024 + 512)); } while (0)
#define EX(v) __builtin_amdgcn_exp2f(v)
#define KRD(G, jj) do { if (G) { kf[jj] = *(const LAS bf16x8*)(kp0 + sl_next + ((jj) >> 1) * 2048 + ((jj) & 1) * 512); } } while (0)
#define QK(C, kk, dd, CI) do { C = __builtin_amdgcn_mfma_f32_32x32x16_bf16(kf[kk], qr[dd], CI, 0, 0, 0); ATT_SBAR(); } while (0)
#define GAPB(i, PWK, X, B, RD, Y, PB, WD) do { o[(i) & 3] = __builtin_amdgcn_mfma_f32_32x32x16_bf16(VFR((i) & 3), __builtin_bit_cast(bf16x8, PWK), o[(i) & 3], 0, 0, 0); \
        if (RD) VRD((i) + 4, (i) & 3); X[B] = EX(X[B]); X[(B) + 1] = EX(X[(B) + 1]); ATT_PIN(X); \
        if ((i) > 0) { sacc += Y[PB]; sacc += Y[(PB) + 1]; ATT_PIN(sacc); WD = cvtpk(Y[PB], Y[(PB) + 1]); ATT_PIN(WD); } ATT_SBAR(); } while (0)
#define STEP(PW, PN, t, GK, GV, GL) do { ATT_SBAR(); \
    const lds_cptr vp_ = vp0 + sl_prev; \
    QK(c0, 0, 0, negm); QK(c1, 1, 0, negm); QK(c0, 2, 1, c0); QK(c1, 3, 1, c1); \
    VRD(0, 0); QK(c0, 4, 2, c0); VRD(1, 1); QK(c1, 5, 2, c1); VRD(2, 2); QK(c0, 6, 3, c0); VRD(3, 3); QK(c1, 7, 3, c1); \
    if (GK) { DMA_K((t) + 3, sl_cur); } if (GV) { DMA_V((t) + 1, sl_next); } \
    { float a_ = ATT_MX3(c0[0], c0[1], c1[0]), b_ = ATT_MX3(c0[2], c0[3], c1[1]); a_ = ATT_MX3(a_, c1[2], c1[3]); \
      _Pragma("unroll") for (int r = 4; r < 16; r += 4) { a_ = ATT_MX3(a_, c0[r], c0[r + 1]); b_ = ATT_MX3(b_, c0[r + 2], c0[r + 3]); a_ = ATT_MX3(a_, c1[r], c1[r + 1]); b_ = ATT_MX3(b_, c1[r + 2], c1[r + 3]); } \
      float rm = swap_max(__builtin_fmaxf(a_, b_)); \
      resc = false; \
      if (__builtin_expect(__any(rm > THR), 0)) { const float dl = __builtin_fmaxf(rm, 0.f); mhat += dl; \
        _Pragma("unroll") for (int r = 0; r < 16; ++r) { c0[r] -= dl; c1[r] -= dl; } \
        _Pragma("unroll") for (int r = 0; r < 16; ++r) negm[r] = -mhat; asm volatile("" : "+v"(negm)); \
        fres = __builtin_amdgcn_exp2f(-dl); l_reg *= fres; resc = true; } } \
    ATT_SBAR(); \
    float sacc = 0.f; \
    GAPB(0, PW##0, c0, 0, true, c0, 0, PN##0[0]);  GAPB(1, PW##0, c0, 2, true, c0, 0, PN##0[0]);  GAPB(2, PW##0, c0, 4, true, c0, 2, PN##0[1]);  GAPB(3, PW##0, c0, 6, true, c0, 4, PN##0[2]); \
    KRD(GL, 0); GAPB(4, PW##1, c0, 8, true, c0, 6, PN##0[3]);  KRD(GL, 1); GAPB(5, PW##1, c0, 10, true, c0, 8, PN##1[0]); KRD(GL, 2); GAPB(6, PW##1, c0, 12, true, c0, 10, PN##1[1]); KRD(GL, 3); GAPB(7, PW##1, c0, 14, true, c0, 12, PN##1[2]); \
    KRD(GL, 4); GAPB(8, PW##2, c1, 0, true, c0, 14, PN##1[3]);  KRD(GL, 5); GAPB(9, PW##2, c1, 2, true, c1, 0, PN##2[0]);  KRD(GL, 6); GAPB(10, PW##2, c1, 4, true, c1, 2, PN##2[1]); KRD(GL, 7); GAPB(11, PW##2, c1, 6, true, c1, 4, PN##2[2]); \
    GAPB(12, PW##3, c1, 8, false, c1, 6, PN##2[3]); GAPB(13, PW##3, c1, 10, false, c1, 8, PN##3[0]); GAPB(14, PW##3, c1, 12, false, c1, 10, PN##3[1]); GAPB(15, PW##3, c1, 14, false, c1, 12, PN##3[2]); \
    sacc += c1[14]; sacc += c1[15]; PN##3[3] = cvtpk(c1[14], c1[15]); l_reg += sacc; \
    } while (0)
#define ENDW(tt) do { if ((tt) + 3 < NT) { ATT_WAIT_BAR(4); } else if ((tt) + 2 < NT) { ATT_WAIT_BAR(2); } else { ATT_WAIT_BAR(0); } } while (0)
    int t = 1;
    for (; t + 5 < NT; t += 2) {
        STEP(pwa, pwb, t, true, true, true);     ATT_WAIT_BAR(4); RESC(); ROT();
        STEP(pwb, pwa, t + 1, true, true, true); ATT_WAIT_BAR(4); RESC(); ROT();
    }
    for (; t + 1 < NT; t += 2) {
        STEP(pwa, pwb, t, (t + 3 < NT), (t + 1 < NT), (t + 1 < NT));     ENDW(t);     RESC(); ROT();
        STEP(pwb, pwa, t + 1, (t + 4 < NT), (t + 2 < NT), (t + 2 < NT)); ENDW(t + 1); RESC(); ROT();
    }
    if (vis_last) {
        STEP(pwa, pwb, NT - 1, false, false, false); RESC();
        pv_tail(o, pwb0, pwb1, pwb2, pwb3, vp0 + sl_cur);
    } else {
        pv_tail(o, pwa0, pwa1, pwa2, pwa3, vp0 + sl_prev);
    }
#undef STEP
#undef ENDW
#undef QK
#undef GAPB
#undef KRD
#undef VRD
#undef VFR
#undef EX
#undef ROT
#undef RESC
#undef DMA_K
#undef DMA_V
    const float lsum = l_reg;
    const float inv = 1.0f / swap_add(lsum);
    ATT_WAIT_BAR(0);
    LAS float* X = (LAS float*)(F.lds + LDS_X) + rb * 4096 + lane;
    if (map == 1) {
        const float sc = inv * ((const float*)(F.ws + WS_LAM))[L];
#pragma unroll
        for (int d0 = 0; d0 < 4; ++d0)
#pragma unroll
            for (int r = 0; r < 16; ++r) X[(d0 * 16 + r) * 64] = o[d0][r] * sc;
    }
    ATT_WAIT_BAR(0);
    if (map == 0) {
        float ssq = 0.f;
#pragma unroll
        for (int d0 = 0; d0 < 4; ++d0)
#pragma unroll
            for (int r = 0; r < 16; ++r) { const float v = o[d0][r] * inv - X[(d0 * 16 + r) * 64]; o[d0][r] = v; ssq += v * v; }
        const float rstd = 1.0f / sqrtf(swap_add(ssq) * (1.0f / 128.0f) + EPS);
        LAS char* S = (LAS char*)F.lds + LDS_S + rb * 32 * SPITCH;
#pragma unroll
        for (int d0 = 0; d0 < 4; ++d0)
#pragma unroll
            for (int g4 = 0; g4 < 4; ++g4) { u32x2_t w; w.x = cvtpk(o[d0][4 * g4] * rstd, o[d0][4 * g4 + 1] * rstd); w.y = cvtpk(o[d0][4 * g4 + 2] * rstd, o[d0][4 * g4 + 3] * rstd);
                *(LAS u32x2_t*)(S + r32 * SPITCH + (32 * d0 + 8 * g4 + 4 * hi) * 2) = w; }
        asm volatile("s_waitcnt lgkmcnt(0)" ::: "memory");
        const int ch = lane & 15; const float g = 1.0f - lambda_init(L);
        float anw[8];
#pragma unroll
        for (int k = 0; k < 8; ++k) anw[k] = a.a_norm_w[L * 128 + 8 * ch + k] * g;
#pragma unroll
        for (int it = 0; it < 8; ++it) { const int row = it * 4 + (lane >> 4);
            const u32x4_t sv = *(const LAS u32x4_t*)(S + row * SPITCH + ch * 16);
            const size_t grow = rowbase + q0 + rb * 32 + row;
            const u32x4_t zv = *(const u32x4_t*)(PROJ + grow * 4096 + C_AZ + h * 128 + 8 * ch);
            float v[8], z[8];
#pragma unroll
            for (int k = 0; k < 4; ++k) { v[2 * k] = __uint_as_float(sv[k] << 16); v[2 * k + 1] = __uint_as_float(sv[k] & 0xffff0000u); z[2 * k] = __uint_as_float(zv[k] << 16); z[2 * k + 1] = __uint_as_float(zv[k] & 0xffff0000u); }
            u32x4_t ov;
#pragma unroll
            for (int k = 0; k < 4; ++k) ov[k] = cvtpk(v[2 * k] * anw[2 * k] * silu_f(z[2 * k]), v[2 * k + 1] * anw[2 * k + 1] * silu_f(z[2 * k + 1]));
            *(u32x4_t*)(Y + grow * 1024 + 512 + h * 128 + 8 * ch) = ov; }
    }
    ATT_WAIT_BAR(0);
}
}

namespace ml {
using att::bf16x8; using att::s16x4; using att::f32x16; using att::glds16; using att::cvtpk; using att::vtr; using att::swap_add;
constexpr int NCH = 32;
constexpr float LOG2E = 1.4426950408889634f;
constexpr size_t WS_CROW = 26 * MiB, WS_BROW = WS_CROW + 256 * 1024, WS_PMROW = WS_BROW + 256 * 1024;
constexpr size_t WS_GCH = 27 * MiB, WS_BLCH = WS_GCH + 4096, WS_MST = WS_BLCH + 4096;
constexpr size_t WS_DN = 27 * MiB + 256 * 1024, WS_NST = WS_DN + 128 * 1024;
constexpr int B1_KW = 0, B1_V = 65536, B1_SC = 131072;
#define ML_WAIT_BAR(N) asm volatile("s_waitcnt vmcnt(" #N ") lgkmcnt(0)\n\ts_barrier" ::: "memory")
__device__ __forceinline__ bf16x8 trfrag(const LAS char* p) { const s16x4 lo = vtr(p), hh = vtr(p + 512); return (bf16x8){lo[0], lo[1], lo[2], lo[3], hh[0], hh[1], hh[2], hh[3]}; }
__device__ __forceinline__ void unpack8(const u32x4_t v, float (&f)[8]) {
#pragma unroll
    for (int k = 0; k < 4; ++k) { f[2 * k] = __uint_as_float(v[k] << 16); f[2 * k + 1] = __uint_as_float(v[k] & 0xffff0000u); } }

__device__ __forceinline__ void b1_unit(const Frame& F, const Args& a, const int L, const int bh, const int c) {
    const int tid = F.tid, lane = F.lane, wid = F.wave, hi = lane >> 5, r32 = lane & 31;
    const int b = bh >> 2, h = bh & 3; const size_t row0 = (size_t)b * SEQ + (size_t)c * 256;
    const bf16* PROJ = (const bf16*)(F.ws + WS_PROJ); const float* GATES = (const float*)(F.ws + WS_GATES);
    bf16* QC = (bf16*)(F.ws + WS_QC); bf16* KC = (bf16*)(F.ws + WS_KC);
    const unsigned lds0 = (unsigned)(uintptr_t)F.lds;
    LAS float* wl = (LAS float*)(F.lds + B1_SC); LAS float* wsum = wl + 256; LAS float* wmax = wsum + 8;
    { const bf16* vs = PROJ + (row0 + 16 * (wid & 3) + (lane >> 2)) * 4096 + C_MV + h * 128 + (wid >> 2) * 32 + (lane & 3) * 8; unsigned vd = lds0 + B1_V + wid * 1024;
#pragma unroll 1
      for (int i = 0; i < 4; ++i) { glds16(vs, (unsigned)__builtin_amdgcn_readfirstlane(vd)); glds16(vs + 64, (unsigned)__builtin_amdgcn_readfirstlane(vd + 8192)); vs += 64 * 4096; vd += 16384; } }
    float bl = 0.f, cl = 0.f, pm = 0.f;
    if (tid < 256) {
        const float lf = GATES[(row0 + tid) * 8 + 4 + h], li = GATES[(row0 + tid) * 8 + h];
        bl = lf;
#pragma unroll
        for (int off = 1; off < 64; off <<= 1) { const float t = __shfl_up(bl, off); if (lane >= off) bl += t; }
        if (lane == 63) wsum[wid] = bl;
    }
    __syncthreads();
    if (tid < 256) {
        float offs = 0.f;
#pragma unroll
        for (int w = 0; w < 4; ++w) offs += (w < wid) ? wsum[w] : 0.f;
        bl += offs;
        const float li = GATES[(row0 + tid) * 8 + h];
        cl = li - bl; pm = cl;
#pragma unroll
        for (int off = 1; off < 64; off <<= 1) { const float t = __shfl_up(pm, off); if (lane >= off) pm = fmaxf(pm, t); }
        if (lane == 63) wmax[wid] = pm;
    }
    __syncthreads();
    if (tid < 256) {
        float pmo = -INFINITY;
#pragma unroll
        for (int w = 0; w < 4; ++w) pmo = (w < wid) ? fmaxf(pmo, wmax[w]) : pmo;
        pm = fmaxf(pm, pmo);
        const float G = fmaxf(fmaxf(wmax[0], wmax[1]), fmaxf(wmax[2], wmax[3]));
        wl[tid] = expf(cl - G);
        float* CROW = (float*)(F.ws + WS_CROW); float* BROW = (float*)(F.ws + WS_BROW); float* PMROW = (float*)(F.ws + WS_PMROW);
        CROW[(row0 + tid) * 4 + h] = cl; BROW[(row0 + tid) * 4 + h] = bl; PMROW[(row0 + tid) * 4 + h] = pm;
        if (tid == 255) { ((float*)(F.ws + WS_GCH))[bh * NCH + c] = G; ((float*)(F.ws + WS_BLCH))[bh * NCH + c] = bl; }
    }
    __syncthreads();
    {
        const int ch8 = tid & 15, run = tid >> 4, r0 = run * 8;
        const float* cw = a.conv_w + (size_t)L * 4 * 1024; const float* cb = a.conv_b + (size_t)L * 1024;
#pragma unroll 1
        for (int which = 0; which < 2; ++which) {
            const int cch = which * 512 + h * 128 + ch8 * 8;
            const bf16* src = PROJ + row0 * 4096 + (which ? C_MK : C_MQ) + h * 128 + ch8 * 8;
            float w[4][8], bs[8];
#pragma unroll
            for (int k = 0; k < 4; ++k) { const f32x4 w0 = *(const f32x4*)(cw + k * 1024 + cch), w1 = *(const f32x4*)(cw + k * 1024 + cch + 4);
                w[k][0] = w0[0]; w[k][1] = w0[1]; w[k][2] = w0[2]; w[k][3] = w0[3]; w[k][4] = w1[0]; w[k][5] = w1[1]; w[k][6] = w1[2]; w[k][7] = w1[3]; }
            { const f32x4 b0 = *(const f32x4*)(cb + cch), b1 = *(const f32x4*)(cb + cch + 4); bs[0] = b0[0]; bs[1] = b0[1]; bs[2] = b0[2]; bs[3] = b0[3]; bs[4] = b1[0]; bs[5] = b1[1]; bs[6] = b1[2]; bs[7] = b1[3]; }
            u32x4_t xr[11];
#pragma unroll
            for (int i = 0; i < 11; ++i) { const int rr = r0 - 3 + i; xr[i] = (c > 0 || rr >= 0) ? *(const u32x4_t*)(src + (long)rr * 4096) : (u32x4_t){0u, 0u, 0u, 0u}; }
            float x0[8], x1[8], x2[8], x3[8];
            unpack8(xr[0], x0); unpack8(xr[1], x1); unpack8(xr[2], x2);
#pragma unroll
            for (int r = 0; r < 8; ++r) {
                unpack8(xr[r + 3], x3);
                float y[8];
#pragma unroll
                for (int k = 0; k < 8; ++k) { y[k] = silu_f(bs[k] + w[0][k] * x0[k] + w[1][k] * x1[k] + w[2][k] * x2[k] + w[3][k] * x3[k]); x0[k] = x1[k]; x1[k] = x2[k]; x2[k] = x3[k]; }
                const size_t orow = row0 + r0 + r;
                if (which == 0) {
                    u32x4_t o; o[0] = cvtpk(y[0], y[1]); o[1] = cvtpk(y[2], y[3]); o[2] = cvtpk(y[4], y[5]); o[3] = cvtpk(y[6], y[7]);
                    *(u32x4_t*)(QC + orow * 512 + h * 128 + ch8 * 8) = o;
                } else {
#pragma unroll
                    for (int k = 0; k < 8; ++k) y[k] *= KSCALE;
                    u32x4_t o; o[0] = cvtpk(y[0], y[1]); o[1] = cvtpk(y[2], y[3]); o[2] = cvtpk(y[4], y[5]); o[3] = cvtpk(y[6], y[7]);
                    *(u32x4_t*)(KC + orow * 512 + h * 128 + ch8 * 8) = o;
                    const int l = r0 + r; const float wv = wl[l];
                    u32x4_t ow; ow[0] = cvtpk(y[0] * wv, y[1] * wv); ow[1] = cvtpk(y[2] * wv, y[3] * wv); ow[2] = cvtpk(y[4] * wv, y[5] * wv); ow[3] = cvtpk(y[6] * wv, y[7] * wv);
                    *(LAS u32x4_t*)(F.lds + B1_KW + (l >> 6) * 16384 + ((ch8 >> 2) * 4 + ((l >> 4) & 3)) * 1024 + (l & 15) * 64 + (ch8 & 3) * 16) = ow;
                }
            }
        }
    }
    asm volatile("s_waitcnt vmcnt(0)" ::: "memory");
    __syncthreads();
    {
        const int td = wid & 3, tep = wid >> 2;
        const LAS char* fb = (const LAS char*)F.lds + ((lane >> 4) & 1) * 32 + (lane & 3) * 8 + (4 * hi + ((lane & 15) >> 2)) * 64;
        f32x16 acc0 = f32x16{}, acc1 = f32x16{}, accn = f32x16{};
        const bf16x8 ones = (bf16x8){(short)0x3f80, (short)0x3f80, (short)0x3f80, (short)0x3f80, (short)0x3f80, (short)0x3f80, (short)0x3f80, (short)0x3f80};
#pragma unroll 4
        for (int s16 = 0; s16 < 16; ++s16) { const int off = (s16 >> 2) * 16384 + (s16 & 3) * 1024;
            const bf16x8 kwf = trfrag(fb + B1_KW + off + td * 4096);
            const bf16x8 v0 = trfrag(fb + B1_V + off + (2 * tep) * 4096), v1 = trfrag(fb + B1_V + off + (2 * tep + 1) * 4096);
            acc0 = __builtin_amdgcn_mfma_f32_32x32x16_bf16(v0, kwf, acc0, 0, 0, 0);
            acc1 = __builtin_amdgcn_mfma_f32_32x32x16_bf16(v1, kwf, acc1, 0, 0, 0);
            if (tep == 0) accn = __builtin_amdgcn_mfma_f32_32x32x16_bf16(ones, kwf, accn, 0, 0, 0);
        }
        float* DCT = (float*)(F.ws + WS_DC) + (size_t)(bh * NCH + c) * 16384;
#pragma unroll
        for (int r = 0; r < 16; ++r) { const int er = (r & 3) + 8 * (r >> 2) + 4 * hi;
            DCT[(size_t)((2 * tep) * 32 + er) * 128 + td * 32 + r32] = acc0[r];
            DCT[(size_t)((2 * tep + 1) * 32 + er) * 128 + td * 32 + r32] = acc1[r]; }
        if (tep == 0 && hi == 0) ((float*)(F.ws + WS_DN))[(size_t)(bh * NCH + c) * 128 + td * 32 + r32] = accn[0];
    }
    __syncthreads();
}

__device__ __forceinline__ void b2_scan(const Frame& F) {
    const int gid = F.vcu * 512 + F.tid;
    if (gid >= 8 * 16384) return;
    const int bh = gid >> 14, el = gid & 16383;
    const float* DCT = (const float*)(F.ws + WS_DC) + (size_t)bh * NCH * 16384 + el;
    const float* G = (const float*)(F.ws + WS_GCH) + bh * NCH; const float* BL = (const float*)(F.ws + WS_BLCH) + bh * NCH;
    bf16* CST = (bf16*)(F.ws + WS_CST) + (size_t)bh * NCH * 16384 + el;
    float d[NCH];
#pragma unroll
    for (int c = 0; c < NCH; ++c) d[c] = DCT[(size_t)c * 16384];
    float dn[NCH];
    const bool has_n = el < 128;
    if (has_n) {
        const float* DN = (const float*)(F.ws + WS_DN) + (size_t)bh * NCH * 128 + el;
#pragma unroll
        for (int c = 0; c < NCH; ++c) dn[c] = DN[c * 128];
    }
    float C = 0.f, n = 0.f, m = 0.f;
    float* NST = (float*)(F.ws + WS_NST) + (size_t)bh * NCH * 128 + el; float* MST = (float*)(F.ws + WS_MST) + bh * NCH;
#pragma unroll
    for (int c = 0; c < NCH; ++c) {
        CST[(size_t)c * 16384] = (bf16)f2bf(C);
        if (has_n) NST[c * 128] = n;
        if (el == 0) MST[c] = m;
        const float g = G[c], Ml = fmaxf(m, g), ac = expf(m - Ml), gc = expf(g - Ml);
        C = ac * C + gc * d[c];
        if (has_n) n = ac * n + gc * dn[c];
        m = BL[c] + Ml;
    }
}

constexpr int B3_CT = 0, B3_NV = 32768, B3_K = 0, B3_V = 65536, B3_CL = 131072, B3_S = 0, B3_SPITCH = 272;
__device__ __forceinline__ void b3_unit(const Frame& F, const Args& a, const int L, const int bh, const int c) {
    const int tid = F.tid, lane = F.lane, wid = F.wave, hi = lane >> 5, r32 = lane & 31;
    const int b = bh >> 2, h = bh & 3; const size_t row0 = (size_t)b * SEQ + (size_t)c * 256;
    const bf16* PROJ = (const bf16*)(F.ws + WS_PROJ); const bf16* QC = (const bf16*)(F.ws + WS_QC); const bf16* KC = (const bf16*)(F.ws + WS_KC); bf16* Y = (bf16*)(F.ws + WS_XN);
    const unsigned lds0 = (unsigned)(uintptr_t)F.lds;
    const size_t myrow = row0 + wid * 32 + r32;
    bf16x8 qr[8];
#pragma unroll
    for (int s = 0; s < 8; ++s) qr[s] = *(const bf16x8*)(QC + myrow * 512 + h * 128 + 16 * s + 8 * hi);
    const float c_i = ((const float*)(F.ws + WS_CROW))[myrow * 4 + h], b_i = ((const float*)(F.ws + WS_BROW))[myrow * 4 + h], pm_i = ((const float*)(F.ws + WS_PMROW))[myrow * 4 + h];
    const float m0 = ((const float*)(F.ws + WS_MST))[bh * NCH + c];
    const float M_i = fmaxf(m0, pm_i), M2 = M_i * LOG2E, w_inter = expf(m0 - M_i);
    (void)c_i;
    LAS float* nv = (LAS float*)(F.lds + B3_NV); LAS float* cl2 = (LAS float*)(F.lds + B3_CL);
    if (tid < 128) nv[tid] = ((const float*)(F.ws + WS_NST))[(size_t)(bh * NCH + c) * 128 + tid];
    if (tid < 256) cl2[tid] = ((const float*)(F.ws + WS_CROW))[(row0 + tid) * 4 + h] * LOG2E;
    asm volatile("s_waitcnt vmcnt(0)" ::: "memory");
    { const bf16* CST = (const bf16*)(F.ws + WS_CST) + (size_t)(bh * NCH + c) * 16384;
#pragma unroll
      for (int i = 0; i < 4; ++i) { const int p = wid + 8 * i, chunk = p >> 1, g = p & 1;
          glds16(CST + (size_t)(g * 64 + lane) * 128 + chunk * 8, (unsigned)__builtin_amdgcn_readfirstlane(lds0 + B3_CT + chunk * 2048 + g * 1024)); } }
    ML_WAIT_BAR(0);
    f32x16 acc[4];
#pragma unroll
    for (int te = 0; te < 4; ++te) { acc[te] = f32x16{};
#pragma unroll
        for (int s = 0; s < 8; ++s) { const bf16x8 cf = *(const LAS bf16x8*)(F.lds + B3_CT + (2 * s + hi) * 2048 + (te * 32 + r32) * 16);
            acc[te] = __builtin_amdgcn_mfma_f32_32x32x16_bf16(cf, qr[s], acc[te], 0, 0, 0); }
        __builtin_amdgcn_sched_barrier(0); }
    float qn = 0.f;
#pragma unroll
    for (int s = 0; s < 8; ++s) { float qf[8]; unpack8(__builtin_bit_cast(u32x4_t, qr[s]), qf);
        const f32x4 n0 = *(const LAS f32x4*)(nv + 16 * s + 8 * hi), n1 = *(const LAS f32x4*)(nv + 16 * s + 8 * hi + 4);
        qn += (qf[0] * n0[0] + qf[1] * n0[1]) + (qf[2] * n0[2] + qf[3] * n0[3]) + (qf[4] * n1[0] + qf[5] * n1[1]) + (qf[6] * n1[2] + qf[7] * n1[3]); }
    qn = swap_add(qn);
    ML_WAIT_BAR(0);
    {
      const bf16* ks = KC + (row0 + (wid & 3) * 64 + lane) * 512 + h * 128 + (wid >> 2) * 8; unsigned kd = lds0 + B3_K + (wid >> 2) * 4096 + (wid & 3) * 1024;
#pragma unroll 1
      for (int i = 0; i < 8; ++i) { glds16(ks, (unsigned)__builtin_amdgcn_readfirstlane(kd)); ks += 16; kd += 8192; }
      const bf16* vs = PROJ + (row0 + 16 * (wid & 3) + (lane >> 2)) * 4096 + C_MV + h * 128 + (wid >> 2) * 32 + (lane & 3) * 8; unsigned vd = lds0 + B3_V + wid * 1024;
#pragma unroll 1
      for (int i = 0; i < 4; ++i) { glds16(vs, (unsigned)__builtin_amdgcn_readfirstlane(vd)); glds16(vs + 64, (unsigned)__builtin_amdgcn_readfirstlane(vd + 8192)); vs += 64 * 4096; vd += 16384; } }
#pragma unroll
    for (int te = 0; te < 4; ++te)
#pragma unroll
        for (int r = 0; r < 16; ++r) acc[te][r] *= w_inter;
    float rowsum = 0.f;
    ML_WAIT_BAR(0);
    const LAS char* vb = (const LAS char*)F.lds + B3_V + ((lane >> 4) & 1) * 32 + (lane & 3) * 8 + (4 * hi + ((lane & 15) >> 2)) * 64;
    for (int hf = 0; hf <= wid; ++hf) {
        f32x16 p = f32x16{};
#pragma unroll
        for (int s = 0; s < 8; ++s) { const bf16x8 kf = *(const LAS bf16x8*)(F.lds + B3_K + (2 * s + hi) * 4096 + (32 * hf + r32) * 16);
            p = __builtin_amdgcn_mfma_f32_32x32x16_bf16(kf, qr[s], p, 0, 0, 0); }
        __builtin_amdgcn_sched_barrier(0);
        const bool diag = (hf == wid);
#pragma unroll
        for (int g4 = 0; g4 < 4; ++g4) { const f32x4 cc = *(const LAS f32x4*)(cl2 + 32 * hf + 8 * g4 + 4 * hi);
#pragma unroll
            for (int i = 0; i < 4; ++i) { const int r = 4 * g4 + i; const int kl = 8 * g4 + 4 * hi + i;
                const float wgt = __builtin_amdgcn_exp2f(cc[i] - M2);
                float v = p[r] * wgt; if (diag && kl > r32) v = 0.f; p[r] = v; rowsum += v; } }
        bf16x8 pw0, pw1;
        { u32x4_t w0 = {cvtpk(p[0], p[1]), cvtpk(p[2], p[3]), cvtpk(p[4], p[5]), cvtpk(p[6], p[7])}; pw0 = __builtin_bit_cast(bf16x8, w0);
          u32x4_t w1 = {cvtpk(p[8], p[9]), cvtpk(p[10], p[11]), cvtpk(p[12], p[13]), cvtpk(p[14], p[15])}; pw1 = __builtin_bit_cast(bf16x8, w1); }
        const LAS char* vt = vb + (hf >> 1) * 16384 + (2 * (hf & 1)) * 1024;
        __builtin_amdgcn_sched_barrier(0);
#pragma unroll
        for (int te = 0; te < 4; ++te) {
            acc[te] = __builtin_amdgcn_mfma_f32_32x32x16_bf16(trfrag(vt + te * 4096), pw0, acc[te], 0, 0, 0);
            acc[te] = __builtin_amdgcn_mfma_f32_32x32x16_bf16(trfrag(vt + te * 4096 + 1024), pw1, acc[te], 0, 0, 0);
        }
        __builtin_amdgcn_sched_barrier(0);
    }
    const float den = w_inter * qn + swap_add(rowsum);
    const float hden = 1.0f / fmaxf(fabsf(den), exp2f(-(b_i * LOG2E + M2)));
    float ssq = 0.f;
#pragma unroll
    for (int te = 0; te < 4; ++te)
#pragma unroll
        for (int r = 0; r < 16; ++r) { const float v = acc[te][r] * hden; acc[te][r] = v; ssq += v * v; }
    const float rstd = 1.0f / sqrtf(swap_add(ssq) * (1.0f / 128.0f) + EPS);
    ML_WAIT_BAR(0);
    LAS char* S = (LAS char*)F.lds + B3_S + wid * 32 * B3_SPITCH;
#pragma unroll
    for (int te = 0; te < 4; ++te)
#pragma unroll
        for (int g4 = 0; g4 < 4; ++g4) { u32x2_t w; w.x = cvtpk(acc[te][4 * g4] * rstd, acc[te][4 * g4 + 1] * rstd); w.y = cvtpk(acc[te][4 * g4 + 2] * rstd, acc[te][4 * g4 + 3] * rstd);
            *(LAS u32x2_t*)(S + r32 * B3_SPITCH + (32 * te + 8 * g4 + 4 * hi) * 2) = w; }
    asm volatile("s_waitcnt lgkmcnt(0)" ::: "memory");
    { const int ch = lane & 15; float mnw[8], msk[8];
#pragma unroll
      for (int k = 0; k < 8; ++k) { mnw[k] = a.m_norm_w[L * 512 + h * 128 + 8 * ch + k]; msk[k] = a.m_skip[L * 512 + h * 128 + 8 * ch + k]; }
#pragma unroll
      for (int it = 0; it < 8; ++it) { const int row = it * 4 + (lane >> 4); const size_t grow = row0 + wid * 32 + row;
          const u32x4_t sv = *(const LAS u32x4_t*)(S + row * B3_SPITCH + ch * 16);
          const u32x4_t qv = *(const u32x4_t*)(QC + grow * 512 + h * 128 + 8 * ch), zv = *(const u32x4_t*)(PROJ + grow * 4096 + C_MZ + h * 128 + 8 * ch);
          float v[8], q[8], z[8]; unpack8(sv, v); unpack8(qv, q); unpack8(zv, z);
          u32x4_t ov;
#pragma unroll
          for (int k = 0; k < 4; ++k) ov[k] = cvtpk((v[2 * k] * mnw[2 * k] + msk[2 * k] * q[2 * k]) * silu_f(z[2 * k]), (v[2 * k + 1] * mnw[2 * k + 1] + msk[2 * k + 1] * q[2 * k + 1]) * silu_f(z[2 * k + 1]));
          *(u32x4_t*)(Y + grow * 1024 + h * 128 + 8 * ch) = ov; } }
    ML_WAIT_BAR(0);
}
}


typedef __attribute__((address_space(1))) unsigned gu32;
#define XB_TMO      128
#define XB_XCNT(j)  (256  + 64 * (j))
#define XB_XSUB(j)  (1280 + 64 * (j))
#define XB_XGEN(j)  (2304 + 64 * (j))
#define XB_TOP      3328
#define XB_TOPGEN   3392
#define XCD_BAR_WORDS 3456
#define XB_SPIN_CAP (1u << 18)

__device__ __forceinline__ unsigned xb_ld(unsigned* p)              { return __hip_atomic_load(p, __ATOMIC_RELAXED, __HIP_MEMORY_SCOPE_AGENT); }
__device__ __forceinline__ unsigned xb_add(unsigned* p, unsigned v) { return __hip_atomic_fetch_add(p, v, __ATOMIC_RELAXED, __HIP_MEMORY_SCOPE_AGENT); }
__device__ __forceinline__ unsigned xb_xcc_id() { return (unsigned)__builtin_amdgcn_s_getreg((3 << 11) | 20) & 0xFu; }
#define XB_SPIN(cond, bar) do { unsigned _sp = 0; while (cond) { __builtin_amdgcn_s_sleep(1); \
    if ((++_sp & 255u) == 0u) { if (xb_ld(&(bar)[XB_TMO])) break; if (_sp > XB_SPIN_CAP) { atomicAdd(&(bar)[XB_TMO], 1u); break; } } } } while (0)

struct XcdBarrier {
    unsigned* bar; unsigned x;
    volatile LAS unsigned* st;
};

__device__ __forceinline__ XcdBarrier xcd_barrier_post(unsigned* bar, volatile LAS unsigned* st) {
    XcdBarrier b; b.bar = bar; b.x = xb_xcc_id(); b.st = st;
    if (threadIdx.x == 0) (void)xb_add(&bar[XB_XCNT(b.x)], 1u);
    return b;
}
__device__ __forceinline__ void xcd_barrier_complete(unsigned* bar, unsigned x, unsigned& nloc, unsigned& nx) {
    const unsigned G = gridDim.x * gridDim.y * gridDim.z;
    unsigned sum, cnt, mine, sp = 0u;
    for (;;) {
        sum = 0u; cnt = 0u; mine = 0u;
#pragma unroll
        for (unsigned j = 0; j < 16; ++j) { const unsigned c = xb_ld(&bar[XB_XCNT(j)]); sum += c; cnt += (c > 0u) ? 1u : 0u; mine = (j == x) ? c : mine; }
        if (sum == G) break;
        __builtin_amdgcn_s_sleep(1);
        if ((++sp & 255u) == 0u) { if (xb_ld(&bar[XB_TMO])) break; if (sp > XB_SPIN_CAP) { atomicAdd(&bar[XB_TMO], 1u); break; } }
    }
    nloc = mine > 0u ? mine : 1u; nx = cnt > 0u ? cnt : 1u;
}

__device__ __forceinline__ void xcd_barrier(const XcdBarrier& b) {
    asm volatile("s_waitcnt vmcnt(0)" ::: "memory");
    __syncthreads();
    if (threadIdx.x == 0) {
        unsigned* bar = b.bar;
        __builtin_amdgcn_s_waitcnt(0);
        unsigned nloc = b.st[0], nx = b.st[1];
        if (nloc == 0u) { xcd_barrier_complete(bar, b.x, nloc, nx); b.st[0] = nloc; b.st[1] = nx; }
        const unsigned old = xb_add(&bar[XB_XSUB(b.x)], 1u);
        const unsigned gen = old / nloc;
        if (old + 1u == (gen + 1u) * nloc) {
            __builtin_amdgcn_fence(__ATOMIC_RELEASE, "agent");
            asm volatile("s_waitcnt vmcnt(0)" ::: "memory");
            const unsigned og = xb_add(&bar[XB_TOP], 1u);
            const unsigned tg = og / nx;
            if (og + 1u == (tg + 1u) * nx) xb_add(&bar[XB_TOPGEN], 1u);
            else XB_SPIN(xb_ld(&bar[XB_TOPGEN]) == tg, bar);
            __builtin_amdgcn_fence(__ATOMIC_ACQUIRE, "agent");
            xb_add(&bar[XB_XGEN(b.x)], 1u);
            asm volatile("s_waitcnt vmcnt(0)" ::: "memory");
        } else {
            XB_SPIN(xb_ld(&bar[XB_XGEN(b.x)]) == gen, bar);
            __builtin_amdgcn_fence(__ATOMIC_ACQUIRE, "agent");
            asm volatile("s_waitcnt vmcnt(0)" ::: "memory");
        }
    }
    __syncthreads();
}

constexpr int N_PHASES = 1 + 6 * DEPTH;
#ifndef NAIVE_MIX
#define NAIVE_MIX 0
#endif
#ifndef NAIVE_ATTN
#define NAIVE_ATTN 0
#endif
constexpr bool HAS_B12 = true;
#define PH_IN(k) (lo <= (k) && (k) < hi)
#ifndef REP_G1
#define REP_G1 1
#endif
#ifndef REP_B1
#define REP_B1 1
#endif
#ifndef REP_B2
#define REP_B2 1
#endif
#ifndef REP_B3
#define REP_B3 1
#endif
#ifndef REP_AT
#define REP_AT 1
#endif
#ifndef REP_G2
#define REP_G2 1
#endif
#ifndef REP_R
#define REP_R 1
#endif
#define REP_DO(n, ...) do { __VA_ARGS__; if ((n) >= 2) { __VA_ARGS__; } } while (0)
#ifndef USE_XCD_BAR
#define USE_XCD_BAR 1
#endif
#if USE_XCD_BAR
#define PH_SYNC(k) do { if (lo <= (k) && (k) + 1 < hi) { if ((k) == 0) cg::this_grid().sync(); else xcd_barrier(bar); } } while (0)
#else
#define PH_SYNC(k) do { if (lo <= (k) && (k) + 1 < hi) cg::this_grid().sync(); } while (0)
#endif
template <int L> __device__ __forceinline__ void layer_phases(const Frame& F, const Args& a, const int lo, const int hi, const XcdBarrier& bar) {
    constexpr int base = 1 + 6 * L;
    bf16* XN = (bf16*)(a.ws + WS_XN); bf16* PROJ = (bf16*)(a.ws + WS_PROJ); float* GATES = (float*)(a.ws + WS_GATES);
    if (PH_IN(base + 0)) {
        pg8::Gemm g{XN, (const bf16*)(a.ws + WS_WIN) + (size_t)L * NPROJ * DMODEL, TOK, NPROJ, DMODEL}; pg8::StaticOrder S; S.init(TOK, NPROJ, F.G, (int)blockIdx.x);
        pg8::EpiProj E{PROJ, (const float*)(a.ws + WS_COS), (const float*)(a.ws + WS_SIN), C2};
        REP_DO(REP_G1, pg8::gemm_phase<pg8::EpiProj, pg8::StaticOrder, true, true>(F.lds, g, S, E));
    }
    PH_SYNC(base + 0);
    if (PH_IN(base + 1)) { REP_DO(REP_B1, ml::b1_unit(F, a, L, F.vcu >> 5, F.vcu & 31)); }
    PH_SYNC(base + 1);
    if (PH_IN(base + 2)) { REP_DO(REP_B2, ml::b2_scan(F)); }
    PH_SYNC(base + 2);
    if (PH_IN(base + 3)) {
        REP_DO(REP_B3, ml::b3_unit(F, a, L, F.vcu >> 5, F.vcu & 31));
        { const int bh = F.vcu >> 5, s_ = F.vcu & 31;
          REP_DO(REP_AT, att::attn_unit2(F, a, L, bh >> 2, bh & 3, s_); att::attn_unit2(F, a, L, bh >> 2, bh & 3, 63 - s_)); }
    }
    PH_SYNC(base + 3);
    if (PH_IN(base + 4)) {
        pg8::Gemm g{XN  , (const bf16*)(a.ws + WS_WOUT) + (size_t)L * DMODEL * DMODEL, TOK, DMODEL, DMODEL}; pg8::StaticOrder S; S.init(TOK, DMODEL, F.G, (int)blockIdx.x);
        pg8::EpiRes E{L == 0 ? a.x : a.out, a.out};
        REP_DO(L == 0 ? REP_G2 : 1, pg8::gemm_phase<pg8::EpiRes, pg8::StaticOrder, false, true>(F.lds, g, S, E));
    }
    PH_SYNC(base + 4);
    if (PH_IN(base + 5)) {
        if (L + 1 < DEPTH) { REP_DO(REP_R, phase_rownorm(F, a.out, a.norm_w + (L + 1) * DMODEL, a.w_in + (size_t)(L + 1) * DMODEL * DIN, a.i_bias + (L + 1) * 4, a.f_bias + (L + 1) * 4, XN, GATES, nullptr)); }
        else phase_rownorm(F, a.out, a.fnw, nullptr, nullptr, nullptr, nullptr, nullptr, a.out);
    }
    if (L + 1 < DEPTH) PH_SYNC(base + 5);
}
__global__ void __launch_bounds__(512, 2) fwd_kernel(Args a) {
    extern __shared__ __attribute__((aligned(16))) unsigned char lds_raw[];
    Frame F; F.lds = (LAS unsigned char*)lds_raw; F.tid = threadIdx.x; F.lane = F.tid & 63; F.wave = __builtin_amdgcn_readfirstlane(F.tid >> 6);
    F.G = gridDim.x; { const int bx = blockIdx.x; F.vcu = (F.G % 8 == 0) ? (bx % 8) * (F.G / 8) + bx / 8 : bx; }
    F.ws = a.ws;
    const int lo = a.ph_lo, hi = a.ph_hi;
    volatile LAS unsigned* MISC = (volatile LAS unsigned*)(F.lds + MISC_OFF);
    if (F.tid < 16) MISC[F.tid] = 0u;
    __syncthreads();
    XcdBarrier bar = xcd_barrier_post((unsigned*)(a.ws + WS_CTL) + 4096, MISC + 8);
    if (PH_IN(0)) {
        phase_prologue(F, a);
        phase_rownorm(F, a.x, a.norm_w, a.w_in, a.i_bias, a.f_bias, (bf16*)(a.ws + WS_XN), (float*)(a.ws + WS_GATES), nullptr);
    }
    PH_SYNC(0);
    layer_phases<0>(F, a, lo, hi, bar);
    layer_phases<1>(F, a, lo, hi, bar);
}

extern "C" void kernel_launch(void* const* d_in, const int* in_sizes, int n_in, void* d_out, int out_size, void* d_ws, size_t ws_size, hipStream_t stream) {
    static int grid = 0;
    if (grid == 0) {
        if (n_in != 16 || in_sizes[0] != TOK * DMODEL || out_size != TOK * DMODEL || ws_size < WS_END) { fprintf(stderr, "kernel_launch: unexpected shapes (n_in %d, in0 %d, out %d, ws %zu)\n", n_in, n_in > 0 ? in_sizes[0] : -1, out_size, ws_size); grid = -1; return; }
        int dev = 0, cus = 0, per_cu = 0;
        hipGetDevice(&dev); hipDeviceGetAttribute(&cus, hipDeviceAttributeMultiprocessorCount, dev);
        if (hipFuncSetAttribute((const void*)fwd_kernel, hipFuncAttributeMaxDynamicSharedMemorySize, LDS_BYTES) != hipSuccess) { fprintf(stderr, "kernel_launch: hipFuncSetAttribute failed\n"); grid = -1; return; }
        hipOccupancyMaxActiveBlocksPerMultiprocessor(&per_cu, (const void*)fwd_kernel, 512, LDS_BYTES);
        (void)hipGetLastError();
        if (per_cu < 1) { fprintf(stderr, "kernel_launch: occupancy query says %d blocks per CU\n", per_cu); grid = -1; return; }
        grid = cus;
        if (grid != 256) { fprintf(stderr, "kernel_launch: this kernel's static schedules need exactly 256 CUs (got %d); nothing launched\n", grid); grid = -1; return; }
    }
    if (grid < 0) return;
    Args a{};
    a.x = (const float*)d_in[0]; a.norm_w = (const float*)d_in[1]; a.w_in = (const float*)d_in[2]; a.conv_w = (const float*)d_in[3]; a.conv_b = (const float*)d_in[4];
    a.i_bias = (const float*)d_in[5]; a.f_bias = (const float*)d_in[6]; a.m_norm_w = (const float*)d_in[7]; a.m_skip = (const float*)d_in[8];
    a.lq1 = (const float*)d_in[9]; a.lk1 = (const float*)d_in[10]; a.lq2 = (const float*)d_in[11]; a.lk2 = (const float*)d_in[12]; a.a_norm_w = (const float*)d_in[13];
    a.w_out = (const float*)d_in[14]; a.fnw = (const float*)d_in[15]; a.out = (float*)d_out; a.ws = (unsigned char*)d_ws;
#if MK_ONE_LAUNCH
    if (hipMemsetAsync((char*)d_ws + WS_CTL, 0, 65536, stream) != hipSuccess) { fprintf(stderr, "kernel_launch: hipMemsetAsync failed\n"); return; }
    a.ph_lo = 0; a.ph_hi = N_PHASES;
    void* args[] = {&a};
    hipError_t e = hipLaunchCooperativeKernel((const void*)fwd_kernel, dim3(grid), dim3(512), args, LDS_BYTES, stream);
    if (e != hipSuccess) fprintf(stderr, "cooperative launch failed: %s (grid %d)\n", hipGetErrorString(e), grid);
#else
    for (int ph = 0; ph < N_PHASES; ++ph) {
        if (ph > 0) { const int s = (ph - 1) % 6; if (!HAS_B12 && (s == 1 || s == 2)) continue; }
        a.ph_lo = ph; a.ph_hi = ph + 1;
        hipLaunchKernelGGL(fwd_kernel, dim3(grid), dim3(512), LDS_BYTES, stream, a);
    }
#endif
}
```

```cpp
#include <hip/hip_runtime.h>
#include <hip/hip_cooperative_groups.h>
#include <cstdio>
#include <cstdint>
namespace cg = cooperative_groups;

#ifndef MK_ONE_LAUNCH
#define MK_ONE_LAUNCH 1
#endif


#ifndef WT_STORES
#define WT_STORES 0
#endif
#ifndef WT_SMALL
#define WT_SMALL 0
#endif
typedef unsigned wt_u32x4 __attribute__((ext_vector_type(4)));
typedef unsigned wt_u32x2 __attribute__((ext_vector_type(2)));
typedef float wt_f32x4 __attribute__((ext_vector_type(4)));
__device__ __forceinline__ void st16_wt(void* p, wt_u32x4 v) {
#if WT_STORES
    asm volatile("global_store_dwordx4 %0, %1, off sc1\n\ts_nop 1" :: "v"(p), "v"(v) : "memory");
#else
    *(wt_u32x4*)p = v;
#endif
}
__device__ __forceinline__ void st16f_wt(void* p, wt_f32x4 v) { st16_wt(p, __builtin_bit_cast(wt_u32x4, v)); }
__device__ __forceinline__ void st8_wt(void* p, wt_u32x2 v) {
#if WT_STORES && WT_SMALL
    asm volatile("global_store_dwordx2 %0, %1, off sc1\n\ts_nop 0" :: "v"(p), "v"(v) : "memory");
#else
    *(wt_u32x2*)p = v;
#endif
}
__device__ __forceinline__ void st4_wt(void* p, float v) {
#if WT_STORES && WT_SMALL
    asm volatile("global_store_dword %0, %1, off sc1" :: "v"(p), "v"(v) : "memory");
#else
    *(float*)p = v;
#endif
}
namespace pg8 {
#define PG8_LAS __attribute__((address_space(3)))
typedef unsigned short bf16_t;
typedef short bf16x8 __attribute__((ext_vector_type(8)));
typedef float f32x4 __attribute__((ext_vector_type(4)));
typedef unsigned u32x4 __attribute__((ext_vector_type(4)));
constexpr int BM = 256, BK = 64, HALF = 128, HTB = HALF * BK * 2  , STAGE_BYTES = 8 * HTB, NXCD = 8, WGM = 8;

__host__ __device__ __forceinline__ int lds_byte(int r, int c) { const int st = (r >> 4) * 2 + (c >> 5), rr = r & 15, cc = c & 31, ob = rr * 64 + cc * 2; return st * 1024 + (ob ^ (((ob >> 9) & 1) << 5)); }
__host__ __device__ __forceinline__ void stage_rc(int b, int& R, int& C) { const int st = b / 1024, sb = b % 1024, swz = sb ^ (((sb >> 9) & 1) << 5); R = (st >> 1) * 16 + swz / 64; C = (st & 1) * 32 + (swz % 64) / 2; }
__host__ __device__ __forceinline__ int perm32(int rho) { const int n = rho >> 4, i = rho & 15; return 8 * (i >> 2) + 4 * n + (i & 3); }

struct Unit { int pm, pn; };
struct Gemm { const bf16_t* A; const bf16_t* Bt; int M, N, K; };

struct StaticOrder {
    int nM, nN, nwg, G, c;
    __host__ __device__ void init(int M, int N, int G_, int c_) { nM = M / BM; nN = N / BM; nwg = nM * nN; G = G_; c = c_; }
    __host__ __device__ bool next(int i, Unit& u) const {
        const long L = (long)i * G + c; if (L >= nwg) return false;
        int wgid = (int)L; { const int q = nwg / NXCD, r = nwg % NXCD, xcd = wgid % NXCD, off = wgid / NXCD; wgid = (xcd < r ? xcd * (q + 1) : r * (q + 1) + (xcd - r) * q) + off; }
        const int nig = WGM * nN, gid = wgid / nig, fm = gid * WGM, gsz = (nM - fm) < WGM ? (nM - fm) : WGM;
        u.pm = fm + ((wgid % nig) % gsz); u.pn = (wgid % nig) / gsz; return true;
    }
    __device__ __forceinline__ void a_ready(const Unit&) const {}
    __device__ __forceinline__ void done(const Unit&) const {}
};


__device__ __forceinline__ unsigned cvt_pk_bf16(float lo, float hi) { unsigned r; asm volatile("v_cvt_pk_bf16_f32 %0, %1, %2" : "=v"(r) : "v"(lo), "v"(hi)); return r; }
typedef unsigned u32x2 __attribute__((ext_vector_type(2)));

struct EpiProj {
    static constexpr bool PERM = true, AFTER_DRAIN = false;
    bf16_t* P; const float* cosT; const float* sinT; float c2;
    __device__ __forceinline__ void operator()(const f32x4 (&acc)[2][2][4][2], const Unit& u, int wr, int wc, int fr, int fq) const {
        const int row0 = u.pm * BM + wr * 64 + fr;
        const int kind = (u.pn >= 8 && u.pn < 12) ? (u.pn < 10 ? 1 : 2) : 0;
        if (kind == 0) {
            const int col0 = u.pn * BM + wc * 32 + 8 * fq;
#pragma unroll
            for (int ai = 0; ai < 2; ++ai)
#pragma unroll
                for (int m = 0; m < 4; ++m) { bf16_t* rowp = P + (size_t)(row0 + ai * HALF + m * 16) * 4096 + col0;
#pragma unroll
                    for (int bj = 0; bj < 2; ++bj) { const f32x4 v0 = acc[ai][bj][m][0], v1 = acc[ai][bj][m][1];
                        u32x4 w; w.x = cvt_pk_bf16(v0[0], v0[1]); w.y = cvt_pk_bf16(v0[2], v0[3]); w.z = cvt_pk_bf16(v1[0], v1[1]); w.w = cvt_pk_bf16(v1[2], v1[3]);
                        st16_wt(rowp + bj * HALF, w); } }
        } else {
            const float sc = (kind == 1) ? c2 : 1.0f;
#pragma unroll
            for (int ai = 0; ai < 2; ++ai)
#pragma unroll
                for (int m = 0; m < 4; ++m) { const int row = row0 + ai * HALF + m * 16; const int pos = row & 8191;
#pragma unroll
                    for (int bj = 0; bj < 2; ++bj) { const f32x4 v0 = acc[ai][bj][m][0], v1 = acc[ai][bj][m][1];
                        const int cg_ = u.pn * BM + bj * HALF + wc * 32 + 8 * fq; const int i0 = (cg_ & 63) >> 1; const int gb = cg_ & ~63;
                        const f32x4 cs = *(const f32x4*)(cosT + pos * 32 + i0), sn = *(const f32x4*)(sinT + pos * 32 + i0);
                        const f32x4 x1 = (f32x4){v0[0], v0[2], v1[0], v1[2]}, x2 = (f32x4){v0[1], v0[3], v1[1], v1[3]};
                        const f32x4 o1 = (x1 * cs - x2 * sn) * sc, o2 = (x2 * cs + x1 * sn) * sc;
                        u32x2 w1, w2; w1.x = cvt_pk_bf16(o1[0], o1[1]); w1.y = cvt_pk_bf16(o1[2], o1[3]); w2.x = cvt_pk_bf16(o2[0], o2[1]); w2.y = cvt_pk_bf16(o2[2], o2[3]);
                        bf16_t* dst = P + (size_t)row * 4096 + gb + i0;
                        st8_wt(dst, w1); st8_wt(dst + 32, w2); } }
        }
    }
};
struct EpiRes {
    static constexpr bool PERM = false, AFTER_DRAIN = false;
    const float* base; float* out;
    __device__ __forceinline__ void operator()(const f32x4 (&acc)[2][2][4][2], const Unit& u, int wr, int wc, int fr, int fq) const {
        const int row0 = u.pm * BM + wr * 64 + fr, col0 = u.pn * BM + wc * 32 + 4 * fq;
#pragma unroll
        for (int ai = 0; ai < 2; ++ai)
#pragma unroll
            for (int m = 0; m < 4; ++m) { const size_t off = (size_t)(row0 + ai * HALF + m * 16) * 1024 + col0;
#pragma unroll
                for (int bj = 0; bj < 2; ++bj)
#pragma unroll
                    for (int n = 0; n < 2; ++n) { const f32x4 bs = *(const f32x4*)(base + off + bj * HALF + n * 16); st16f_wt(out + off + bj * HALF + n * 16, bs + acc[ai][bj][m][n]); }
                if (m & 1) asm volatile("" ::: "memory"); }
    }
};

template <class Epi, class Sched, bool ALIGN_EPI = false, bool SP2 = false>
__device__ __forceinline__ void gemm_phase(PG8_LAS unsigned char* lds, const Gemm g, const Sched& S, const Epi& E) {
    const int tid = threadIdx.x, wid = __builtin_amdgcn_readfirstlane(tid >> 6), lane = tid & 63, wr = wid >> 2, wc = wid & 3, fr = lane & 15, fq = lane >> 4;
    const int K = g.K, nt = K / BK;
    unsigned voffA[2], voffB[2];
#pragma unroll
    for (int i = 0; i < 2; ++i) { int R, C; stage_rc(tid * 16 + i * 8192, R, C); const int Rb = Epi::PERM ? ((R & ~31) + perm32(R & 31)) : R;
        voffA[i] = (unsigned)(R * K + C) * 2u; voffB[i] = (unsigned)(Rb * K + C) * 2u; }
    const size_t kstep = (size_t)(BK * 2);
    const size_t hstep = (size_t)HALF * K * 2;
    const size_t tstep = 2 * hstep;
    const unsigned ldsw = (unsigned)wid * 1024u;
    const int aoff = lds_byte(wr * 64 + fr, fq * 8), boff = lds_byte(wc * 32 + fr, fq * 8);
#define PG8_SA(b, h) (((b) * 2 + (h)) * HTB)
#define PG8_SB(b, h) ((4 + (b) * 2 + (h)) * HTB)
#define PG8_STAGE(bufoff, gbase, voff) do { _Pragma("unroll") for (int _i = 0; _i < 2; ++_i) \
        __builtin_amdgcn_global_load_lds((const unsigned*)((const char*)(gbase) + (voff)[_i]), (PG8_LAS unsigned*)(lds + (bufoff) + ldsw + _i * 8192), 16, 0, 0); } while (0)
#define PG8_LDA(dst, b, h) do { _Pragma("unroll") for (int m = 0; m < 4; ++m) _Pragma("unroll") for (int k = 0; k < 2; ++k) dst[m][k] = *(const PG8_LAS bf16x8*)(lds + PG8_SA(b, h) + aoff + m * 2048 + k * 1024); } while (0)
#define PG8_LDB(dst, b, h) do { _Pragma("unroll") for (int n = 0; n < 2; ++n) _Pragma("unroll") for (int k = 0; k < 2; ++k) dst[n][k] = *(const PG8_LAS bf16x8*)(lds + PG8_SB(b, h) + boff + n * 2048 + k * 1024); } while (0)
#define PG8_MMA(ai, bj, At, Bt) do { __builtin_amdgcn_s_setprio(1); _Pragma("unroll") for (int m = 0; m < 4; ++m) _Pragma("unroll") for (int n = 0; n < 2; ++n) _Pragma("unroll") for (int k = 0; k < 2; ++k) \
        acc[ai][bj][m][n] = __builtin_amdgcn_mfma_f32_16x16x32_bf16(Bt[n][k], At[m][k], acc[ai][bj][m][n], 0, 0, 0); __builtin_amdgcn_s_setprio(0); } while (0)
#define PG8_WAIT_V(n) asm volatile("s_waitcnt vmcnt(" #n ")" ::: "memory")
#define PG8_WAIT_L(n) asm volatile("s_waitcnt lgkmcnt(" #n ")" ::: "memory")
#define PG8_BAR __builtin_amdgcn_s_barrier()
#define PG8_SCHED __builtin_amdgcn_sched_barrier(0)
    Unit cur, nxt; int ui = 0;
    if (!S.next(0, cur)) return;
    f32x4 acc[2][2][4][2];
#pragma unroll
    for (int a = 0; a < 2; ++a)
#pragma unroll
        for (int b = 0; b < 2; ++b)
#pragma unroll
            for (int m = 0; m < 4; ++m)
#pragma unroll
                for (int n = 0; n < 2; ++n) acc[a][b][m][n] = (f32x4){0.f, 0.f, 0.f, 0.f};
    bf16x8 At[4][2], B0[2][2], B1[2][2];
    const char* cA = (const char*)g.A + (size_t)cur.pm * tstep; const char* cB = (const char*)g.Bt + (size_t)cur.pn * tstep;
    S.a_ready(cur);
    if constexpr (SP2) {
        PG8_STAGE(PG8_SB(0, 0), cB, voffB); PG8_STAGE(PG8_SB(0, 1), cB + hstep, voffB); PG8_STAGE(PG8_SA(0, 0), cA, voffA); PG8_STAGE(PG8_SA(0, 1), cA + hstep, voffA);
        if (wr == 1) PG8_BAR;
        PG8_WAIT_V(2); PG8_BAR;
        PG8_STAGE(PG8_SB(1, 0), cB + kstep, voffB); PG8_STAGE(PG8_SA(1, 0), cA + kstep, voffA); PG8_STAGE(PG8_SB(1, 1), cB + hstep + kstep, voffB);
        PG8_WAIT_V(6); PG8_BAR;
    } else {
        PG8_STAGE(PG8_SB(0, 0), cB, voffB); PG8_STAGE(PG8_SA(0, 0), cA, voffA); PG8_STAGE(PG8_SB(0, 1), cB + hstep, voffB); PG8_STAGE(PG8_SA(0, 1), cA + hstep, voffA);
        if (wr == 1) PG8_BAR;
        PG8_WAIT_V(4); PG8_BAR;
        PG8_STAGE(PG8_SB(1, 0), cB + kstep, voffB); PG8_STAGE(PG8_SA(1, 0), cA + kstep, voffA); PG8_STAGE(PG8_SB(1, 1), cB + hstep + kstep, voffB);
        PG8_WAIT_V(6); PG8_BAR;
    }
    for (;;) {
        const bool has_next = S.next(ui + 1, nxt);
        const char* nA = has_next ? (const char*)g.A + (size_t)nxt.pm * tstep : cA; const char* nB = has_next ? (const char*)g.Bt + (size_t)nxt.pn * tstep : cB;
        for (int t = 0; t < nt; t += 2) {
            const bool last = (t == nt - 2);
            const char* a1 = cA + (size_t)(t + 1) * kstep;
            const char* a2 = last ? nA : cA + (size_t)(t + 2) * kstep; const char* b2 = last ? nB : cB + (size_t)(t + 2) * kstep;
            const char* a3 = a2 + kstep; const char* b3 = b2 + kstep;
            if (last && has_next) S.a_ready(nxt);
            if constexpr (SP2) {
            PG8_LDB(B0, 0, 0); PG8_LDB(B1, 0, 1); PG8_SCHED; PG8_LDA(At, 0, 0); PG8_STAGE(PG8_SA(1, 1), a1 + hstep, voffA);
            PG8_WAIT_V(8); PG8_WAIT_L(0); PG8_BAR; PG8_MMA(0, 0, At, B0); PG8_MMA(0, 1, At, B1); PG8_BAR; PG8_SCHED;
            PG8_LDA(At, 0, 1); PG8_STAGE(PG8_SB(0, 0), b2, voffB); PG8_STAGE(PG8_SB(0, 1), b2 + hstep, voffB); PG8_STAGE(PG8_SA(0, 0), a2, voffA);
            PG8_WAIT_V(8); PG8_WAIT_L(0); PG8_BAR; PG8_MMA(1, 0, At, B0); PG8_MMA(1, 1, At, B1); PG8_BAR; PG8_SCHED;
            PG8_LDB(B0, 1, 0); PG8_LDB(B1, 1, 1); PG8_SCHED; PG8_LDA(At, 1, 0); PG8_STAGE(PG8_SA(0, 1), a2 + hstep, voffA);
            PG8_WAIT_V(8); PG8_WAIT_L(0); PG8_BAR; PG8_MMA(0, 0, At, B0); PG8_MMA(0, 1, At, B1); PG8_BAR; PG8_SCHED;
            PG8_LDA(At, 1, 1); PG8_STAGE(PG8_SB(1, 0), b3, voffB); PG8_STAGE(PG8_SB(1, 1), b3 + hstep, voffB); PG8_STAGE(PG8_SA(1, 0), a3, voffA);
            PG8_WAIT_V(8); PG8_WAIT_L(0); PG8_BAR; PG8_MMA(1, 0, At, B0); PG8_MMA(1, 1, At, B1); PG8_BAR; PG8_SCHED;
            } else {
            PG8_LDB(B0, 0, 0); PG8_SCHED; PG8_LDA(At, 0, 0); PG8_STAGE(PG8_SA(1, 1), a1 + hstep, voffA);
            PG8_WAIT_L(8); PG8_BAR; PG8_WAIT_L(0); PG8_MMA(0, 0, At, B0); PG8_BAR; PG8_SCHED;
            PG8_LDB(B1, 0, 1); PG8_STAGE(PG8_SB(0, 0), b2, voffB);
            PG8_BAR; PG8_WAIT_L(0); PG8_MMA(0, 1, At, B1); PG8_BAR;
            PG8_LDA(At, 0, 1); PG8_STAGE(PG8_SA(0, 0), a2, voffA);
            PG8_BAR; PG8_WAIT_L(0); PG8_MMA(1, 0, At, B0); PG8_BAR; PG8_SCHED;
            PG8_STAGE(PG8_SB(0, 1), b2 + hstep, voffB);
            PG8_WAIT_V(6); PG8_BAR; PG8_MMA(1, 1, At, B1); PG8_BAR;
            PG8_LDB(B0, 1, 0); PG8_SCHED; PG8_LDA(At, 1, 0); PG8_STAGE(PG8_SA(0, 1), a2 + hstep, voffA);
            PG8_WAIT_L(8); PG8_BAR; PG8_WAIT_L(0); PG8_MMA(0, 0, At, B0); PG8_BAR; PG8_SCHED;
            PG8_LDB(B1, 1, 1); PG8_STAGE(PG8_SB(1, 0), b3, voffB);
            PG8_BAR; PG8_WAIT_L(0); PG8_MMA(0, 1, At, B1); PG8_BAR;
            PG8_LDA(At, 1, 1); PG8_STAGE(PG8_SA(1, 0), a3, voffA);
            PG8_BAR; PG8_WAIT_L(0); PG8_MMA(1, 0, At, B0); PG8_BAR; PG8_SCHED;
            PG8_STAGE(PG8_SB(1, 1), b3 + hstep, voffB);
            PG8_WAIT_V(6); PG8_BAR; PG8_MMA(1, 1, At, B1); PG8_BAR;
            }
        }
        if constexpr (ALIGN_EPI) { if (wr == 0) PG8_BAR; }
        if constexpr (!Epi::AFTER_DRAIN) { E(acc, cur, wr, wc, fr, fq); S.done(cur); }
        if (!has_next) break;
#pragma unroll
        for (int a = 0; a < 2; ++a)
#pragma unroll
            for (int b = 0; b < 2; ++b)
#pragma unroll
                for (int m = 0; m < 4; ++m)
#pragma unroll
                    for (int n = 0; n < 2; ++n) acc[a][b][m][n] = (f32x4){0.f, 0.f, 0.f, 0.f};
        cur = nxt; cA = nA; cB = nB; ++ui;
        if constexpr (ALIGN_EPI) { if (wr == 1) PG8_BAR; }
    }
    PG8_WAIT_V(0);
    if constexpr (!ALIGN_EPI) { if (wr == 0) PG8_BAR; }
    PG8_BAR;
    if constexpr (Epi::AFTER_DRAIN) { E.fused(acc, cur, wr, wc, fr, fq, lds, wid, lane); S.done(cur); }
#undef PG8_SA
#undef PG8_SB
#undef PG8_STAGE
#undef PG8_LDA
#undef PG8_LDB
#undef PG8_MMA
#undef PG8_WAIT_V
#undef PG8_WAIT_L
#undef PG8_BAR
#undef PG8_SCHED
}
}

constexpr int BATCH = 2, SEQ = 8192, DMODEL = 1024, DEPTH = 2, TOK = BATCH * SEQ;
constexpr int DIN = 4104, NPROJ = 4096;
constexpr int C_MQ = 0, C_MK = 512, C_MV = 1024, C_MZ = 1536, C_AQ = 2048, C_AK = 2560, C_AV = 3072, C_AZ = 3584;
constexpr float EPS = 1e-6f;
constexpr float C2 = 0.125f * 1.4426950408889634f;
constexpr float KSCALE = 0.08838834764831845f;
__constant__ float INVF[32] = {1.000000000e+00f, 7.498942018e-01f, 5.623413324e-01f, 4.216965139e-01f, 3.162277639e-01f, 2.371373624e-01f, 1.778279394e-01f, 1.333521456e-01f, 1.000000015e-01f, 7.498941571e-02f, 5.623412877e-02f, 4.216964915e-02f, 3.162277862e-02f, 2.371373586e-02f, 1.778279431e-02f, 1.333521493e-02f, 9.999999776e-03f, 7.498942316e-03f, 5.623413250e-03f, 4.216964822e-03f, 3.162277862e-03f, 2.371373819e-03f, 1.778279431e-03f, 1.333521446e-03f, 1.000000047e-03f, 7.498941850e-04f, 5.623413017e-04f, 4.216964880e-04f, 3.162277862e-04f, 2.371373848e-04f, 1.778279402e-04f, 1.333521504e-04f};
__device__ __forceinline__ float lambda_init(int l) { return l == 0 ? 0.2f : 0.35550906759096934f; }

constexpr size_t MiB = 1u << 20;
constexpr size_t WS_CTL = 0, CTL_ZERO_BYTES = 1 * MiB;
constexpr size_t WS_WIN = 2 * MiB;
constexpr size_t WS_WOUT = 18 * MiB;
constexpr size_t WS_COS = 22 * MiB, WS_SIN = 23 * MiB;
constexpr size_t WS_LAM = 24 * MiB;
constexpr size_t WS_GATES = 25 * MiB;
constexpr size_t WS_DC = 32 * MiB, WS_CST = 48 * MiB;
constexpr size_t WS_XN = 56 * MiB;
constexpr size_t WS_PROJ = 88 * MiB;
constexpr size_t WS_QC = 216 * MiB, WS_KC = 232 * MiB, WS_END = 248 * MiB;

constexpr int RING_BYTES = 131072, LDS_BYTES = 147456, MISC_OFF = 147200;

typedef unsigned short bf16;
typedef float f32x4 __attribute__((ext_vector_type(4)));
typedef unsigned v4u __attribute__((ext_vector_type(4)));
typedef unsigned u32x4_t __attribute__((ext_vector_type(4)));
typedef unsigned u32x2_t __attribute__((ext_vector_type(2)));
#define LAS __attribute__((address_space(3)))
__device__ __forceinline__ float bf2f(unsigned short u) { return __uint_as_float((unsigned)u << 16); }
__device__ __forceinline__ unsigned f2bf(float f) { unsigned u = __builtin_bit_cast(unsigned, f); return (u + 0x7fffu + ((u >> 16) & 1u)) >> 16; }
__device__ __forceinline__ unsigned pk2(float lo, float hi) { return f2bf(lo) | (f2bf(hi) << 16); }
__device__ __forceinline__ float wave_sum(float v) {
#pragma unroll
    for (int o = 1; o < 64; o <<= 1) v += __shfl_xor(v, o);
    return v;
}
__device__ __forceinline__ float silu_f(float x) { return x / (1.0f + __expf(-x)); }
__device__ __forceinline__ float logsigmoid_f(float x) { return fminf(x, 0.f) - log1pf(expf(-fabsf(x))); }

struct Args {
    const float* x; const float* norm_w; const float* w_in; const float* conv_w; const float* conv_b; const float* i_bias; const float* f_bias; const float* m_norm_w;
    const float* m_skip; const float* lq1; const float* lk1; const float* lq2; const float* lk2; const float* a_norm_w; const float* w_out; const float* fnw;
    float* out; unsigned char* ws; int ph_lo, ph_hi;
};

__device__ __forceinline__ int src_col(int g) {
    if (g < 1536) return g;
    if (g < 2048) return g + 8;
    if (g < 3072) { const int base = (g < 2560) ? 2056 : 2568; const int j = (g - 2048) & 511; const int grp = j >> 6, jj = j & 63; return base + grp * 64 + (jj >> 1) + 32 * (jj & 1); }
    return g + 8;
}
template <bool MAP> __device__ __forceinline__ void transpose_item(const float* W, int ldw, int K, int N, bf16* WT, LAS float* scr, int item, int lane) {
    const int nblk = N / 32, kb = item / nblk, nb = item % nblk, k0 = 64 * kb, n0 = 32 * nb;
    const int sc = MAP ? src_col(n0 + (lane & 31)) : (n0 + (lane & 31));
#pragma unroll 8
    for (int i = 0; i < 32; ++i) { const int kk = 2 * i + (lane >> 5); scr[kk * 33 + (lane & 31)] = W[(size_t)(k0 + kk) * ldw + sc]; }
    asm volatile("s_waitcnt lgkmcnt(0)" ::: "memory");
    const int c = lane & 7;
#pragma unroll
    for (int j = 0; j < 4; ++j) { const int n = (lane >> 3) + 8 * j; const LAS float* s = scr + (8 * c) * 33 + n;
        v4u o; o.x = pk2(s[0 * 33], s[1 * 33]); o.y = pk2(s[2 * 33], s[3 * 33]); o.z = pk2(s[4 * 33], s[5 * 33]); o.w = pk2(s[6 * 33], s[7 * 33]);
        *(v4u*)(WT + (size_t)(n0 + n) * K + k0 + 8 * c) = o; }
    asm volatile("s_waitcnt lgkmcnt(0)" ::: "memory");
}
__device__ __forceinline__ void sincos_acc(float xf, float& s, float& c) {
    const double x = (double)xf; const double k = __builtin_rint(x * 0.63661977236758134308);
    const double r = (x - k * 1.57079632679489655800) - k * 6.123233995736766e-17; const double r2 = r * r;
    double sp = r2 * (-1.0 / 6227020800.0) + (1.0 / 39916800.0); sp = sp * r2 - (1.0 / 362880.0); sp = sp * r2 + (1.0 / 5040.0); sp = sp * r2 - (1.0 / 120.0); sp = sp * r2 + (1.0 / 6.0); sp = r - r * r2 * sp;
    double cp = r2 * (1.0 / 87178291200.0) - (1.0 / 479001600.0); cp = cp * r2 + (1.0 / 3628800.0); cp = cp * r2 - (1.0 / 40320.0); cp = cp * r2 + (1.0 / 720.0); cp = cp * r2 - (1.0 / 24.0); cp = cp * r2 + 0.5; cp = 1.0 - r2 * cp;
    const int q = ((int)k) & 3;
    const double ss = (q == 0) ? sp : (q == 1) ? cp : (q == 2) ? -sp : -cp;
    const double cc = (q == 0) ? cp : (q == 1) ? -sp : (q == 2) ? -cp : sp;
    s = (float)ss; c = (float)cc;
}

struct Frame {
    LAS unsigned char* lds; int tid, lane, wave, vcu, G;
    unsigned char* ws;
};

__device__ __forceinline__ void phase_prologue(const Frame& F, const Args& a) {
    LAS float* scr = (LAS float*)(F.lds + F.wave * 16384);
    const int gw = F.vcu * 8 + F.wave, NGW = F.G * 8;
    constexpr int I_IN = (DMODEL / 64) * (NPROJ / 32), I_OUT = (DMODEL / 64) * (DMODEL / 32);
    constexpr int NITEMS = DEPTH * (I_IN + I_OUT);
    for (int it = gw; it < NITEMS; it += NGW) {
        int r = it; const int l = r / (I_IN + I_OUT); r -= l * (I_IN + I_OUT);
        if (r < I_IN) transpose_item<true>(a.w_in + (size_t)l * DMODEL * DIN, DIN, DMODEL, NPROJ, (bf16*)(F.ws + WS_WIN) + (size_t)l * NPROJ * DMODEL, scr, r, F.lane);
        else transpose_item<false>(a.w_out + (size_t)l * DMODEL * DMODEL, DMODEL, DMODEL, DMODEL, (bf16*)(F.ws + WS_WOUT) + (size_t)l * DMODEL * DMODEL, scr, r - I_IN, F.lane);
    }
    float* cosT = (float*)(F.ws + WS_COS); float* sinT = (float*)(F.ws + WS_SIN);
    for (int idx = (F.vcu * 512 + F.tid); idx < SEQ * 32; idx += F.G * 512) {
        const int pos = idx >> 5, i = idx & 31; const float ang = (float)pos * INVF[i]; float s, c; sincos_acc(ang, s, c); cosT[idx] = c; sinT[idx] = s;
    }
    if (F.vcu == 0 && F.wave < DEPTH) {
        const int l = F.wave;
        const float p1 = wave_sum(a.lq1[l * 64 + F.lane] * a.lk1[l * 64 + F.lane]), p2 = wave_sum(a.lq2[l * 64 + F.lane] * a.lk2[l * 64 + F.lane]);
        if (F.lane == 0) ((float*)(F.ws + WS_LAM))[l] = expf(p1) - expf(p2) + lambda_init(l);
    }
}

__device__ __forceinline__ void phase_rownorm(const Frame& F, const float* xin, const float* nw, const float* wg_src, const float* ib, const float* fb, bf16* XN, float* GATES, float* fout) {
    LAS float* WG = (LAS float*)F.lds;
    __syncthreads();
    if (wg_src) {
        for (int idx = F.tid; idx < 8192; idx += 512) { const int k = idx >> 3, g = idx & 7; WG[g * 1024 + k] = wg_src[(size_t)k * DIN + 1536 + g]; }
    }
    __syncthreads();
    const int gw = F.vcu * 8 + F.wave, NGW = F.G * 8;
    f32x4 nwv[4];
#pragma unroll
    for (int j = 0; j < 4; ++j) nwv[j] = ((const f32x4*)nw)[64 * j + F.lane];
    for (int row = gw; row < TOK; row += NGW) {
        const f32x4* xr = (const f32x4*)(xin + (size_t)row * DMODEL) + F.lane;
        f32x4 v[4]; float s = 0.f;
#pragma unroll
        for (int j = 0; j < 4; ++j) { v[j] = xr[64 * j]; s += (v[j].x * v[j].x + v[j].y * v[j].y) + (v[j].z * v[j].z + v[j].w * v[j].w); }
        const float rstd = 1.0f / sqrtf(wave_sum(s) * (1.0f / DMODEL) + EPS);
#pragma unroll
        for (int j = 0; j < 4; ++j) v[j] = v[j] * rstd * nwv[j];
        if (fout) {
            f32x4* o = (f32x4*)(fout + (size_t)row * DMODEL) + F.lane;
#pragma unroll
            for (int j = 0; j < 4; ++j) st16f_wt(&o[64 * j], v[j]);
        } else {
            unsigned long long* o8 = (unsigned long long*)(XN + (size_t)row * DMODEL) + F.lane;
#pragma unroll
            for (int j = 0; j < 4; ++j) st8_wt(&o8[64 * j], (wt_u32x2){pk2(v[j].x, v[j].y), pk2(v[j].z, v[j].w)});
            float gs[8];
#pragma unroll
            for (int g = 0; g < 8; ++g) { float t = 0.f;
#pragma unroll
                for (int j = 0; j < 4; ++j) { const f32x4 w = *(const LAS f32x4*)(WG + g * 1024 + 256 * j + 4 * F.lane); t += (v[j].x * w.x + v[j].y * w.y) + (v[j].z * w.z + v[j].w * w.w); }
                gs[g] = wave_sum(t); }
            float mine = gs[0];
#pragma unroll
            for (int g = 1; g < 8; ++g) mine = (F.lane == g) ? gs[g] : mine;
            if (F.lane < 4) GATES[(size_t)row * 8 + F.lane] = mine + ib[F.lane];
            else if (F.lane < 8) GATES[(size_t)row * 8 + F.lane] = logsigmoid_f(mine + fb[F.lane - 4]);
        }
    }
    __syncthreads();
}

__device__ __forceinline__ void naive_mlstm_unit(const Frame& F, const Args& a, int l, int bh) {
    const int b = bh >> 2, h = bh & 3, e = F.tid & 127; const bool act = F.tid < 128;
    LAS float* qs = (LAS float*)F.lds; LAS float* ks = qs + 128; LAS float* red = ks + 128; LAS float* red2 = red + 8;
    const bf16* PROJ = (const bf16*)(F.ws + WS_PROJ); const float* GATES = (const float*)(F.ws + WS_GATES); bf16* Y = (bf16*)(F.ws + WS_XN);
    const float* cw = a.conv_w + (size_t)l * 4 * 1024; const float* cb = a.conv_b + (size_t)l * 1024;
    const int cq = h * 128 + e, ck = 512 + h * 128 + e;
    const float wq0 = cw[cq], wq1 = cw[1024 + cq], wq2 = cw[2048 + cq], wq3 = cw[3072 + cq], bq = cb[cq];
    const float wk0 = cw[ck], wk1 = cw[1024 + ck], wk2 = cw[2048 + ck], wk3 = cw[3072 + ck], bk = cb[ck];
    const float mnw = a.m_norm_w[l * 512 + cq], msk = a.m_skip[l * 512 + cq];
    float C[128];
#pragma unroll
    for (int d = 0; d < 128; ++d) C[d] = 0.f;
    float n_e = 0.f, m = 0.f, xq1 = 0.f, xq2 = 0.f, xq3 = 0.f, xk1 = 0.f, xk2 = 0.f, xk3 = 0.f;
    for (int t = 0; t < SEQ; ++t) {
        const size_t row = (size_t)b * SEQ + t; const bf16* pr = PROJ + row * 4096;
        float qc = 0.f, ve = 0.f, mz = 0.f, a_ = 0.f, bb = 0.f;
        if (act) {
            const float xq0 = bf2f(pr[C_MQ + cq]), xk0 = bf2f(pr[C_MK + cq]); ve = bf2f(pr[C_MV + cq]); mz = bf2f(pr[C_MZ + cq]);
            const float li = GATES[row * 8 + h], lf = GATES[row * 8 + 4 + h];
            qc = silu_f(bq + wq0 * xq3 + wq1 * xq2 + wq2 * xq1 + wq3 * xq0);
            const float kc = silu_f(bk + wk0 * xk3 + wk1 * xk2 + wk2 * xk1 + wk3 * xk0) * KSCALE;
            xq3 = xq2; xq2 = xq1; xq1 = xq0; xk3 = xk2; xk2 = xk1; xk1 = xk0;
            const float m_new = fmaxf(lf + m, li); a_ = expf(lf + m - m_new); bb = expf(li - m_new); m = m_new;
            n_e = a_ * n_e + bb * kc;
            qs[e] = qc; ks[e] = kc;
            const float dp = wave_sum(n_e * qc); if (F.lane == 0) red[F.wave] = dp;
        }
        __syncthreads();
        float hval = 0.f;
        if (act) {
            const float den = red[0] + red[1]; const float bv = bb * ve; float acc = 0.f;
#pragma unroll
            for (int d = 0; d < 128; ++d) { C[d] = a_ * C[d] + bv * ks[d]; acc += C[d] * qs[d]; }
            hval = acc / fmaxf(fabsf(den), expf(-m));
            const float sq = wave_sum(hval * hval); if (F.lane == 0) red2[F.wave] = sq;
        }
        __syncthreads();
        if (act) {
            const float ssq = red2[0] + red2[1];
            const float hm = hval * (1.0f / sqrtf(ssq * (1.0f / 128.0f) + EPS)) * mnw;
            const float ym = (hm + msk * qc) * silu_f(mz);
            Y[row * 1024 + cq] = (bf16)f2bf(ym);
        }
    }
    __syncthreads();
}

__device__ __forceinline__ void naive_attn_unit(const Frame& F, const Args& a, int l, int unit) {
    const int blk = unit & 63, h = (unit >> 6) & 3, b = unit >> 8;
    const int r = F.tid & 127, map = (F.tid >> 7) & 1, half = F.tid >> 8;
    const int q0 = blk * 128, c0 = q0 >> 6, myc = c0 + (r >> 6);
    LAS float* Kf = (LAS float*)F.lds; LAS float* Vf = Kf + 64 * 128; LAS float* Cb = Kf; LAS float* red = Kf + 2 * 64 * 128;
    const bf16* PROJ = (const bf16*)(F.ws + WS_PROJ); bf16* Y = (bf16*)(F.ws + WS_XN);
    const size_t row = (size_t)b * SEQ + q0 + r;
    float q[64], o[64];
    { const bf16* qp = PROJ + row * 4096 + C_AQ + h * 128 + map * 64;
#pragma unroll
      for (int d = 0; d < 64; ++d) q[d] = bf2f(qp[d]); }
#pragma unroll
    for (int e = 0; e < 64; ++e) o[e] = 0.f;
    float m = -1e30f, lsum = 0.f;
    for (int kt = 0; kt <= c0 + 1; ++kt) {
        __syncthreads();
#pragma unroll
        for (int i = 0; i < 2; ++i) { const int id = F.tid + 512 * i, key = id >> 4, c8 = id & 15;
            const bf16* kp = PROJ + ((size_t)b * SEQ + kt * 64 + key) * 4096 + h * 128 + c8 * 8;
            const v4u kk = *(const v4u*)(kp + C_AK), vv = *(const v4u*)(kp + C_AV);
            LAS float* kd = Kf + key * 128 + c8 * 8; LAS float* vd = Vf + key * 128 + c8 * 8;
            kd[0] = __uint_as_float(kk.x << 16); kd[1] = __uint_as_float(kk.x & 0xffff0000u); kd[2] = __uint_as_float(kk.y << 16); kd[3] = __uint_as_float(kk.y & 0xffff0000u);
            kd[4] = __uint_as_float(kk.z << 16); kd[5] = __uint_as_float(kk.z & 0xffff0000u); kd[6] = __uint_as_float(kk.w << 16); kd[7] = __uint_as_float(kk.w & 0xffff0000u);
            vd[0] = __uint_as_float(vv.x << 16); vd[1] = __uint_as_float(vv.x & 0xffff0000u); vd[2] = __uint_as_float(vv.y << 16); vd[3] = __uint_as_float(vv.y & 0xffff0000u);
            vd[4] = __uint_as_float(vv.z << 16); vd[5] = __uint_as_float(vv.z & 0xffff0000u); vd[6] = __uint_as_float(vv.w << 16); vd[7] = __uint_as_float(vv.w & 0xffff0000u); }
        __syncthreads();
        if (kt <= myc) {
            for (int j = 0; j < 64; ++j) {
                const LAS float* kr = Kf + j * 128 + map * 64; const LAS float* vr = Vf + j * 128 + half * 64;
                float s = 0.f;
#pragma unroll
                for (int d = 0; d < 64; ++d) s += q[d] * kr[d];
                const float m_new = fmaxf(m, s), alpha = exp2f(m - m_new), p = exp2f(s - m_new);
                lsum = lsum * alpha + p; m = m_new;
#pragma unroll
                for (int e = 0; e < 64; ++e) o[e] = o[e] * alpha + p * vr[e];
            }
        }
    }
    __syncthreads();
    const float inv_l = 1.0f / lsum; const float lam = ((const float*)(F.ws + WS_LAM))[l];
    if (map == 1) {
#pragma unroll
        for (int e = 0; e < 64; ++e) Cb[r * 128 + half * 64 + e] = lam * o[e] * inv_l;
    }
    __syncthreads();
    float ssq = 0.f;
    if (map == 0) {
#pragma unroll
        for (int e = 0; e < 64; ++e) { o[e] = o[e] * inv_l - Cb[r * 128 + half * 64 + e]; ssq += o[e] * o[e]; }
        red[half * 128 + r] = ssq;
    }
    __syncthreads();
    if (map == 0) {
        const float rstd = 1.0f / sqrtf((red[r] + red[128 + r]) * (1.0f / 128.0f) + EPS); const float g = 1.0f - lambda_init(l);
        const bf16* azp = PROJ + row * 4096 + C_AZ + h * 128 + half * 64; bf16* yp = Y + row * 1024 + 512 + h * 128 + half * 64; const float* anw = a.a_norm_w + l * 128 + half * 64;
#pragma unroll
        for (int e = 0; e < 64; ++e) yp[e] = (bf16)f2bf(o[e] * rstd * anw[e] * g * silu_f(bf2f(azp[e])));
    }
    __syncthreads();
}

namespace att {
typedef short bf16x8 __attribute__((ext_vector_type(8)));
typedef short s16x4 __attribute__((ext_vector_type(4)));
typedef float f32x16 __attribute__((ext_vector_type(16)));
typedef float f32x2_t __attribute__((ext_vector_type(2))); typedef __bf16 bf16x2_t __attribute__((ext_vector_type(2)));
typedef short v4i16_t __attribute__((ext_vector_type(4)));
constexpr int SLOT = 16384, LDS_K = 0, LDS_V = 3 * SLOT, LDS_X = 0, LDS_S = 6 * SLOT, SPITCH = 272, LDS_END = LDS_S + 4 * 32 * SPITCH;
constexpr float THR = 8.0f;
__device__ __forceinline__ void glds16(const void* gsrc, unsigned lds_dst) { unsigned keep;
    asm volatile("s_mov_b32 %0, m0\n\ts_mov_b32 m0, %2\n\ts_nop 0\n\tglobal_load_lds_dwordx4 %1, off\n\ts_mov_b32 m0, %0" : "=&s"(keep) : "v"(gsrc), "s"(lds_dst) : "memory"); }
template <int IMM> __device__ __forceinline__ void glds16s(const void* sbase, unsigned voff, unsigned lds_dst_) { unsigned keep; const unsigned lds_dst = lds_dst_ - (unsigned)IMM;
    asm volatile("s_mov_b32 %0, m0\n\ts_mov_b32 m0, %3\n\ts_nop 0\n\tglobal_load_lds_dwordx4 %1, %2 offset:%c4\n\ts_mov_b32 m0, %0" : "=&s"(keep) : "v"(voff), "s"(sbase), "s"(lds_dst), "i"(IMM) : "memory"); }
__device__ __forceinline__ unsigned cvtpk(float lo, float hi) { f32x2_t v = {lo, hi}; bf16x2_t b = __builtin_convertvector(v, bf16x2_t); return __builtin_bit_cast(unsigned, b); }
__device__ __forceinline__ s16x4 vtr(const LAS char* p) { return __builtin_bit_cast(s16x4, __builtin_amdgcn_ds_read_tr16_b64_v4i16((LAS v4i16_t*)p)); }
__device__ __forceinline__ float swap_max(float m) { auto rr = __builtin_amdgcn_permlane32_swap(__float_as_uint(m), __float_as_uint(m), false, false); return fmaxf(__uint_as_float(rr[0]), __uint_as_float(rr[1])); }
__device__ __forceinline__ float swap_add(float m) { auto rr = __builtin_amdgcn_permlane32_swap(__float_as_uint(m), __float_as_uint(m), false, false); return __uint_as_float(rr[0]) + __uint_as_float(rr[1]); }
#define ATT_WAIT_BAR(N) asm volatile("s_waitcnt vmcnt(" #N ") lgkmcnt(0)\n\ts_barrier" ::: "memory")

__device__ __forceinline__ void attn_unit(const Frame& F, const Args& a, const int L, const int b, const int h, const int j) {
    const int lane = F.lane, r32 = lane & 31, hi = lane >> 5, wid = F.wave, rb = wid & 3, map = wid >> 2;
    const bf16* PROJ = (const bf16*)(F.ws + WS_PROJ); bf16* Y = (bf16*)(F.ws + WS_XN);
    const size_t rowbase = (size_t)b * SEQ; const int q0 = j * 128;
    const int NT = 2 * j + 2, myNT = 2 * j + 1 + (rb >> 1);
    const unsigned lds0 = (unsigned)(uintptr_t)F.lds;
    bf16x8 qr[4];
    { const bf16* qp = PROJ + (rowbase + q0 + rb * 32 + r32) * 4096 + C_AQ + h * 128 + map * 64 + hi * 8;
#pragma unroll
      for (int d0 = 0; d0 < 4; ++d0) qr[d0] = *(const bf16x8*)(qp + d0 * 16); }
    asm volatile("s_waitcnt vmcnt(0)" ::: "memory");
    const bf16* ksrc0 = PROJ + (rowbase + lane) * 4096 + C_AK + h * 128 + wid * 8; const bf16* ksrc1 = ksrc0 + 64;
    const bf16* vsrc0 = PROJ + (rowbase + 16 * (wid & 3) + (lane >> 2)) * 4096 + C_AV + h * 128 + (wid >> 2) * 32 + (lane & 3) * 8; const bf16* vsrc1 = vsrc0 + 64;
    const unsigned kdst = lds0 + LDS_K + wid * 1024, vdst = lds0 + LDS_V + wid * 1024;
#define ATT_DMA(t, slot) do { const size_t to_ = (size_t)(t) * 64 * 4096; const unsigned so_ = (unsigned)(slot) * SLOT; \
        glds16(ksrc0 + to_, (unsigned)__builtin_amdgcn_readfirstlane(kdst + so_)); glds16(ksrc1 + to_, (unsigned)__builtin_amdgcn_readfirstlane(kdst + so_ + 8192)); \
        glds16(vsrc0 + to_, (unsigned)__builtin_amdgcn_readfirstlane(vdst + so_)); glds16(vsrc1 + to_, (unsigned)__builtin_amdgcn_readfirstlane(vdst + so_ + 8192)); } while (0)
    ATT_DMA(0, 0); ATT_DMA(1, 1);
    f32x16 o[4]; o[0] = f32x16{}; o[1] = f32x16{}; o[2] = f32x16{}; o[3] = f32x16{};
    f32x16 negm = f32x16{}; float mhat = 0.f, lsum = 0.f;
    const LAS char* kfrag = (const LAS char*)F.lds + LDS_K + map * 8192 + hi * 1024 + r32 * 16;
    const LAS char* vfrag = (const LAS char*)F.lds + LDS_V + ((lane >> 4) & 1) * 32 + (lane & 3) * 8 + (4 * hi + ((lane & 15) >> 2)) * 64;
    int slot = 0;
    for (int t = 0; t < NT; ++t) {
        if (t + 1 < NT) ATT_WAIT_BAR(4); else ATT_WAIT_BAR(0);
        if (t + 2 < NT) { const int s2 = (slot >= 1) ? slot - 1 : 2; ATT_DMA(t + 2, s2); }
        if (t < myNT) {
            const LAS char* kb = kfrag + slot * SLOT; const LAS char* vb = vfrag + slot * SLOT;
            f32x16 p0, p1;
#pragma unroll
            for (int d0 = 0; d0 < 4; ++d0) {
                const bf16x8 b0 = *(const LAS bf16x8*)(kb + d0 * 2048), b1 = *(const LAS bf16x8*)(kb + d0 * 2048 + 512);
                p0 = __builtin_amdgcn_mfma_f32_32x32x16_bf16(b0, qr[d0], d0 == 0 ? negm : p0, 0, 0, 0);
                p1 = __builtin_amdgcn_mfma_f32_32x32x16_bf16(b1, qr[d0], d0 == 0 ? negm : p1, 0, 0, 0);
            }
            float rm = fmaxf(p0[0], p1[0]);
#pragma unroll
            for (int r = 1; r < 16; ++r) rm = fmaxf(rm, fmaxf(p0[r], p1[r]));
            rm = swap_max(rm);
            if (t == 0 || __any(rm > THR)) {
                const float dl = (t == 0) ? rm : fmaxf(rm, 0.f); mhat += dl;
#pragma unroll
                for (int r = 0; r < 16; ++r) { p0[r] -= dl; p1[r] -= dl; negm[r] = -mhat; }
                const float f = exp2f(-dl); lsum *= f;
#pragma unroll
                for (int d0 = 0; d0 < 4; ++d0)
#pragma unroll
                    for (int r = 0; r < 16; ++r) o[d0][r] *= f;
            }
            float sacc = 0.f;
#pragma unroll
            for (int r = 0; r < 16; ++r) { p0[r] = __builtin_amdgcn_exp2f(p0[r]); p1[r] = __builtin_amdgcn_exp2f(p1[r]); sacc += p0[r] + p1[r]; }
            lsum += sacc;
            bf16x8 pw[4];
            { u32x4_t w0 = {cvtpk(p0[0], p0[1]), cvtpk(p0[2], p0[3]), cvtpk(p0[4], p0[5]), cvtpk(p0[6], p0[7])}; pw[0] = __builtin_bit_cast(bf16x8, w0);
              u32x4_t w1 = {cvtpk(p0[8], p0[9]), cvtpk(p0[10], p0[11]), cvtpk(p0[12], p0[13]), cvtpk(p0[14], p0[15])}; pw[1] = __builtin_bit_cast(bf16x8, w1);
              u32x4_t w2 = {cvtpk(p1[0], p1[1]), cvtpk(p1[2], p1[3]), cvtpk(p1[4], p1[5]), cvtpk(p1[6], p1[7])}; pw[2] = __builtin_bit_cast(bf16x8, w2);
              u32x4_t w3 = {cvtpk(p1[8], p1[9]), cvtpk(p1[10], p1[11]), cvtpk(p1[12], p1[13]), cvtpk(p1[14], p1[15])}; pw[3] = __builtin_bit_cast(bf16x8, w3); }
#pragma unroll
            for (int d0 = 0; d0 < 4; ++d0) {
#pragma unroll
                for (int ks = 0; ks < 4; ++ks) {
                    const s16x4 lo = vtr(vb + d0 * 4096 + ks * 1024), hh = vtr(vb + d0 * 4096 + ks * 1024 + 512);
                    const bf16x8 vf = (bf16x8){lo[0], lo[1], lo[2], lo[3], hh[0], hh[1], hh[2], hh[3]};
                    o[d0] = __builtin_amdgcn_mfma_f32_32x32x16_bf16(vf, pw[ks], o[d0], 0, 0, 0);
                }
            }
        }
        slot = (slot == 2) ? 0 : slot + 1;
    }
    const float inv = 1.0f / swap_add(lsum);
    ATT_WAIT_BAR(0);
    LAS float* X = (LAS float*)(F.lds + LDS_X) + rb * 4096 + lane;
    if (map == 1) {
        const float sc = inv * ((const float*)(F.ws + WS_LAM))[L];
#pragma unroll
        for (int d0 = 0; d0 < 4; ++d0)
#pragma unroll
            for (int r = 0; r < 16; ++r) X[(d0 * 16 + r) * 64] = o[d0][r] * sc;
    }
    ATT_WAIT_BAR(0);
    if (map == 0) {
        float ssq = 0.f;
#pragma unroll
        for (int d0 = 0; d0 < 4; ++d0)
#pragma unroll
            for (int r = 0; r < 16; ++r) { const float v = o[d0][r] * inv - X[(d0 * 16 + r) * 64]; o[d0][r] = v; ssq += v * v; }
        const float rstd = 1.0f / sqrtf(swap_add(ssq) * (1.0f / 128.0f) + EPS);
        LAS char* S = (LAS char*)F.lds + LDS_S + rb * 32 * SPITCH;
#pragma unroll
        for (int d0 = 0; d0 < 4; ++d0)
#pragma unroll
            for (int g4 = 0; g4 < 4; ++g4) { u32x2_t w; w.x = cvtpk(o[d0][4 * g4] * rstd, o[d0][4 * g4 + 1] * rstd); w.y = cvtpk(o[d0][4 * g4 + 2] * rstd, o[d0][4 * g4 + 3] * rstd);
                *(LAS u32x2_t*)(S + r32 * SPITCH + (32 * d0 + 8 * g4 + 4 * hi) * 2) = w; }
        asm volatile("s_waitcnt lgkmcnt(0)" ::: "memory");
        const int ch = lane & 15; const float g = 1.0f - lambda_init(L);
        float anw[8];
#pragma unroll
        for (int k = 0; k < 8; ++k) anw[k] = a.a_norm_w[L * 128 + 8 * ch + k] * g;
#pragma unroll
        for (int it = 0; it < 8; ++it) { const int row = it * 4 + (lane >> 4);
            const u32x4_t sv = *(const LAS u32x4_t*)(S + row * SPITCH + ch * 16);
            const size_t grow = rowbase + q0 + rb * 32 + row;
            const u32x4_t zv = *(const u32x4_t*)(PROJ + grow * 4096 + C_AZ + h * 128 + 8 * ch);
            float v[8], z[8];
#pragma unroll
            for (int k = 0; k < 4; ++k) { v[2 * k] = __uint_as_float(sv[k] << 16); v[2 * k + 1] = __uint_as_float(sv[k] & 0xffff0000u); z[2 * k] = __uint_as_float(zv[k] << 16); z[2 * k + 1] = __uint_as_float(zv[k] & 0xffff0000u); }
            u32x4_t ov;
#pragma unroll
            for (int k = 0; k < 4; ++k) ov[k] = cvtpk(v[2 * k] * anw[2 * k] * silu_f(z[2 * k]), v[2 * k + 1] * anw[2 * k + 1] * silu_f(z[2 * k + 1]));
            st16_wt(Y + grow * 1024 + 512 + h * 128 + 8 * ch, ov); }
    }
    ATT_WAIT_BAR(0);
#undef ATT_DMA
}
typedef const LAS char* lds_cptr;
#define ATT_SBAR() __builtin_amdgcn_sched_barrier(0)
#define ATT_PIN(x) asm volatile("" : "+v"(x))
#define ATT_MX3(a, b, c) __builtin_fmaxf(__builtin_fmaxf((a), (b)), (c))
__device__ __forceinline__ void kload8(bf16x8* kf, lds_cptr kp) {
    kf[0] = *(const LAS bf16x8*)(kp);        kf[1] = *(const LAS bf16x8*)(kp + 512);
    kf[2] = *(const LAS bf16x8*)(kp + 2048); kf[3] = *(const LAS bf16x8*)(kp + 2560);
    kf[4] = *(const LAS bf16x8*)(kp + 4096); kf[5] = *(const LAS bf16x8*)(kp + 4608);
    kf[6] = *(const LAS bf16x8*)(kp + 6144); kf[7] = *(const LAS bf16x8*)(kp + 6656);
}
__device__ __forceinline__ void pv_tail(f32x16 (&o)[4], const u32x4_t& w0, const u32x4_t& w1, const u32x4_t& w2, const u32x4_t& w3, lds_cptr vb) {
    bf16x8 pw[4] = {__builtin_bit_cast(bf16x8, w0), __builtin_bit_cast(bf16x8, w1), __builtin_bit_cast(bf16x8, w2), __builtin_bit_cast(bf16x8, w3)};
#pragma unroll
    for (int ks = 0; ks < 4; ++ks) {
#pragma unroll
        for (int d0 = 0; d0 < 4; ++d0) {
            const s16x4 lo = vtr(vb + d0 * 4096 + ks * 1024), hh = vtr(vb + d0 * 4096 + ks * 1024 + 512);
            const bf16x8 vf = (bf16x8){lo[0], lo[1], lo[2], lo[3], hh[0], hh[1], hh[2], hh[3]};
            o[d0] = __builtin_amdgcn_mfma_f32_32x32x16_bf16(vf, pw[ks], o[d0], 0, 0, 0);
        }
    }
}

__device__ __forceinline__ void attn_unit2(const Frame& F, const Args& a, const int L, const int b, const int h, const int j) {
    const int lane = F.lane, r32 = lane & 31, hi = lane >> 5, wid = F.wave, rb = wid & 3, map = wid >> 2;
    const bf16* PROJ = (const bf16*)(F.ws + WS_PROJ); bf16* Y = (bf16*)(F.ws + WS_XN);
    const size_t rowbase = (size_t)b * SEQ; const int q0 = j * 128;
    const int NT = 2 * j + 2; const bool vis_last = (rb >> 1) != 0;
    const unsigned lds0 = (unsigned)(uintptr_t)F.lds;
    bf16x8 qr[4];
    { const bf16* qp = PROJ + (rowbase + q0 + rb * 32 + r32) * 4096 + C_AQ + h * 128 + map * 64 + hi * 8;
#pragma unroll
      for (int d0 = 0; d0 < 4; ++d0) qr[d0] = *(const bf16x8*)(qp + d0 * 16); }
    asm volatile("s_waitcnt vmcnt(0)" ::: "memory");
    const bf16* kbase = PROJ + rowbase * 4096 + C_AK + h * 128; const bf16* vbase = PROJ + rowbase * 4096 + C_AV + h * 128;
    const unsigned kvoff = (unsigned)(lane * 4096 + wid * 8) * 2u, vvoff = (unsigned)((16 * (wid & 3) + (lane >> 2)) * 4096 + (wid >> 2) * 32 + (lane & 3) * 8) * 2u;
    const unsigned kdst = lds0 + LDS_K + wid * 1024, vdst = lds0 + LDS_V + wid * 1024;
#define DMA_K(t, so) do { const bf16* sb_ = kbase + (size_t)(t) * 64 * 4096; \
        glds16s<0>(sb_, kvoff, (unsigned)__builtin_amdgcn_readfirstlane(kdst + (so))); glds16s<128>(sb_, kvoff, (unsigned)__builtin_amdgcn_readfirstlane(kdst + (so) + 8192)); } while (0)
#define DMA_V(t, so) do { const bf16* sb_ = vbase + (size_t)(t) * 64 * 4096; \
        glds16s<0>(sb_, vvoff, (unsigned)__builtin_amdgcn_readfirstlane(vdst + (so))); glds16s<128>(sb_, vvoff, (unsigned)__builtin_amdgcn_readfirstlane(vdst + (so) + 8192)); } while (0)
    const lds_cptr kp0 = (lds_cptr)F.lds + LDS_K + map * 8192 + hi * 1024 + r32 * 16;
    const lds_cptr vp0 = (lds_cptr)F.lds + LDS_V + ((lane >> 4) & 1) * 32 + (lane & 3) * 8 + (4 * hi + ((lane & 15) >> 2)) * 64;
    DMA_K(0, 0); DMA_V(0, 0); DMA_K(1, SLOT); if (NT > 2) DMA_K(2, 2 * SLOT);
    float mhat = 0.f, l_reg = 0.f; f32x16 o[4]; o[0] = f32x16{}; o[1] = f32x16{}; o[2] = f32x16{}; o[3] = f32x16{};
    f32x16 negm = f32x16{}; asm volatile("" : "+v"(negm));
    bool resc = false; float fres = 1.f;
    f32x16 c0, c1; bf16x8 kf[8]; u32x4_t pwa0, pwa1, pwa2, pwa3, pwb0, pwb1, pwb2, pwb3;
    int sl_prev = 0, sl_cur = 0, sl_next = SLOT;
#define ROT() do { sl_prev = sl_cur; sl_cur = sl_next; sl_next = (sl_next == 2 * SLOT) ? 0 : sl_next + SLOT; } while (0)
#define RESC() do { if (resc) { _Pragma("unroll") for (int d_ = 0; d_ < 4; ++d_) _Pragma("unroll") for (int r = 0; r < 16; ++r) o[d_][r] *= fres; } } while (0)
    if (NT > 2) ATT_WAIT_BAR(6); else ATT_WAIT_BAR(4);
    { kload8(kf, kp0);
#pragma unroll
      for (int d0 = 0; d0 < 4; ++d0) {
          c0 = __builtin_amdgcn_mfma_f32_32x32x16_bf16(kf[2 * d0], qr[d0], d0 == 0 ? negm : c0, 0, 0, 0);
          c1 = __builtin_amdgcn_mfma_f32_32x32x16_bf16(kf[2 * d0 + 1], qr[d0], d0 == 0 ? negm : c1, 0, 0, 0); }
      float rm = fmaxf(c0[0], c1[0]);
#pragma unroll
      for (int r = 1; r < 16; ++r) rm = fmaxf(rm, fmaxf(c0[r], c1[r]));
      rm = swap_max(rm); mhat = rm; float sacc = 0.f;
#pragma unroll
      for (int r = 0; r < 16; ++r) { c0[r] = __builtin_amdgcn_exp2f(c0[r] - rm); c1[r] = __builtin_amdgcn_exp2f(c1[r] - rm); sacc += c0[r] + c1[r]; negm[r] = -mhat; }
      l_reg = sacc; asm volatile("" : "+v"(negm));
      pwa0 = (u32x4_t){cvtpk(c0[0], c0[1]), cvtpk(c0[2], c0[3]), cvtpk(c0[4], c0[5]), cvtpk(c0[6], c0[7])}; pwa1 = (u32x4_t){cvtpk(c0[8], c0[9]), cvtpk(c0[10], c0[11]), cvtpk(c0[12], c0[13]), cvtpk(c0[14], c0[15])};
      pwa2 = (u32x4_t){cvtpk(c1[0], c1[1]), cvtpk(c1[2], c1[3]), cvtpk(c1[4], c1[5]), cvtpk(c1[6], c1[7])}; pwa3 = (u32x4_t){cvtpk(c1[8], c1[9]), cvtpk(c1[10], c1[11]), cvtpk(c1[12], c1[13]), cvtpk(c1[14], c1[15])}; }
    ATT_WAIT_BAR(0);
    if (NT > 3) DMA_K(3, 0);
    DMA_V(1, SLOT);
    ROT();
    kload8(kf, kp0 + sl_cur);
    if (NT > 3) ATT_WAIT_BAR(4); else ATT_WAIT_BAR(0);
    s16x4 vlo[4], vhi[4];
#define VFR(i) (bf16x8){vlo[i][0], vlo[i][1], vlo[i][2], vlo[i][3], vhi[i][0], vhi[i][1], vhi[i][2], vhi[i][3]}
#define VRD(f, buf) do { vlo[buf] = vtr(vp_ + (((f) & 3) * 4096 + ((f) >> 2) * 1024)); vhi[buf] = vtr(vp_ + (((f) & 3) * 4096 + ((f) >> 2) * 1024 + 512)); } while (0)
#define EX(v) __builtin_amdgcn_exp2f(v)
#define KRD(G, jj) do { if (G) { kf[jj] = *(const LAS bf16x8*)(kp0 + sl_next + ((jj) >> 1) * 2048 + ((jj) & 1) * 512); } } while (0)
#define QK(C, kk, dd, CI) do { C = __builtin_amdgcn_mfma_f32_32x32x16_bf16(kf[kk], qr[dd], CI, 0, 0, 0); ATT_SBAR(); } while (0)
#define GAPB(i, PWK, X, B, RD, Y, PB, WD) do { o[(i) & 3] = __builtin_amdgcn_mfma_f32_32x32x16_bf16(VFR((i) & 3), __builtin_bit_cast(bf16x8, PWK), o[(i) & 3], 0, 0, 0); \
        if (RD) VRD((i) + 4, (i) & 3); X[B] = EX(X[B]); X[(B) + 1] = EX(X[(B) + 1]); ATT_PIN(X); \
        if ((i) > 0) { sacc += Y[PB]; sacc += Y[(PB) + 1]; ATT_PIN(sacc); WD = cvtpk(Y[PB], Y[(PB) + 1]); ATT_PIN(WD); } ATT_SBAR(); } while (0)
#define STEP(PW, PN, t, GK, GV, GL) do { ATT_SBAR(); \
    const lds_cptr vp_ = vp0 + sl_prev; \
    if (map == 1) { if (GK) { DMA_K((t) + 3, sl_cur); } if (GV) { DMA_V((t) + 1, sl_next); } } \
    QK(c0, 0, 0, negm); QK(c1, 1, 0, negm); QK(c0, 2, 1, c0); QK(c1, 3, 1, c1); \
    VRD(0, 0); QK(c0, 4, 2, c0); VRD(1, 1); QK(c1, 5, 2, c1); VRD(2, 2); QK(c0, 6, 3, c0); VRD(3, 3); QK(c1, 7, 3, c1); \
    if (map == 0) { if (GK) { DMA_K((t) + 3, sl_cur); } if (GV) { DMA_V((t) + 1, sl_next); } } \
    { float a_ = ATT_MX3(c0[0], c0[1], c1[0]), b_ = ATT_MX3(c0[2], c0[3], c1[1]); a_ = ATT_MX3(a_, c1[2], c1[3]); \
      _Pragma("unroll") for (int r = 4; r < 16; r += 4) { a_ = ATT_MX3(a_, c0[r], c0[r + 1]); b_ = ATT_MX3(b_, c0[r + 2], c0[r + 3]); a_ = ATT_MX3(a_, c1[r], c1[r + 1]); b_ = ATT_MX3(b_, c1[r + 2], c1[r + 3]); } \
      float rm = swap_max(__builtin_fmaxf(a_, b_)); \
      resc = false; \
      if (__builtin_expect(__any(rm > THR), 0)) { const float dl = __builtin_fmaxf(rm, 0.f); mhat += dl; \
        _Pragma("unroll") for (int r = 0; r < 16; ++r) { c0[r] -= dl; c1[r] -= dl; } \
        _Pragma("unroll") for (int r = 0; r < 16; ++r) negm[r] = -mhat; asm volatile("" : "+v"(negm)); \
        fres = __builtin_amdgcn_exp2f(-dl); l_reg *= fres; resc = true; } } \
    ATT_SBAR(); \
    float sacc = 0.f; \
    GAPB(0, PW##0, c0, 0, true, c0, 0, PN##0[0]);  GAPB(1, PW##0, c0, 2, true, c0, 0, PN##0[0]);  GAPB(2, PW##0, c0, 4, true, c0, 2, PN##0[1]);  GAPB(3, PW##0, c0, 6, true, c0, 4, PN##0[2]); \
    KRD(GL, 0); GAPB(4, PW##1, c0, 8, true, c0, 6, PN##0[3]);  KRD(GL, 1); GAPB(5, PW##1, c0, 10, true, c0, 8, PN##1[0]); KRD(GL, 2); GAPB(6, PW##1, c0, 12, true, c0, 10, PN##1[1]); KRD(GL, 3); GAPB(7, PW##1, c0, 14, true, c0, 12, PN##1[2]); \
    KRD(GL, 4); GAPB(8, PW##2, c1, 0, true, c0, 14, PN##1[3]);  KRD(GL, 5); GAPB(9, PW##2, c1, 2, true, c1, 0, PN##2[0]);  KRD(GL, 6); GAPB(10, PW##2, c1, 4, true, c1, 2, PN##2[1]); KRD(GL, 7); GAPB(11, PW##2, c1, 6, true, c1, 4, PN##2[2]); \
    GAPB(12, PW##3, c1, 8, false, c1, 6, PN##2[3]); GAPB(13, PW##3, c1, 10, false, c1, 8, PN##3[0]); GAPB(14, PW##3, c1, 12, false, c1, 10, PN##3[1]); GAPB(15, PW##3, c1, 14, false, c1, 12, PN##3[2]); \
    sacc += c1[14]; sacc += c1[15]; PN##3[3] = cvtpk(c1[14], c1[15]); l_reg += sacc; \
    } while (0)
#define ENDW(tt) do { if ((tt) + 3 < NT) { ATT_WAIT_BAR(4); } else if ((tt) + 2 < NT) { ATT_WAIT_BAR(2); } else { ATT_WAIT_BAR(0); } } while (0)
    int t = 1;
    for (; t + 5 < NT; t += 2) {
        STEP(pwa, pwb, t, true, true, true);     ATT_WAIT_BAR(4); RESC(); ROT();
        STEP(pwb, pwa, t + 1, true, true, true); ATT_WAIT_BAR(4); RESC(); ROT();
    }
    for (; t + 1 < NT; t += 2) {
        STEP(pwa, pwb, t, (t + 3 < NT), (t + 1 < NT), (t + 1 < NT));     ENDW(t);     RESC(); ROT();
        STEP(pwb, pwa, t + 1, (t + 4 < NT), (t + 2 < NT), (t + 2 < NT)); ENDW(t + 1); RESC(); ROT();
    }
    if (vis_last) {
        STEP(pwa, pwb, NT - 1, false, false, false); RESC();
        pv_tail(o, pwb0, pwb1, pwb2, pwb3, vp0 + sl_cur);
    } else {
        pv_tail(o, pwa0, pwa1, pwa2, pwa3, vp0 + sl_prev);
    }
#undef STEP
#undef ENDW
#undef QK
#undef GAPB
#undef KRD
#undef VRD
#undef VFR
#undef EX
#undef ROT
#undef RESC
#undef DMA_K
#undef DMA_V
    const float lsum = l_reg;
    const float inv = 1.0f / swap_add(lsum);
    ATT_WAIT_BAR(0);
    LAS float* X = (LAS float*)(F.lds + LDS_X) + rb * 4096 + lane;
    if (map == 1) {
        const float sc = inv * ((const float*)(F.ws + WS_LAM))[L];
#pragma unroll
        for (int d0 = 0; d0 < 4; ++d0)
#pragma unroll
            for (int r = 0; r < 16; ++r) X[(d0 * 16 + r) * 64] = o[d0][r] * sc;
    }
    ATT_WAIT_BAR(0);
    if (map == 0) {
        float ssq = 0.f;
#pragma unroll
        for (int d0 = 0; d0 < 4; ++d0)
#pragma unroll
            for (int r = 0; r < 16; ++r) { const float v = o[d0][r] * inv - X[(d0 * 16 + r) * 64]; o[d0][r] = v; ssq += v * v; }
        const float rstd = 1.0f / sqrtf(swap_add(ssq) * (1.0f / 128.0f) + EPS);
        LAS char* S = (LAS char*)F.lds + LDS_S + rb * 32 * SPITCH;
#pragma unroll
        for (int d0 = 0; d0 < 4; ++d0)
#pragma unroll
            for (int g4 = 0; g4 < 4; ++g4) { u32x2_t w; w.x = cvtpk(o[d0][4 * g4] * rstd, o[d0][4 * g4 + 1] * rstd); w.y = cvtpk(o[d0][4 * g4 + 2] * rstd, o[d0][4 * g4 + 3] * rstd);
                *(LAS u32x2_t*)(S + r32 * SPITCH + (32 * d0 + 8 * g4 + 4 * hi) * 2) = w; }
        asm volatile("s_waitcnt lgkmcnt(0)" ::: "memory");
        const int ch = lane & 15; const float g = 1.0f - lambda_init(L);
        float anw[8];
#pragma unroll
        for (int k = 0; k < 8; ++k) anw[k] = a.a_norm_w[L * 128 + 8 * ch + k] * g;
#pragma unroll
        for (int it = 0; it < 8; ++it) { const int row = it * 4 + (lane >> 4);
            const u32x4_t sv = *(const LAS u32x4_t*)(S + row * SPITCH + ch * 16);
            const size_t grow = rowbase + q0 + rb * 32 + row;
            const u32x4_t zv = *(const u32x4_t*)(PROJ + grow * 4096 + C_AZ + h * 128 + 8 * ch);
            float v[8], z[8];
#pragma unroll
            for (int k = 0; k < 4; ++k) { v[2 * k] = __uint_as_float(sv[k] << 16); v[2 * k + 1] = __uint_as_float(sv[k] & 0xffff0000u); z[2 * k] = __uint_as_float(zv[k] << 16); z[2 * k + 1] = __uint_as_float(zv[k] & 0xffff0000u); }
            u32x4_t ov;
#pragma unroll
            for (int k = 0; k < 4; ++k) ov[k] = cvtpk(v[2 * k] * anw[2 * k] * silu_f(z[2 * k]), v[2 * k + 1] * anw[2 * k + 1] * silu_f(z[2 * k + 1]));
            st16_wt(Y + grow * 1024 + 512 + h * 128 + 8 * ch, ov); }
    }
    ATT_WAIT_BAR(0);
}
}

namespace ml {
using att::bf16x8; using att::s16x4; using att::f32x16; using att::glds16; using att::cvtpk; using att::vtr; using att::swap_add;
constexpr int NCH = 32;
constexpr float LOG2E = 1.4426950408889634f;
constexpr size_t WS_CROW = 26 * MiB, WS_BROW = WS_CROW + 256 * 1024, WS_PMROW = WS_BROW + 256 * 1024;
constexpr size_t WS_GCH = 27 * MiB, WS_BLCH = WS_GCH + 4096, WS_MST = WS_BLCH + 4096;
constexpr size_t WS_DN = 27 * MiB + 256 * 1024, WS_NST = WS_DN + 128 * 1024;
constexpr int B1_KW = 0, B1_V = 65536, B1_SC = 131072;
#define ML_WAIT_BAR(N) asm volatile("s_waitcnt vmcnt(" #N ") lgkmcnt(0)\n\ts_barrier" ::: "memory")
__device__ __forceinline__ bf16x8 trfrag(const LAS char* p) { const s16x4 lo = vtr(p), hh = vtr(p + 512); return (bf16x8){lo[0], lo[1], lo[2], lo[3], hh[0], hh[1], hh[2], hh[3]}; }
__device__ __forceinline__ void unpack8(const u32x4_t v, float (&f)[8]) {
#pragma unroll
    for (int k = 0; k < 4; ++k) { f[2 * k] = __uint_as_float(v[k] << 16); f[2 * k + 1] = __uint_as_float(v[k] & 0xffff0000u); } }

__device__ __forceinline__ void b1_unit(const Frame& F, const Args& a, const int L, const int bh, const int c) {
    const int tid = F.tid, lane = F.lane, wid = F.wave, hi = lane >> 5, r32 = lane & 31;
    const int b = bh >> 2, h = bh & 3; const size_t row0 = (size_t)b * SEQ + (size_t)c * 256;
    const bf16* PROJ = (const bf16*)(F.ws + WS_PROJ); const float* GATES = (const float*)(F.ws + WS_GATES);
    bf16* QC = (bf16*)(F.ws + WS_QC); bf16* KC = (bf16*)(F.ws + WS_KC);
    const unsigned lds0 = (unsigned)(uintptr_t)F.lds;
    LAS float* wl = (LAS float*)(F.lds + B1_SC); LAS float* wsum = wl + 256; LAS float* wmax = wsum + 8;
    { const bf16* vs = PROJ + (row0 + 16 * (wid & 3) + (lane >> 2)) * 4096 + C_MV + h * 128 + (wid >> 2) * 32 + (lane & 3) * 8; unsigned vd = lds0 + B1_V + wid * 1024;
#pragma unroll 1
      for (int i = 0; i < 4; ++i) { glds16(vs, (unsigned)__builtin_amdgcn_readfirstlane(vd)); glds16(vs + 64, (unsigned)__builtin_amdgcn_readfirstlane(vd + 8192)); vs += 64 * 4096; vd += 16384; } }
    float bl = 0.f, cl = 0.f, pm = 0.f;
    if (tid < 256) {
        const float lf = GATES[(row0 + tid) * 8 + 4 + h], li = GATES[(row0 + tid) * 8 + h];
        bl = lf;
#pragma unroll
        for (int off = 1; off < 64; off <<= 1) { const float t = __shfl_up(bl, off); if (lane >= off) bl += t; }
        if (lane == 63) wsum[wid] = bl;
    }
    __syncthreads();
    if (tid < 256) {
        float offs = 0.f;
#pragma unroll
        for (int w = 0; w < 4; ++w) offs += (w < wid) ? wsum[w] : 0.f;
        bl += offs;
        const float li = GATES[(row0 + tid) * 8 + h];
        cl = li - bl; pm = cl;
#pragma unroll
        for (int off = 1; off < 64; off <<= 1) { const float t = __shfl_up(pm, off); if (lane >= off) pm = fmaxf(pm, t); }
        if (lane == 63) wmax[wid] = pm;
    }
    __syncthreads();
    if (tid < 256) {
        float pmo = -INFINITY;
#pragma unroll
        for (int w = 0; w < 4; ++w) pmo = (w < wid) ? fmaxf(pmo, wmax[w]) : pmo;
        pm = fmaxf(pm, pmo);
        const float G = fmaxf(fmaxf(wmax[0], wmax[1]), fmaxf(wmax[2], wmax[3]));
        wl[tid] = expf(cl - G);
        float* CROW = (float*)(F.ws + WS_CROW); float* BROW = (float*)(F.ws + WS_BROW); float* PMROW = (float*)(F.ws + WS_PMROW);
        CROW[(row0 + tid) * 4 + h] = cl; BROW[(row0 + tid) * 4 + h] = bl; PMROW[(row0 + tid) * 4 + h] = pm;
        if (tid == 255) { ((float*)(F.ws + WS_GCH))[bh * NCH + c] = G; ((float*)(F.ws + WS_BLCH))[bh * NCH + c] = bl; }
    }
    __syncthreads();
    {
        const int ch8 = tid & 15, run = tid >> 4, r0 = run * 8;
        const float* cw = a.conv_w + (size_t)L * 4 * 1024; const float* cb = a.conv_b + (size_t)L * 1024;
#pragma unroll 1
        for (int which = 0; which < 2; ++which) {
            const int cch = which * 512 + h * 128 + ch8 * 8;
            const bf16* src = PROJ + row0 * 4096 + (which ? C_MK : C_MQ) + h * 128 + ch8 * 8;
            float w[4][8], bs[8];
#pragma unroll
            for (int k = 0; k < 4; ++k) { const f32x4 w0 = *(const f32x4*)(cw + k * 1024 + cch), w1 = *(const f32x4*)(cw + k * 1024 + cch + 4);
                w[k][0] = w0[0]; w[k][1] = w0[1]; w[k][2] = w0[2]; w[k][3] = w0[3]; w[k][4] = w1[0]; w[k][5] = w1[1]; w[k][6] = w1[2]; w[k][7] = w1[3]; }
            { const f32x4 b0 = *(const f32x4*)(cb + cch), b1 = *(const f32x4*)(cb + cch + 4); bs[0] = b0[0]; bs[1] = b0[1]; bs[2] = b0[2]; bs[3] = b0[3]; bs[4] = b1[0]; bs[5] = b1[1]; bs[6] = b1[2]; bs[7] = b1[3]; }
            u32x4_t xr[11];
#pragma unroll
            for (int i = 0; i < 11; ++i) { const int rr = r0 - 3 + i; xr[i] = (c > 0 || rr >= 0) ? *(const u32x4_t*)(src + (long)rr * 4096) : (u32x4_t){0u, 0u, 0u, 0u}; }
            float x0[8], x1[8], x2[8], x3[8];
            unpack8(xr[0], x0); unpack8(xr[1], x1); unpack8(xr[2], x2);
#pragma unroll
            for (int r = 0; r < 8; ++r) {
                unpack8(xr[r + 3], x3);
                float y[8];
#pragma unroll
                for (int k = 0; k < 8; ++k) { y[k] = silu_f(bs[k] + w[0][k] * x0[k] + w[1][k] * x1[k] + w[2][k] * x2[k] + w[3][k] * x3[k]); x0[k] = x1[k]; x1[k] = x2[k]; x2[k] = x3[k]; }
                const size_t orow = row0 + r0 + r;
                if (which == 0) {
                    u32x4_t o; o[0] = cvtpk(y[0], y[1]); o[1] = cvtpk(y[2], y[3]); o[2] = cvtpk(y[4], y[5]); o[3] = cvtpk(y[6], y[7]);
                    st16_wt(QC + orow * 512 + h * 128 + ch8 * 8, o);
                } else {
#pragma unroll
                    for (int k = 0; k < 8; ++k) y[k] *= KSCALE;
                    u32x4_t o; o[0] = cvtpk(y[0], y[1]); o[1] = cvtpk(y[2], y[3]); o[2] = cvtpk(y[4], y[5]); o[3] = cvtpk(y[6], y[7]);
                    st16_wt(KC + orow * 512 + h * 128 + ch8 * 8, o);
                    const int l = r0 + r; const float wv = wl[l];
                    u32x4_t ow; ow[0] = cvtpk(y[0] * wv, y[1] * wv); ow[1] = cvtpk(y[2] * wv, y[3] * wv); ow[2] = cvtpk(y[4] * wv, y[5] * wv); ow[3] = cvtpk(y[6] * wv, y[7] * wv);
                    *(LAS u32x4_t*)(F.lds + B1_KW + (l >> 6) * 16384 + ((ch8 >> 2) * 4 + ((l >> 4) & 3)) * 1024 + (l & 15) * 64 + (ch8 & 3) * 16) = ow;
                }
            }
        }
    }
    asm volatile("s_waitcnt vmcnt(0)" ::: "memory");
    __syncthreads();
    {
        const int td = wid & 3, tep = wid >> 2;
        const LAS char* fb = (const LAS char*)F.lds + ((lane >> 4) & 1) * 32 + (lane & 3) * 8 + (4 * hi + ((lane & 15) >> 2)) * 64;
        f32x16 acc0 = f32x16{}, acc1 = f32x16{}, accn = f32x16{};
        const bf16x8 ones = (bf16x8){(short)0x3f80, (short)0x3f80, (short)0x3f80, (short)0x3f80, (short)0x3f80, (short)0x3f80, (short)0x3f80, (short)0x3f80};
#pragma unroll 4
        for (int s16 = 0; s16 < 16; ++s16) { const int off = (s16 >> 2) * 16384 + (s16 & 3) * 1024;
            const bf16x8 kwf = trfrag(fb + B1_KW + off + td * 4096);
            const bf16x8 v0 = trfrag(fb + B1_V + off + (2 * tep) * 4096), v1 = trfrag(fb + B1_V + off + (2 * tep + 1) * 4096);
            acc0 = __builtin_amdgcn_mfma_f32_32x32x16_bf16(v0, kwf, acc0, 0, 0, 0);
            acc1 = __builtin_amdgcn_mfma_f32_32x32x16_bf16(v1, kwf, acc1, 0, 0, 0);
            if (tep == 0) accn = __builtin_amdgcn_mfma_f32_32x32x16_bf16(ones, kwf, accn, 0, 0, 0);
        }
        float* DCT = (float*)(F.ws + WS_DC) + (size_t)(bh * NCH + c) * 16384;
#pragma unroll
        for (int r = 0; r < 16; ++r) { const int er = (r & 3) + 8 * (r >> 2) + 4 * hi;
            st4_wt(&DCT[(size_t)((2 * tep) * 32 + er) * 128 + td * 32 + r32], acc0[r]);
            st4_wt(&DCT[(size_t)((2 * tep + 1) * 32 + er) * 128 + td * 32 + r32], acc1[r]); }
        if (tep == 0 && hi == 0) ((float*)(F.ws + WS_DN))[(size_t)(bh * NCH + c) * 128 + td * 32 + r32] = accn[0];
    }
    __syncthreads();
}

__device__ __forceinline__ void b2_scan(const Frame& F) {
    const int gid = F.vcu * 512 + F.tid;
    if (gid >= 8 * 16384) return;
    const int bh = gid >> 14, el = gid & 16383;
    const float* DCT = (const float*)(F.ws + WS_DC) + (size_t)bh * NCH * 16384 + el;
    const float* G = (const float*)(F.ws + WS_GCH) + bh * NCH; const float* BL = (const float*)(F.ws + WS_BLCH) + bh * NCH;
    bf16* CST = (bf16*)(F.ws + WS_CST) + (size_t)bh * NCH * 16384 + el;
    float d[NCH];
#pragma unroll
    for (int c = 0; c < NCH; ++c) d[c] = DCT[(size_t)c * 16384];
    float dn[NCH];
    const bool has_n = el < 128;
    if (has_n) {
        const float* DN = (const float*)(F.ws + WS_DN) + (size_t)bh * NCH * 128 + el;
#pragma unroll
        for (int c = 0; c < NCH; ++c) dn[c] = DN[c * 128];
    }
    float C = 0.f, n = 0.f, m = 0.f;
    float* NST = (float*)(F.ws + WS_NST) + (size_t)bh * NCH * 128 + el; float* MST = (float*)(F.ws + WS_MST) + bh * NCH;
#pragma unroll
    for (int c = 0; c < NCH; ++c) {
        CST[(size_t)c * 16384] = (bf16)f2bf(C);
        if (has_n) NST[c * 128] = n;
        if (el == 0) MST[c] = m;
        const float g = G[c], Ml = fmaxf(m, g), ac = expf(m - Ml), gc = expf(g - Ml);
        C = ac * C + gc * d[c];
        if (has_n) n = ac * n + gc * dn[c];
        m = BL[c] + Ml;
    }
}

constexpr int B3_CT = 0, B3_NV = 32768, B3_K = 0, B3_V = 65536, B3_CL = 131072, B3_S = 0, B3_SPITCH = 272;
__device__ __forceinline__ void b3_unit(const Frame& F, const Args& a, const int L, const int bh, const int c) {
    const int tid = F.tid, lane = F.lane, wid = F.wave, hi = lane >> 5, r32 = lane & 31;
    const int b = bh >> 2, h = bh & 3; const size_t row0 = (size_t)b * SEQ + (size_t)c * 256;
    const bf16* PROJ = (const bf16*)(F.ws + WS_PROJ); const bf16* QC = (const bf16*)(F.ws + WS_QC); const bf16* KC = (const bf16*)(F.ws + WS_KC); bf16* Y = (bf16*)(F.ws + WS_XN);
    const unsigned lds0 = (unsigned)(uintptr_t)F.lds;
    const size_t myrow = row0 + wid * 32 + r32;
    bf16x8 qr[8];
#pragma unroll
    for (int s = 0; s < 8; ++s) qr[s] = *(const bf16x8*)(QC + myrow * 512 + h * 128 + 16 * s + 8 * hi);
    const float c_i = ((const float*)(F.ws + WS_CROW))[myrow * 4 + h], b_i = ((const float*)(F.ws + WS_BROW))[myrow * 4 + h], pm_i = ((const float*)(F.ws + WS_PMROW))[myrow * 4 + h];
    const float m0 = ((const float*)(F.ws + WS_MST))[bh * NCH + c];
    const float M_i = fmaxf(m0, pm_i), M2 = M_i * LOG2E, w_inter = expf(m0 - M_i);
    (void)c_i;
    LAS float* nv = (LAS float*)(F.lds + B3_NV); LAS float* cl2 = (LAS float*)(F.lds + B3_CL);
    if (tid < 128) nv[tid] = ((const float*)(F.ws + WS_NST))[(size_t)(bh * NCH + c) * 128 + tid];
    if (tid < 256) cl2[tid] = ((const float*)(F.ws + WS_CROW))[(row0 + tid) * 4 + h] * LOG2E;
    asm volatile("s_waitcnt vmcnt(0)" ::: "memory");
    { const bf16* CST = (const bf16*)(F.ws + WS_CST) + (size_t)(bh * NCH + c) * 16384;
#pragma unroll
      for (int i = 0; i < 4; ++i) { const int p = wid + 8 * i, chunk = p >> 1, g = p & 1;
          glds16(CST + (size_t)(g * 64 + lane) * 128 + chunk * 8, (unsigned)__builtin_amdgcn_readfirstlane(lds0 + B3_CT + chunk * 2048 + g * 1024)); } }
    ML_WAIT_BAR(0);
    f32x16 acc[4];
#pragma unroll
    for (int te = 0; te < 4; ++te) { acc[te] = f32x16{};
#pragma unroll
        for (int s = 0; s < 8; ++s) { const bf16x8 cf = *(const LAS bf16x8*)(F.lds + B3_CT + (2 * s + hi) * 2048 + (te * 32 + r32) * 16);
            acc[te] = __builtin_amdgcn_mfma_f32_32x32x16_bf16(cf, qr[s], acc[te], 0, 0, 0); }
        __builtin_amdgcn_sched_barrier(0); }
    float qn = 0.f;
#pragma unroll
    for (int s = 0; s < 8; ++s) { float qf[8]; unpack8(__builtin_bit_cast(u32x4_t, qr[s]), qf);
        const f32x4 n0 = *(const LAS f32x4*)(nv + 16 * s + 8 * hi), n1 = *(const LAS f32x4*)(nv + 16 * s + 8 * hi + 4);
        qn += (qf[0] * n0[0] + qf[1] * n0[1]) + (qf[2] * n0[2] + qf[3] * n0[3]) + (qf[4] * n1[0] + qf[5] * n1[1]) + (qf[6] * n1[2] + qf[7] * n1[3]); }
    qn = swap_add(qn);
    ML_WAIT_BAR(0);
    {
      const bf16* ks = KC + (row0 + (wid & 3) * 64 + lane) * 512 + h * 128 + (wid >> 2) * 8; unsigned kd = lds0 + B3_K + (wid >> 2) * 4096 + (wid & 3) * 1024;
#pragma unroll 1
      for (int i = 0; i < 8; ++i) { glds16(ks, (unsigned)__builtin_amdgcn_readfirstlane(kd)); ks += 16; kd += 8192; }
      const bf16* vs = PROJ + (row0 + 16 * (wid & 3) + (lane >> 2)) * 4096 + C_MV + h * 128 + (wid >> 2) * 32 + (lane & 3) * 8; unsigned vd = lds0 + B3_V + wid * 1024;
#pragma unroll 1
      for (int i = 0; i < 4; ++i) { glds16(vs, (unsigned)__builtin_amdgcn_readfirstlane(vd)); glds16(vs + 64, (unsigned)__builtin_amdgcn_readfirstlane(vd + 8192)); vs += 64 * 4096; vd += 16384; } }
#pragma unroll
    for (int te = 0; te < 4; ++te)
#pragma unroll
        for (int r = 0; r < 16; ++r) acc[te][r] *= w_inter;
    float rowsum = 0.f;
    ML_WAIT_BAR(0);
    const LAS char* vb = (const LAS char*)F.lds + B3_V + ((lane >> 4) & 1) * 32 + (lane & 3) * 8 + (4 * hi + ((lane & 15) >> 2)) * 64;
    for (int hf = 0; hf <= wid; ++hf) {
        f32x16 p = f32x16{};
#pragma unroll
        for (int s = 0; s < 8; ++s) { const bf16x8 kf = *(const LAS bf16x8*)(F.lds + B3_K + (2 * s + hi) * 4096 + (32 * hf + r32) * 16);
            p = __builtin_amdgcn_mfma_f32_32x32x16_bf16(kf, qr[s], p, 0, 0, 0); }
        __builtin_amdgcn_sched_barrier(0);
        const bool diag = (hf == wid);
#pragma unroll
        for (int g4 = 0; g4 < 4; ++g4) { const f32x4 cc = *(const LAS f32x4*)(cl2 + 32 * hf + 8 * g4 + 4 * hi);
#pragma unroll
            for (int i = 0; i < 4; ++i) { const int r = 4 * g4 + i; const int kl = 8 * g4 + 4 * hi + i;
                const float wgt = __builtin_amdgcn_exp2f(cc[i] - M2);
                float v = p[r] * wgt; if (diag && kl > r32) v = 0.f; p[r] = v; rowsum += v; } }
        bf16x8 pw0, pw1;
        { u32x4_t w0 = {cvtpk(p[0], p[1]), cvtpk(p[2], p[3]), cvtpk(p[4], p[5]), cvtpk(p[6], p[7])}; pw0 = __builtin_bit_cast(bf16x8, w0);
          u32x4_t w1 = {cvtpk(p[8], p[9]), cvtpk(p[10], p[11]), cvtpk(p[12], p[13]), cvtpk(p[14], p[15])}; pw1 = __builtin_bit_cast(bf16x8, w1); }
        const LAS char* vt = vb + (hf >> 1) * 16384 + (2 * (hf & 1)) * 1024;
        __builtin_amdgcn_sched_barrier(0);
#pragma unroll
        for (int te = 0; te < 4; ++te) {
            acc[te] = __builtin_amdgcn_mfma_f32_32x32x16_bf16(trfrag(vt + te * 4096), pw0, acc[te], 0, 0, 0);
            acc[te] = __builtin_amdgcn_mfma_f32_32x32x16_bf16(trfrag(vt + te * 4096 + 1024), pw1, acc[te], 0, 0, 0);
        }
        __builtin_amdgcn_sched_barrier(0);
    }
    const float den = w_inter * qn + swap_add(rowsum);
    const float hden = 1.0f / fmaxf(fabsf(den), exp2f(-(b_i * LOG2E + M2)));
    float ssq = 0.f;
#pragma unroll
    for (int te = 0; te < 4; ++te)
#pragma unroll
        for (int r = 0; r < 16; ++r) { const float v = acc[te][r] * hden; acc[te][r] = v; ssq += v * v; }
    const float rstd = 1.0f / sqrtf(swap_add(ssq) * (1.0f / 128.0f) + EPS);
    ML_WAIT_BAR(0);
    LAS char* S = (LAS char*)F.lds + B3_S + wid * 32 * B3_SPITCH;
#pragma unroll
    for (int te = 0; te < 4; ++te)
#pragma unroll
        for (int g4 = 0; g4 < 4; ++g4) { u32x2_t w; w.x = cvtpk(acc[te][4 * g4] * rstd, acc[te][4 * g4 + 1] * rstd); w.y = cvtpk(acc[te][4 * g4 + 2] * rstd, acc[te][4 * g4 + 3] * rstd);
            *(LAS u32x2_t*)(S + r32 * B3_SPITCH + (32 * te + 8 * g4 + 4 * hi) * 2) = w; }
    asm volatile("s_waitcnt lgkmcnt(0)" ::: "memory");
    { const int ch = lane & 15; float mnw[8], msk[8];
#pragma unroll
      for (int k = 0; k < 8; ++k) { mnw[k] = a.m_norm_w[L * 512 + h * 128 + 8 * ch + k]; msk[k] = a.m_skip[L * 512 + h * 128 + 8 * ch + k]; }
#pragma unroll
      for (int it = 0; it < 8; ++it) { const int row = it * 4 + (lane >> 4); const size_t grow = row0 + wid * 32 + row;
          const u32x4_t sv = *(const LAS u32x4_t*)(S + row * B3_SPITCH + ch * 16);
          const u32x4_t qv = *(const u32x4_t*)(QC + grow * 512 + h * 128 + 8 * ch), zv = *(const u32x4_t*)(PROJ + grow * 4096 + C_MZ + h * 128 + 8 * ch);
          float v[8], q[8], z[8]; unpack8(sv, v); unpack8(qv, q); unpack8(zv, z);
          u32x4_t ov;
#pragma unroll
          for (int k = 0; k < 4; ++k) ov[k] = cvtpk((v[2 * k] * mnw[2 * k] + msk[2 * k] * q[2 * k]) * silu_f(z[2 * k]), (v[2 * k + 1] * mnw[2 * k + 1] + msk[2 * k + 1] * q[2 * k + 1]) * silu_f(z[2 * k + 1]));
          st16_wt(Y + grow * 1024 + h * 128 + 8 * ch, ov); } }
    ML_WAIT_BAR(0);
}
}


typedef __attribute__((address_space(1))) unsigned gu32;
#define XB_TMO      128
#define XB_XCNT(j)  (256  + 64 * (j))
#define XB_XSUB(j)  (1280 + 64 * (j))
#define XB_XGEN(j)  (2304 + 64 * (j))
#define XB_TOP      3328
#define XB_TOPGEN   3392
#define XCD_BAR_WORDS 3456
#define XB_SPIN_CAP (1u << 18)

__device__ __forceinline__ unsigned xb_ld(unsigned* p)              { return __hip_atomic_load(p, __ATOMIC_RELAXED, __HIP_MEMORY_SCOPE_AGENT); }
__device__ __forceinline__ unsigned xb_add(unsigned* p, unsigned v) { return __hip_atomic_fetch_add(p, v, __ATOMIC_RELAXED, __HIP_MEMORY_SCOPE_AGENT); }
__device__ __forceinline__ unsigned xb_xcc_id() { return (unsigned)__builtin_amdgcn_s_getreg((3 << 11) | 20) & 0xFu; }
#define XB_SPIN(cond, bar) do { unsigned _sp = 0; while (cond) { __builtin_amdgcn_s_sleep(1); \
    if ((++_sp & 255u) == 0u) { if (xb_ld(&(bar)[XB_TMO])) break; if (_sp > XB_SPIN_CAP) { atomicAdd(&(bar)[XB_TMO], 1u); break; } } } } while (0)

struct XcdBarrier {
    unsigned* bar; unsigned x;
    volatile LAS unsigned* st;
};

__device__ __forceinline__ XcdBarrier xcd_barrier_post(unsigned* bar, volatile LAS unsigned* st) {
    XcdBarrier b; b.bar = bar; b.x = xb_xcc_id(); b.st = st;
    if (threadIdx.x == 0) (void)xb_add(&bar[XB_XCNT(b.x)], 1u);
    return b;
}
__device__ __forceinline__ void xcd_barrier_complete(unsigned* bar, unsigned x, unsigned& nloc, unsigned& nx) {
    const unsigned G = gridDim.x * gridDim.y * gridDim.z;
    unsigned sum, cnt, mine, sp = 0u;
    for (;;) {
        sum = 0u; cnt = 0u; mine = 0u;
#pragma unroll
        for (unsigned j = 0; j < 16; ++j) { const unsigned c = xb_ld(&bar[XB_XCNT(j)]); sum += c; cnt += (c > 0u) ? 1u : 0u; mine = (j == x) ? c : mine; }
        if (sum == G) break;
        __builtin_amdgcn_s_sleep(1);
        if ((++sp & 255u) == 0u) { if (xb_ld(&bar[XB_TMO])) break; if (sp > XB_SPIN_CAP) { atomicAdd(&bar[XB_TMO], 1u); break; } }
    }
    nloc = mine > 0u ? mine : 1u; nx = cnt > 0u ? cnt : 1u;
}

__device__ __forceinline__ void xcd_barrier(const XcdBarrier& b) {
    asm volatile("s_waitcnt vmcnt(0)" ::: "memory");
    __syncthreads();
    if (threadIdx.x == 0) {
        unsigned* bar = b.bar;
        __builtin_amdgcn_s_waitcnt(0);
        unsigned nloc = b.st[0], nx = b.st[1];
        if (nloc == 0u) { xcd_barrier_complete(bar, b.x, nloc, nx); b.st[0] = nloc; b.st[1] = nx; }
        const unsigned old = xb_add(&bar[XB_XSUB(b.x)], 1u);
        const unsigned gen = old / nloc;
        if (old + 1u == (gen + 1u) * nloc) {
            __builtin_amdgcn_fence(__ATOMIC_RELEASE, "agent");
            asm volatile("s_waitcnt vmcnt(0)" ::: "memory");
            const unsigned og = xb_add(&bar[XB_TOP], 1u);
            const unsigned tg = og / nx;
            if (og + 1u == (tg + 1u) * nx) xb_add(&bar[XB_TOPGEN], 1u);
            else XB_SPIN(xb_ld(&bar[XB_TOPGEN]) == tg, bar);
            __builtin_amdgcn_fence(__ATOMIC_ACQUIRE, "agent");
            xb_add(&bar[XB_XGEN(b.x)], 1u);
            asm volatile("s_waitcnt vmcnt(0)" ::: "memory");
        } else {
            XB_SPIN(xb_ld(&bar[XB_XGEN(b.x)]) == gen, bar);
            __builtin_amdgcn_fence(__ATOMIC_ACQUIRE, "agent");
            asm volatile("s_waitcnt vmcnt(0)" ::: "memory");
        }
    }
    __syncthreads();
}

constexpr int N_PHASES = 1 + 6 * DEPTH;
#ifndef NAIVE_MIX
#define NAIVE_MIX 0
#endif
#ifndef NAIVE_ATTN
#define NAIVE_ATTN 0
#endif
constexpr bool HAS_B12 = true;
#define PH_IN(k) (lo <= (k) && (k) < hi)
#ifndef REP_P0
#define REP_P0 1
#endif
#ifndef REP_G1
#define REP_G1 1
#endif
#ifndef REP_B1
#define REP_B1 1
#endif
#ifndef REP_B2
#define REP_B2 1
#endif
#ifndef REP_B3
#define REP_B3 1
#endif
#ifndef REP_AT
#define REP_AT 1
#endif
#ifndef REP_G2
#define REP_G2 1
#endif
#ifndef REP_R
#define REP_R 1
#endif
#define REP_DO(n, ...) do { __VA_ARGS__; if ((n) >= 2) { asm volatile("" ::: "memory"); __builtin_amdgcn_sched_barrier(0); __VA_ARGS__; } } while (0)
#ifndef USE_XCD_BAR
#define USE_XCD_BAR 1
#endif
#if USE_XCD_BAR
#ifndef REP_BAR
#define REP_BAR 1
#endif
#ifndef CG_FIRST
#define CG_FIRST 0
#endif
#define PH_SYNC(k) do { if (lo <= (k) && (k) + 1 < hi) { if (CG_FIRST && (k) == 0) cg::this_grid().sync(); else { xcd_barrier(bar); if (REP_BAR >= 2) xcd_barrier(bar); } } } while (0)
#else
#define PH_SYNC(k) do { if (lo <= (k) && (k) + 1 < hi) cg::this_grid().sync(); } while (0)
#endif
template <int L> __device__ __forceinline__ void layer_phases(const Frame& F, const Args& a, const int lo, const int hi, const XcdBarrier& bar) {
    constexpr int base = 1 + 6 * L;
    bf16* XN = (bf16*)(a.ws + WS_XN); bf16* PROJ = (bf16*)(a.ws + WS_PROJ); float* GATES = (float*)(a.ws + WS_GATES);
    if (PH_IN(base + 0)) {
        pg8::Gemm g{XN, (const bf16*)(a.ws + WS_WIN) + (size_t)L * NPROJ * DMODEL, TOK, NPROJ, DMODEL}; pg8::StaticOrder S; S.init(TOK, NPROJ, F.G, (int)blockIdx.x);
        pg8::EpiProj E{PROJ, (const float*)(a.ws + WS_COS), (const float*)(a.ws + WS_SIN), C2};
        REP_DO(REP_G1, pg8::gemm_phase<pg8::EpiProj, pg8::StaticOrder, true, true>(F.lds, g, S, E));
    }
    PH_SYNC(base + 0);
    if (PH_IN(base + 1)) { if (REP_B3 >= 2) { ml::b3_unit(F, a, L, F.vcu >> 5, F.vcu & 31); asm volatile("" ::: "memory"); }
        REP_DO(REP_B1, ml::b1_unit(F, a, L, F.vcu >> 5, F.vcu & 31)); }
    PH_SYNC(base + 1);
    if (PH_IN(base + 2)) { REP_DO(REP_B2, ml::b2_scan(F)); }
    PH_SYNC(base + 2);
    if (PH_IN(base + 3)) {
        ml::b3_unit(F, a, L, F.vcu >> 5, F.vcu & 31);
        { const int bh = F.vcu >> 5, s_ = F.vcu & 31;
          REP_DO(REP_AT, att::attn_unit2(F, a, L, bh >> 2, bh & 3, s_); att::attn_unit2(F, a, L, bh >> 2, bh & 3, 63 - s_)); }
    }
    PH_SYNC(base + 3);
    if (PH_IN(base + 4)) {
        pg8::Gemm g{XN  , (const bf16*)(a.ws + WS_WOUT) + (size_t)L * DMODEL * DMODEL, TOK, DMODEL, DMODEL}; pg8::StaticOrder S; S.init(TOK, DMODEL, F.G, (int)blockIdx.x);
        pg8::EpiRes E{L == 0 ? a.x : a.out, a.out};
        REP_DO(L == 0 ? REP_G2 : 1, pg8::gemm_phase<pg8::EpiRes, pg8::StaticOrder, false, true>(F.lds, g, S, E));
    }
    PH_SYNC(base + 4);
    if (PH_IN(base + 5)) {
        if (L + 1 < DEPTH) { REP_DO(REP_R, phase_rownorm(F, a.out, a.norm_w + (L + 1) * DMODEL, a.w_in + (size_t)(L + 1) * DMODEL * DIN, a.i_bias + (L + 1) * 4, a.f_bias + (L + 1) * 4, XN, GATES, nullptr)); }
        else phase_rownorm(F, a.out, a.fnw, nullptr, nullptr, nullptr, nullptr, nullptr, a.out);
    }
    if (L + 1 < DEPTH) PH_SYNC(base + 5);
}
__global__ void __launch_bounds__(512, 2) fwd_kernel(Args a) {
    extern __shared__ __attribute__((aligned(16))) unsigned char lds_raw[];
    Frame F; F.lds = (LAS unsigned char*)lds_raw; F.tid = threadIdx.x; F.lane = F.tid & 63; F.wave = __builtin_amdgcn_readfirstlane(F.tid >> 6);
    F.G = gridDim.x; { const int bx = blockIdx.x; F.vcu = (F.G % 8 == 0) ? (bx % 8) * (F.G / 8) + bx / 8 : bx; }
    F.ws = a.ws;
    const int lo = a.ph_lo, hi = a.ph_hi;
    volatile LAS unsigned* MISC = (volatile LAS unsigned*)(F.lds + MISC_OFF);
    if (F.tid < 16) MISC[F.tid] = 0u;
    __syncthreads();
    XcdBarrier bar = xcd_barrier_post((unsigned*)(a.ws + WS_CTL) + 4096, MISC + 8);
    if (PH_IN(0)) {
        REP_DO(REP_P0, phase_prologue(F, a); __syncthreads());
        phase_rownorm(F, a.x, a.norm_w, a.w_in, a.i_bias, a.f_bias, (bf16*)(a.ws + WS_XN), (float*)(a.ws + WS_GATES), nullptr);
    }
    PH_SYNC(0);
    layer_phases<0>(F, a, lo, hi, bar);
    layer_phases<1>(F, a, lo, hi, bar);
}

extern "C" void kernel_launch(void* const* d_in, const int* in_sizes, int n_in, void* d_out, int out_size, void* d_ws, size_t ws_size, hipStream_t stream) {
    static int grid = 0;
    if (grid == 0) {
        if (n_in != 16 || in_sizes[0] != TOK * DMODEL || out_size != TOK * DMODEL || ws_size < WS_END) { fprintf(stderr, "kernel_launch: unexpected shapes (n_in %d, in0 %d, out %d, ws %zu)\n", n_in, n_in > 0 ? in_sizes[0] : -1, out_size, ws_size); grid = -1; return; }
        int dev = 0, cus = 0, per_cu = 0;
        hipGetDevice(&dev); hipDeviceGetAttribute(&cus, hipDeviceAttributeMultiprocessorCount, dev);
        if (hipFuncSetAttribute((const void*)fwd_kernel, hipFuncAttributeMaxDynamicSharedMemorySize, LDS_BYTES) != hipSuccess) { fprintf(stderr, "kernel_launch: hipFuncSetAttribute failed\n"); grid = -1; return; }
        hipOccupancyMaxActiveBlocksPerMultiprocessor(&per_cu, (const void*)fwd_kernel, 512, LDS_BYTES);
        (void)hipGetLastError();
        if (per_cu < 1) { fprintf(stderr, "kernel_launch: occupancy query says %d blocks per CU\n", per_cu); grid = -1; return; }
        grid = cus;
        if (grid != 256) { fprintf(stderr, "kernel_launch: this kernel's static schedules need exactly 256 CUs (got %d); nothing launched\n", grid); grid = -1; return; }
    }
    if (grid < 0) return;
    Args a{};
    a.x = (const float*)d_in[0]; a.norm_w = (const float*)d_in[1]; a.w_in = (const float*)d_in[2]; a.conv_w = (const float*)d_in[3]; a.conv_b = (const float*)d_in[4];
    a.i_bias = (const float*)d_in[5]; a.f_bias = (const float*)d_in[6]; a.m_norm_w = (const float*)d_in[7]; a.m_skip = (const float*)d_in[8];
    a.lq1 = (const float*)d_in[9]; a.lk1 = (const float*)d_in[10]; a.lq2 = (const float*)d_in[11]; a.lk2 = (const float*)d_in[12]; a.a_norm_w = (const float*)d_in[13];
    a.w_out = (const float*)d_in[14]; a.fnw = (const float*)d_in[15]; a.out = (float*)d_out; a.ws = (unsigned char*)d_ws;
#if MK_ONE_LAUNCH
    if (hipMemsetAsync((char*)d_ws + WS_CTL, 0, 65536, stream) != hipSuccess) { fprintf(stderr, "kernel_launch: hipMemsetAsync failed\n"); return; }
    a.ph_lo = 0; a.ph_hi = N_PHASES;
    void* args[] = {&a};
    hipError_t e = hipLaunchCooperativeKernel((const void*)fwd_kernel, dim3(grid), dim3(512), args, LDS_BYTES, stream);
    if (e != hipSuccess) fprintf(stderr, "cooperative launch failed: %s (grid %d)\n", hipGetErrorString(e), grid);
#else
    for (int ph = 0; ph < N_PHASES; ++ph) {
        if (ph > 0) { const int s = (ph - 1) % 6; if (!HAS_B12 && (s == 1 || s == 2)) continue; }
        a.ph_lo = ph; a.ph_hi = ph + 1;
        hipLaunchKernelGGL(fwd_kernel, dim3(grid), dim3(512), LDS_BYTES, stream, a);
    }
#endif
}
```
